# Optimizing an MI355X kernel written in HIP

```python
import math
import jax, jax.numpy as jnp
from jax import lax
import numpy as np

D_MODEL = 2048
BATCH = 4
SEQ = 8192
DEPTH = 1

GRID_W = 64
CTX_LEN = 256
MIX_W = D_MODEL
GDN_W = MIX_W // 2
HYENA_W = MIX_W - GDN_W
GDN_HEADS = 8
GDN_HEAD_DIM = GDN_W // GDN_HEADS
GDN_CONV = 5
GDN_CHUNK = 64
HYENA_CONV = 3
HYENA_EMB = 33
HYENA_FILTER_W = 64
HYENA_DECAY_TARGET = 1e-2
HYENA_FAST_PCT = 0.3
HYENA_SLOW_PCT = 1.5
D_FF = ((8 * D_MODEL // 3 + 255) // 256) * 256
EPS = 1e-6

COL_K = 0
COL_V = COL_K + GDN_W
COL_Q = COL_V + GDN_W
COL_BETA = COL_Q + GDN_W
COL_Z = COL_BETA + 4 * GDN_HEADS
COL_HY = COL_Z + GDN_W
IN_COLS = COL_HY + 3 * HYENA_W

kernel_name = "hybrid_gdn_hyena_prefix_dit_block"


def _rmsnorm(x, g):
    xf = x.astype(jnp.float32)
    y = xf * lax.rsqrt(jnp.mean(xf * xf, axis=-1, keepdims=True) + EPS)
    return (y * g.astype(jnp.float32)).astype(x.dtype)


def _l2norm(x):
    xf = x.astype(jnp.float32)
    return xf * lax.rsqrt(jnp.sum(xf * xf, axis=-1, keepdims=True) + EPS)


def _dwconv(u, w):
    K = w.shape[0]
    pad = K // 2
    L = u.shape[1]
    up = jnp.pad(u, ((0, 0), (pad, pad), (0, 0)))
    out = up[:, 0:L] * w[0]
    for i in range(1, K):
        out = out + up[:, i:i + L] * w[i]
    return out


def _adaln(cvec, w_mod, b_mod):
    m = jax.nn.silu(cvec) @ w_mod + b_mod
    return jnp.split(m[..., None, :], 6, axis=-1)


def _heads(t):
    return t.reshape(t.shape[:-1] + (GDN_HEADS, GDN_HEAD_DIM))


def _gdn_gates(ba, a_log, dt_bias):
    ba = ba.astype(jnp.float32).reshape(ba.shape[:-1] + (2, 2, GDN_HEADS))
    beta = jax.nn.sigmoid(ba[..., 0, :, :])
    g = -jnp.exp(a_log.astype(jnp.float32)) * jax.nn.softplus(ba[..., 1, :, :] + dt_bias.astype(jnp.float32))
    return beta, g


def _to_chunks(t):
    B, L, H = t.shape[:3]
    t = t.reshape((B, L // GDN_CHUNK, GDN_CHUNK, H) + t.shape[3:])
    return jnp.moveaxis(t, (1, 3), (0, 2))


def _gdn_chunks(k, v, beta, g):
    kc, vc, bc, gc = _to_chunks(k), _to_chunks(v), _to_chunks(beta), _to_chunks(g)
    gcum = jnp.cumsum(gc, axis=-1)
    idx = jnp.arange(GDN_CHUNK)
    strict = idx[:, None] > idx[None, :]
    diff = jnp.where(strict, gcum[..., :, None] - gcum[..., None, :], 0.0)
    kk = jnp.einsum('nbhid,nbhjd->nbhij', kc, kc)
    a_strict = jnp.where(strict, bc[..., :, None] * kk * jnp.exp(diff), 0.0)
    lower_unit = a_strict + jnp.eye(GDN_CHUNK, dtype=a_strict.dtype)
    rhs = jnp.concatenate([vc * bc[..., None], kc * (bc * jnp.exp(gcum))[..., None]], axis=-1)
    sol = lax.linalg.triangular_solve(lower_unit, rhs, left_side=True, lower=True, unit_diagonal=True)
    dv = vc.shape[-1]
    return kc, gcum, sol[..., :dv], sol[..., dv:]


def _gdn_scan(kc, gcum, u, w, s0, emit):
    def step(s, xs):
        k_n, g_n, u_n, w_n = xs
        v_new = u_n - jnp.einsum('bhcd,bhde->bhce', w_n, s)
        g_last = g_n[..., -1]
        s_next = s * jnp.exp(g_last)[..., None, None] + jnp.einsum(
            'bhcd,bhce->bhde', k_n * jnp.exp(g_last[..., None] - g_n)[..., None], v_new)
        return s_next, ((s, v_new) if emit else None)
    return lax.scan(step, s0, (kc, gcum, u, w))


def _gdn_direction(q, k, v, beta, g, s0):
    kc, gcum, u, w = _gdn_chunks(k, v, beta, g)
    s_fin, (s_start, v_new) = _gdn_scan(kc, gcum, u, w, s0, True)
    qc = _to_chunks(q)
    idx = jnp.arange(GDN_CHUNK)
    incl = idx[:, None] >= idx[None, :]
    diff = jnp.where(incl, gcum[..., :, None] - gcum[..., None, :], 0.0)
    attn = jnp.where(incl, jnp.einsum('nbhid,nbhjd->nbhij', qc, kc) * jnp.exp(diff), 0.0)
    o = (jnp.einsum('nbhcd,nbhde->nbhce', qc * jnp.exp(gcum)[..., None], s_start)
         + jnp.einsum('nbhij,nbhje->nbhie', attn, v_new))
    N, B, H, C, E = o.shape
    return jnp.moveaxis(o, (0, 2), (1, 3)).reshape(B, N * C, H, E), s_fin


def _gdn_final_state(k, v, beta, g, s0):
    kc, gcum, u, w = _gdn_chunks(k, v, beta, g)
    s_fin, _ = _gdn_scan(kc, gcum, u, w, s0, False)
    return s_fin


def _hyena_filter(L, w1, b1, f1, w2, b2, f2, w3, b3, f3, w4):
    f32 = jnp.float32
    t = jnp.arange(L, dtype=f32)
    t01 = t / max(L - 1, 1)
    bands = (HYENA_EMB - 1) // 2
    freqs = jnp.linspace(1e-4, bands - 1, bands, dtype=f32)
    ang = (2.0 * math.pi / L) * t[:, None] * freqs[None, :]
    z = jnp.concatenate([t01[:, None], jnp.cos(ang), -jnp.sin(ang)], axis=-1)
    h = jnp.sin(f1.astype(f32) * (z @ w1.astype(f32) + b1.astype(f32)))
    h = jnp.sin(f2.astype(f32) * (h @ w2.astype(f32) + b2.astype(f32)))
    h = jnp.sin(f3.astype(f32) * (h @ w3.astype(f32) + b3.astype(f32)))
    h = h @ w4.astype(f32)
    max_decay = math.log(HYENA_DECAY_TARGET) / HYENA_FAST_PCT
    min_decay = math.log(HYENA_DECAY_TARGET) / HYENA_SLOW_PCT
    deltas = jnp.abs(jnp.linspace(min_decay, max_decay, HYENA_W, dtype=f32))
    window = jnp.exp(-t01[:, None] * deltas[None, :])
    return h * jnp.tile(window, (1, 2))


def _long_conv_bidir(u, filt):
    L, C = u.shape[1], u.shape[2]
    hf, hb = filt[:, :C], filt[:, C:]
    taps = jnp.concatenate([hf, jnp.zeros((1, C), filt.dtype), hb[:0:-1]], axis=0)
    U = jnp.fft.rfft(u.astype(jnp.float32), n=2 * L, axis=1)
    K = jnp.fft.rfft(taps, n=2 * L, axis=0)
    y = jnp.fft.irfft(U * K[None], n=2 * L, axis=1)[:, :L]
    return y.astype(u.dtype)


def _mixer(h, s0_f, s0_b, p):
    B, L, _ = h.shape
    proj = h @ p['w_in']
    qkv = jax.nn.silu(_dwconv(proj[..., COL_K:COL_BETA], p['conv_qkv']))
    k = _l2norm(_heads(qkv[..., COL_K:COL_V]))
    v = _heads(qkv[..., COL_V:COL_Q]).astype(jnp.float32)
    q = _l2norm(_heads(qkv[..., COL_Q:COL_BETA])) * (GDN_HEAD_DIM ** -0.5)
    beta, g = _gdn_gates(proj[..., COL_BETA:COL_Z], p['a_log'], p['dt_bias'])
    o_f, s_f = _gdn_direction(q, k, v, beta[:, :, 0], g[:, :, 0], s0_f)
    o_b, s_b = _gdn_direction(jnp.flip(q, 1), jnp.flip(k, 1), jnp.flip(v, 1),
                              jnp.flip(beta[:, :, 1], 1), jnp.flip(g[:, :, 1], 1), s0_b)
    z = jax.nn.silu(_heads(proj[..., COL_Z:COL_HY]).astype(jnp.float32))
    o = _rmsnorm(o_f + jnp.flip(o_b, 1), p['gdn_norm']) * z
    o = o.reshape(B, L, GDN_W).astype(h.dtype)
    hy = _dwconv(proj[..., COL_HY:], p['conv_hy']) + p['conv_hy_b']
    x0, x1, vh = jnp.split(hy, 3, axis=-1)
    uh = x1 * vh
    filt = _hyena_filter(L, p['filt_w1'], p['filt_b1'], p['filt_freq1'], p['filt_w2'], p['filt_b2'],
                         p['filt_freq2'], p['filt_w3'], p['filt_b3'], p['filt_freq3'], p['filt_w4'])
    y = x0 * (_long_conv_bidir(uh, filt) + p['hyena_bias'] * uh)
    out = jnp.concatenate([o, y], axis=-1) @ p['w_out']
    return out, s_f, s_b


def _block(s, mod, s0_f, s0_b, p):
    sh_a, sc_a, g_a, sh_f, sc_f, g_f = mod
    h = _rmsnorm(s, p['norm_pre_mix']) * (1.0 + sc_a) + sh_a
    out, s_f, s_b = _mixer(h, s0_f, s0_b, p)
    s = s + g_a * _rmsnorm(out, p['norm_post_mix'])
    h = _rmsnorm(s, p['norm_pre_ffn']) * (1.0 + sc_f) + sh_f
    ff = (jax.nn.silu(h @ p['w_gate']) * (h @ p['w_up'])) @ p['w_down']
    s = s + g_f * _rmsnorm(ff, p['norm_post_ffn'])
    return s, s_f, s_b


def _context_states(ctx, mod, p):
    sh_a, sc_a = mod[0], mod[1]
    h = _rmsnorm(ctx, p['norm_pre_mix']) * (1.0 + sc_a) + sh_a
    kv = jax.nn.silu(_dwconv(h @ p['w_in'][:, COL_K:COL_Q], p['conv_qkv'][:, COL_K:COL_Q]))
    k = _l2norm(_heads(kv[..., :GDN_W]))
    v = _heads(kv[..., GDN_W:]).astype(jnp.float32)
    beta, g = _gdn_gates(h @ p['w_in'][:, COL_BETA:COL_Z], p['a_log'], p['dt_bias'])
    s0 = jnp.zeros((ctx.shape[0], GDN_HEADS, GDN_HEAD_DIM, GDN_HEAD_DIM), jnp.float32)
    s_f = _gdn_final_state(k, v, beta[:, :, 0], g[:, :, 0], s0)
    s_b = _gdn_final_state(jnp.flip(k, 1), jnp.flip(v, 1), jnp.flip(beta[:, :, 1], 1), jnp.flip(g[:, :, 1], 1), s0)
    return s_f, s_b


def setup_inputs(seed: int = 0) -> dict:
    key = jax.random.key(seed)
    ks = jax.random.split(key, 34)
    f32 = jnp.float32
    D, NL = D_MODEL, DEPTH

    def nrm(k, shape, scale):
        return jax.random.normal(k, shape, f32) * scale

    dt = jnp.exp(jax.random.uniform(ks[13], (NL, 2, GDN_HEADS), f32, math.log(1e-3), math.log(1e-1)))
    return {
        'x': nrm(ks[0], (BATCH, SEQ, D), 1.0),
        'c': nrm(ks[1], (BATCH, D), 1.0),
        'ctx': nrm(ks[2], (BATCH, CTX_LEN, D), 1.0),
        'c_ctx': nrm(ks[3], (D,), 1.0),
        'w_mod': nrm(ks[4], (NL, D, 6 * D), 0.5 * D ** -0.5),
        'b_mod': nrm(ks[5], (NL, 6 * D), 0.02),
        'norm_pre_mix': 1.0 + nrm(ks[6], (NL, D), 0.05),
        'norm_post_mix': 1.0 + nrm(ks[7], (NL, D), 0.05),
        'norm_pre_ffn': 1.0 + nrm(ks[8], (NL, D), 0.05),
        'norm_post_ffn': 1.0 + nrm(ks[9], (NL, D), 0.05),
        'w_in': nrm(ks[10], (NL, D, IN_COLS), D ** -0.5),
        'conv_qkv': nrm(ks[11], (NL, GDN_CONV, 3 * GDN_W), GDN_CONV ** -0.5),
        'a_log': jnp.log(jax.random.uniform(ks[12], (NL, 2, GDN_HEADS), f32, 1.0, 16.0)),
        'dt_bias': dt + jnp.log(-jnp.expm1(-dt)),
        'gdn_norm': 1.0 + nrm(ks[14], (NL, GDN_HEAD_DIM), 0.05),
        'conv_hy': nrm(ks[15], (NL, HYENA_CONV, 3 * HYENA_W), HYENA_CONV ** -0.5),
        'conv_hy_b': nrm(ks[16], (NL, 3 * HYENA_W), 0.02),
        'filt_w1': nrm(ks[17], (NL, HYENA_EMB, HYENA_FILTER_W), HYENA_EMB ** -0.5),
        'filt_b1': nrm(ks[18], (NL, HYENA_FILTER_W), 0.02),
        'filt_freq1': 1.0 + nrm(ks[19], (NL, HYENA_FILTER_W), 0.05),
        'filt_w2': nrm(ks[20], (NL, HYENA_FILTER_W, HYENA_FILTER_W), HYENA_FILTER_W ** -0.5),
        'filt_b2': nrm(ks[21], (NL, HYENA_FILTER_W), 0.02),
        'filt_freq2': 1.0 + nrm(ks[22], (NL, HYENA_FILTER_W), 0.05),
        'filt_w3': nrm(ks[23], (NL, HYENA_FILTER_W, HYENA_FILTER_W), HYENA_FILTER_W ** -0.5),
        'filt_b3': nrm(ks[24], (NL, HYENA_FILTER_W), 0.02),
        'filt_freq3': 1.0 + nrm(ks[25], (NL, HYENA_FILTER_W), 0.05),
        'filt_w4': nrm(ks[26], (NL, HYENA_FILTER_W, 2 * HYENA_W), 0.02),
        'hyena_bias': nrm(ks[27], (NL, HYENA_W), 1.0),
        'w_out': nrm(ks[28], (NL, MIX_W, D), MIX_W ** -0.5),
        'w_gate': nrm(ks[29], (NL, D, D_FF), D ** -0.5),
        'w_up': nrm(ks[30], (NL, D, D_FF), D ** -0.5),
        'w_down': nrm(ks[31], (NL, D_FF, D), D_FF ** -0.5),
    }


def reference(x, c, ctx, c_ctx, w_mod, b_mod, norm_pre_mix, norm_post_mix, norm_pre_ffn, norm_post_ffn,
              w_in, conv_qkv, a_log, dt_bias, gdn_norm, conv_hy, conv_hy_b,
              filt_w1, filt_b1, filt_freq1, filt_w2, filt_b2, filt_freq2, filt_w3, filt_b3, filt_freq3, filt_w4,
              hyena_bias, w_out, w_gate, w_up, w_down):
    for layer in range(DEPTH):
        p = {
            'norm_pre_mix': norm_pre_mix[layer], 'norm_post_mix': norm_post_mix[layer],
            'norm_pre_ffn': norm_pre_ffn[layer], 'norm_post_ffn': norm_post_ffn[layer],
            'w_in': w_in[layer], 'conv_qkv': conv_qkv[layer], 'a_log': a_log[layer], 'dt_bias': dt_bias[layer],
            'gdn_norm': gdn_norm[layer], 'conv_hy': conv_hy[layer], 'conv_hy_b': conv_hy_b[layer],
            'filt_w1': filt_w1[layer], 'filt_b1': filt_b1[layer], 'filt_freq1': filt_freq1[layer],
            'filt_w2': filt_w2[layer], 'filt_b2': filt_b2[layer], 'filt_freq2': filt_freq2[layer],
            'filt_w3': filt_w3[layer], 'filt_b3': filt_b3[layer], 'filt_freq3': filt_freq3[layer],
            'filt_w4': filt_w4[layer], 'hyena_bias': hyena_bias[layer], 'w_out': w_out[layer],
            'w_gate': w_gate[layer], 'w_up': w_up[layer], 'w_down': w_down[layer],
        }
        mod_x = _adaln(c, w_mod[layer], b_mod[layer])
        mod_c = _adaln(c_ctx[None], w_mod[layer], b_mod[layer])
        if layer + 1 < DEPTH:
            s0 = jnp.zeros((ctx.shape[0], GDN_HEADS, GDN_HEAD_DIM, GDN_HEAD_DIM), jnp.float32)
            ctx, s_f, s_b = _block(ctx, mod_c, s0, s0, p)
        else:
            s_f, s_b = _context_states(ctx, mod_c, p)
        x, _, _ = _block(x, mod_x, s_f, s_b, p)
    return x
```

```cpp
#include <hip/hip_runtime.h>
#include <hip/hip_cooperative_groups.h>
#include <cstdio>
#include <cstdint>
namespace cg = cooperative_groups;

#ifndef MULTI_LAUNCH
#define MULTI_LAUNCH 0
#endif

__device__ __forceinline__ int otid() { int t = threadIdx.x; asm volatile("" : "+v"(t)); return t; }

#undef MULTI_LAUNCH
#define MULTI_LAUNCH 0
#define REP_MASK 0
namespace pg8 {
#define PG8_LAS __attribute__((address_space(3)))
typedef unsigned short bf16_t;
typedef short bf16x8 __attribute__((ext_vector_type(8)));
typedef float f32x4 __attribute__((ext_vector_type(4)));
typedef unsigned u32x4 __attribute__((ext_vector_type(4)));
constexpr int BM = 256, BK = 64, HALF = 128, HTB = HALF * BK * 2  , STAGE_BYTES = 8 * HTB, NXCD = 8, WGM = 8;

__host__ __device__ __forceinline__ int lds_byte(int r, int c) { const int st = (r >> 4) * 2 + (c >> 5), rr = r & 15, cc = c & 31, ob = rr * 64 + cc * 2; return st * 1024 + (ob ^ (((ob >> 9) & 1) << 5)); }
__host__ __device__ __forceinline__ void stage_rc(int b, int& R, int& C) { const int st = b / 1024, sb = b % 1024, swz = sb ^ (((sb >> 9) & 1) << 5); R = (st >> 1) * 16 + swz / 64; C = (st & 1) * 32 + (swz % 64) / 2; }
__host__ __device__ __forceinline__ int perm32(int rho) { const int n = rho >> 4, i = rho & 15; return 8 * (i >> 2) + 4 * n + (i & 3); }

struct Unit { int pm, pn; };
struct Gemm { const bf16_t* A; const bf16_t* Bt; int M, N, K; };

struct StaticOrder {
    int nM, nN, nwg, G, c;
    __host__ __device__ void init(int M, int N, int G_, int c_) { nM = M / BM; nN = N / BM; nwg = nM * nN; G = G_; c = c_; }
    __host__ __device__ bool next(int i, Unit& u) const {
        const long L = (long)i * G + c; if (L >= nwg) return false;
        int wgid = (int)L; { const int q = nwg / NXCD, r = nwg % NXCD, xcd = wgid % NXCD, off = wgid / NXCD; wgid = (xcd < r ? xcd * (q + 1) : r * (q + 1) + (xcd - r) * q) + off; }
        const int nig = WGM * nN, gid = wgid / nig, fm = gid * WGM, gsz = (nM - fm) < WGM ? (nM - fm) : WGM;
        u.pm = fm + ((wgid % nig) % gsz); u.pn = (wgid % nig) / gsz; return true;
    }
    __device__ __forceinline__ void a_ready(const Unit&) const {}
    __device__ __forceinline__ void done(const Unit&) const {}
};

__device__ __forceinline__ unsigned cvt_pk_bf16(float lo, float hi) { unsigned r; asm volatile("v_cvt_pk_bf16_f32 %0, %1, %2" : "=v"(r) : "v"(lo), "v"(hi)); return r; }
__device__ __forceinline__ float silu_f(float x) { return x * __builtin_amdgcn_rcpf(1.0f + __expf(-x)); }

struct EpiPlain {
    static constexpr bool PERM = true, AFTER_DRAIN = false;
    bf16_t* O; int ldc;
    __device__ __forceinline__ void operator()(const f32x4 (&acc)[2][2][4][2], const Unit& u, int wr, int wc, int fr, int fq) const {
        const int row0 = u.pm * BM + wr * 64 + fr, col0 = u.pn * BM + wc * 32 + 8 * fq;
#pragma unroll
        for (int ai = 0; ai < 2; ++ai)
#pragma unroll
            for (int m = 0; m < 4; ++m) { bf16_t* rowp = O + (size_t)(row0 + ai * HALF + m * 16) * ldc + col0;
#pragma unroll
                for (int bj = 0; bj < 2; ++bj) { const f32x4 v0 = acc[ai][bj][m][0], v1 = acc[ai][bj][m][1];
                    u32x4 w; w.x = cvt_pk_bf16(v0[0], v0[1]); w.y = cvt_pk_bf16(v0[2], v0[3]); w.z = cvt_pk_bf16(v1[0], v1[1]); w.w = cvt_pk_bf16(v1[2], v1[3]);
                    *(u32x4*)(rowp + bj * HALF) = w; } }
    }
};
struct EpiProj {
    static constexpr bool PERM = true, AFTER_DRAIN = false;
    bf16_t* pgdn; bf16_t* pz; bf16_t* phy; float* gates;
    __device__ __forceinline__ void operator()(const f32x4 (&acc)[2][2][4][2], const Unit& u, int wr, int wc, int fr, int fq) const {
        const int row0 = u.pm * BM + wr * 64 + fr, pn = u.pn;
        if (pn < 28) {
            bf16_t* base; int ld, colt;
            if (pn < 12) { base = pgdn; ld = 3072; colt = pn * 256; }
            else if (pn < 16) { base = pz; ld = 1024; colt = (pn - 12) * 256; }
            else { base = phy; ld = 3072; colt = (pn - 16) * 256; }
            const int col0 = colt + wc * 32 + 8 * fq;
#pragma unroll
            for (int ai = 0; ai < 2; ++ai)
#pragma unroll
                for (int m = 0; m < 4; ++m) { bf16_t* rowp = base + (size_t)(row0 + ai * HALF + m * 16) * ld + col0;
#pragma unroll
                    for (int bj = 0; bj < 2; ++bj) { const f32x4 v0 = acc[ai][bj][m][0], v1 = acc[ai][bj][m][1];
                        u32x4 w; w.x = cvt_pk_bf16(v0[0], v0[1]); w.y = cvt_pk_bf16(v0[2], v0[3]); w.z = cvt_pk_bf16(v1[0], v1[1]); w.w = cvt_pk_bf16(v1[2], v1[3]);
                        *(u32x4*)(rowp + bj * HALF) = w; } }
        } else if (wc == 0) {
#pragma unroll
            for (int ai = 0; ai < 2; ++ai)
#pragma unroll
                for (int m = 0; m < 4; ++m) { float* rowp = gates + (size_t)(row0 + ai * HALF + m * 16) * 32 + 8 * fq;
                    *(f32x4*)(rowp) = acc[ai][0][m][0]; *(f32x4*)(rowp + 4) = acc[ai][0][m][1]; }
        }
    }
};
struct EpiSwiglu {
    static constexpr bool PERM = true, AFTER_DRAIN = false;
    bf16_t* O; int ldc;
    __device__ __forceinline__ void operator()(const f32x4 (&acc)[2][2][4][2], const Unit& u, int wr, int wc, int fr, int fq) const {
        const int row0 = u.pm * BM + wr * 64 + fr, col0 = u.pn * HALF + wc * 32 + 8 * fq;
#pragma unroll
        for (int ai = 0; ai < 2; ++ai)
#pragma unroll
            for (int m = 0; m < 4; ++m) { bf16_t* rowp = O + (size_t)(row0 + ai * HALF + m * 16) * ldc + col0;
                const f32x4 g0 = acc[ai][0][m][0], g1 = acc[ai][0][m][1], u0 = acc[ai][1][m][0], u1 = acc[ai][1][m][1];
                u32x4 w;
                w.x = cvt_pk_bf16(silu_f(g0[0]) * u0[0], silu_f(g0[1]) * u0[1]); w.y = cvt_pk_bf16(silu_f(g0[2]) * u0[2], silu_f(g0[3]) * u0[3]);
                w.z = cvt_pk_bf16(silu_f(g1[0]) * u1[0], silu_f(g1[1]) * u1[1]); w.w = cvt_pk_bf16(silu_f(g1[2]) * u1[2], silu_f(g1[3]) * u1[3]);
                *(u32x4*)(rowp) = w; }
    }
};

template <class Epi, class Sched, bool ALIGN_EPI = false, bool SP2 = false>
__device__ __forceinline__ void gemm_phase(PG8_LAS unsigned char* lds, const Gemm g, const Sched& S, const Epi& E) {
    const int tid = otid(), wid = __builtin_amdgcn_readfirstlane(tid >> 6), lane = tid & 63, wr = wid >> 2, wc = wid & 3, fr = lane & 15, fq = lane >> 4;
    const int K = g.K, nt = K / BK;
    unsigned voffA[2], voffB[2];
#pragma unroll
    for (int i = 0; i < 2; ++i) { int R, C; stage_rc(tid * 16 + i * 8192, R, C); const int Rb = Epi::PERM ? ((R & ~31) + perm32(R & 31)) : R;
        voffA[i] = (unsigned)(R * K + C) * 2u; voffB[i] = (unsigned)(Rb * K + C) * 2u; }
    const size_t kstep = (size_t)(BK * 2);
    const size_t hstep = (size_t)HALF * K * 2;
    const size_t tstep = 2 * hstep;
    const unsigned ldsw = (unsigned)wid * 1024u;
    const int aoff = lds_byte(wr * 64 + fr, fq * 8), boff = lds_byte(wc * 32 + fr, fq * 8);
#define PG8_SA(b, h) (((b) * 2 + (h)) * HTB)
#define PG8_SB(b, h) ((4 + (b) * 2 + (h)) * HTB)
#define PG8_STAGE(bufoff, gbase, voff) do { _Pragma("unroll") for (int _i = 0; _i < 2; ++_i) \
        __builtin_amdgcn_global_load_lds((const unsigned*)((const char*)(gbase) + (voff)[_i]), (PG8_LAS unsigned*)(lds + (bufoff) + ldsw + _i * 8192), 16, 0, 0); } while (0)
#define PG8_LDA(dst, b, h) do { _Pragma("unroll") for (int m = 0; m < 4; ++m) _Pragma("unroll") for (int k = 0; k < 2; ++k) dst[m][k] = *(const PG8_LAS bf16x8*)(lds + PG8_SA(b, h) + aoff + m * 2048 + k * 1024); } while (0)
#define PG8_LDB(dst, b, h) do { _Pragma("unroll") for (int n = 0; n < 2; ++n) _Pragma("unroll") for (int k = 0; k < 2; ++k) dst[n][k] = *(const PG8_LAS bf16x8*)(lds + PG8_SB(b, h) + boff + n * 2048 + k * 1024); } while (0)
#define PG8_MMA(ai, bj, At, Bt) do { __builtin_amdgcn_s_setprio(1); _Pragma("unroll") for (int m = 0; m < 4; ++m) _Pragma("unroll") for (int n = 0; n < 2; ++n) _Pragma("unroll") for (int k = 0; k < 2; ++k) \
        acc[ai][bj][m][n] = __builtin_amdgcn_mfma_f32_16x16x32_bf16(Bt[n][k], At[m][k], acc[ai][bj][m][n], 0, 0, 0); __builtin_amdgcn_s_setprio(0); } while (0)
#define PG8_WAIT_V(n) asm volatile("s_waitcnt vmcnt(" #n ")" ::: "memory")
#define PG8_WAIT_L(n) asm volatile("s_waitcnt lgkmcnt(" #n ")" ::: "memory")
#define PG8_BAR __builtin_amdgcn_s_barrier()
#define PG8_SCHED __builtin_amdgcn_sched_barrier(0)
    Unit cur, nxt; int ui = 0;
    if (!S.next(0, cur)) return;
    f32x4 acc[2][2][4][2];
#pragma unroll
    for (int a = 0; a < 2; ++a)
#pragma unroll
        for (int b = 0; b < 2; ++b)
#pragma unroll
            for (int m = 0; m < 4; ++m)
#pragma unroll
                for (int n = 0; n < 2; ++n) acc[a][b][m][n] = (f32x4){0.f, 0.f, 0.f, 0.f};
    bf16x8 At[4][2], B0[2][2], B1[2][2];
    const char* cA = (const char*)g.A + (size_t)cur.pm * tstep; const char* cB = (const char*)g.Bt + (size_t)cur.pn * tstep;
    S.a_ready(cur);
    if constexpr (SP2) {
        PG8_STAGE(PG8_SB(0, 0), cB, voffB); PG8_STAGE(PG8_SB(0, 1), cB + hstep, voffB); PG8_STAGE(PG8_SA(0, 0), cA, voffA); PG8_STAGE(PG8_SA(0, 1), cA + hstep, voffA);
        if (wr == 1) PG8_BAR;
        PG8_WAIT_V(2); PG8_BAR;
        PG8_STAGE(PG8_SB(1, 0), cB + kstep, voffB); PG8_STAGE(PG8_SA(1, 0), cA + kstep, voffA); PG8_STAGE(PG8_SB(1, 1), cB + hstep + kstep, voffB);
        PG8_WAIT_V(6); PG8_BAR;
    } else {
        PG8_STAGE(PG8_SB(0, 0), cB, voffB); PG8_STAGE(PG8_SA(0, 0), cA, voffA); PG8_STAGE(PG8_SB(0, 1), cB + hstep, voffB); PG8_STAGE(PG8_SA(0, 1), cA + hstep, voffA);
        if (wr == 1) PG8_BAR;
        PG8_WAIT_V(4); PG8_BAR;
        PG8_STAGE(PG8_SB(1, 0), cB + kstep, voffB); PG8_STAGE(PG8_SA(1, 0), cA + kstep, voffA); PG8_STAGE(PG8_SB(1, 1), cB + hstep + kstep, voffB);
        PG8_WAIT_V(6); PG8_BAR;
    }
    for (;;) {
        const bool has_next = S.next(ui + 1, nxt);
        const char* nA = has_next ? (const char*)g.A + (size_t)nxt.pm * tstep : cA; const char* nB = has_next ? (const char*)g.Bt + (size_t)nxt.pn * tstep : cB;
        for (int t = 0; t < nt; t += 2) {
            const bool last = (t == nt - 2);
            const char* a1 = cA + (size_t)(t + 1) * kstep;
            const char* a2 = last ? nA : cA + (size_t)(t + 2) * kstep; const char* b2 = last ? nB : cB + (size_t)(t + 2) * kstep;
            const char* a3 = a2 + kstep; const char* b3 = b2 + kstep;
            if (last && has_next) S.a_ready(nxt);
            if constexpr (SP2) {
            PG8_LDB(B0, 0, 0); PG8_LDB(B1, 0, 1); PG8_SCHED; PG8_LDA(At, 0, 0); PG8_STAGE(PG8_SA(1, 1), a1 + hstep, voffA);
            PG8_WAIT_V(8); PG8_WAIT_L(0); PG8_BAR; PG8_MMA(0, 0, At, B0); PG8_MMA(0, 1, At, B1); PG8_BAR; PG8_SCHED;
            PG8_LDA(At, 0, 1); PG8_STAGE(PG8_SB(0, 0), b2, voffB); PG8_STAGE(PG8_SB(0, 1), b2 + hstep, voffB); PG8_STAGE(PG8_SA(0, 0), a2, voffA);
            PG8_WAIT_V(8); PG8_WAIT_L(0); PG8_BAR; PG8_MMA(1, 0, At, B0); PG8_MMA(1, 1, At, B1); PG8_BAR; PG8_SCHED;
            PG8_LDB(B0, 1, 0); PG8_LDB(B1, 1, 1); PG8_SCHED; PG8_LDA(At, 1, 0); PG8_STAGE(PG8_SA(0, 1), a2 + hstep, voffA);
            PG8_WAIT_V(8); PG8_WAIT_L(0); PG8_BAR; PG8_MMA(0, 0, At, B0); PG8_MMA(0, 1, At, B1); PG8_BAR; PG8_SCHED;
            PG8_LDA(At, 1, 1); PG8_STAGE(PG8_SB(1, 0), b3, voffB); PG8_STAGE(PG8_SB(1, 1), b3 + hstep, voffB); PG8_STAGE(PG8_SA(1, 0), a3, voffA);
            PG8_WAIT_V(8); PG8_WAIT_L(0); PG8_BAR; PG8_MMA(1, 0, At, B0); PG8_MMA(1, 1, At, B1); PG8_BAR; PG8_SCHED;
            } else {
            PG8_LDB(B0, 0, 0); PG8_SCHED; PG8_LDA(At, 0, 0); PG8_STAGE(PG8_SA(1, 1), a1 + hstep, voffA);
            PG8_WAIT_L(8); PG8_BAR; PG8_WAIT_L(0); PG8_MMA(0, 0, At, B0); PG8_BAR; PG8_SCHED;
            PG8_LDB(B1, 0, 1); PG8_STAGE(PG8_SB(0, 0), b2, voffB);
            PG8_BAR; PG8_WAIT_L(0); PG8_MMA(0, 1, At, B1); PG8_BAR;
            PG8_LDA(At, 0, 1); PG8_STAGE(PG8_SA(0, 0), a2, voffA);
            PG8_BAR; PG8_WAIT_L(0); PG8_MMA(1, 0, At, B0); PG8_BAR; PG8_SCHED;
            PG8_STAGE(PG8_SB(0, 1), b2 + hstep, voffB);
            PG8_WAIT_V(6); PG8_BAR; PG8_MMA(1, 1, At, B1); PG8_BAR;
            PG8_LDB(B0, 1, 0); PG8_SCHED; PG8_LDA(At, 1, 0); PG8_STAGE(PG8_SA(0, 1), a2 + hstep, voffA);
            PG8_WAIT_L(8); PG8_BAR; PG8_WAIT_L(0); PG8_MMA(0, 0, At, B0); PG8_BAR; PG8_SCHED;
            PG8_LDB(B1, 1, 1); PG8_STAGE(PG8_SB(1, 0), b3, voffB);
            PG8_BAR; PG8_WAIT_L(0); PG8_MMA(0, 1, At, B1); PG8_BAR;
            PG8_LDA(At, 1, 1); PG8_STAGE(PG8_SA(1, 0), a3, voffA);
            PG8_BAR; PG8_WAIT_L(0); PG8_MMA(1, 0, At, B0); PG8_BAR; PG8_SCHED;
            PG8_STAGE(PG8_SB(1, 1), b3 + hstep, voffB);
            PG8_WAIT_V(6); PG8_BAR; PG8_MMA(1, 1, At, B1); PG8_BAR;
            }
        }
        if constexpr (ALIGN_EPI) { if (wr == 0) PG8_BAR; }
        if constexpr (!Epi::AFTER_DRAIN) { E(acc, cur, wr, wc, fr, fq); S.done(cur); }
        if (!has_next) break;
#pragma unroll
        for (int a = 0; a < 2; ++a)
#pragma unroll
            for (int b = 0; b < 2; ++b)
#pragma unroll
                for (int m = 0; m < 4; ++m)
#pragma unroll
                    for (int n = 0; n < 2; ++n) acc[a][b][m][n] = (f32x4){0.f, 0.f, 0.f, 0.f};
        cur = nxt; cA = nA; cB = nB; ++ui;
        if constexpr (ALIGN_EPI) { if (wr == 1) PG8_BAR; }
    }
    PG8_WAIT_V(0);
    if constexpr (!ALIGN_EPI) { if (wr == 0) PG8_BAR; }
    PG8_BAR;
    if constexpr (Epi::AFTER_DRAIN) { E.fused(acc, cur, wr, wc, fr, fq, lds, wid, lane); S.done(cur); }
#undef PG8_SA
#undef PG8_SB
#undef PG8_STAGE
#undef PG8_LDA
#undef PG8_LDB
#undef PG8_MMA
#undef PG8_WAIT_V
#undef PG8_WAIT_L
#undef PG8_BAR
#undef PG8_SCHED
}
}

typedef unsigned short bf16_t;
typedef short bf16x8 __attribute__((ext_vector_type(8)));
typedef float f32x4 __attribute__((ext_vector_type(4)));
constexpr int NT = 512;
constexpr int DM = 2048, NB = 4, SL = 8192, CL = 256, MLAT = NB * SL, MCTX = NB * CL, MALL = MLAT + MCTX;
constexpr int NHD = 8, HD = 128, CHK = 64, DFF = 5632, N1 = 7424;
constexpr int NCHUNK = 132;
constexpr int NITEM = NB * NCHUNK * NHD;
constexpr float EPSF = 1e-6f;
constexpr int LDS_BYTES = 156 * 1024;

constexpr size_t al256(size_t x) { return (x + 255) & ~(size_t)255; }
constexpr size_t OFF_MOD = 0;
constexpr size_t OFF_GSC = OFF_MOD + al256((size_t)5 * 6 * DM * 4);
constexpr size_t OFF_GATES = OFF_GSC + al256((size_t)NITEM * 2 * 192 * 4);
constexpr size_t OFF_WIN = OFF_GATES + al256((size_t)MALL * 32 * 4);
constexpr size_t OFF_WOUT = OFF_WIN + al256((size_t)N1 * DM * 2);
constexpr size_t OFF_WGU = OFF_WOUT + al256((size_t)DM * DM * 2);
constexpr size_t OFF_WDOWN = OFF_WGU + al256((size_t)2 * DFF * DM * 2);
constexpr size_t OFF_H = OFF_WDOWN + al256((size_t)DM * DFF * 2);
constexpr size_t OFF_PGDN = OFF_H + al256((size_t)MALL * DM * 2);
constexpr size_t OFF_PZ = OFF_PGDN + al256((size_t)MALL * 3072 * 2);
constexpr size_t OFF_PHY = OFF_PZ + al256((size_t)MALL * 1024 * 2);
constexpr size_t OFF_UHT = OFF_PHY + al256((size_t)MALL * 3072 * 2);
constexpr size_t OFF_TAPS = OFF_UHT + al256((size_t)NB * 1024 * SL * 4);
constexpr size_t END_TAPS = OFF_TAPS + al256((size_t)1024 * 16384 * 4);
constexpr size_t OFF_KSPEC = END_TAPS;
constexpr size_t OFF_KT = OFF_PHY;
constexpr size_t OFF_Q = OFF_KT + (size_t)NITEM * 16384;
constexpr size_t OFF_UW = OFF_Q + (size_t)NITEM * 16384;
constexpr size_t OFF_ATT = OFF_UW + (size_t)NITEM * 2 * 32768;
constexpr size_t END_G2 = OFF_ATT + (size_t)NITEM * 2 * 8192;
constexpr size_t WS_END = END_G2 > END_TAPS ? END_G2 : END_TAPS;
constexpr size_t OFF_S1B = OFF_UHT;
constexpr size_t OFF_OF = OFF_PGDN;
constexpr size_t OFF_OB = OFF_PGDN + (size_t)MLAT * 1024 * 2;
constexpr size_t OFF_OUT = OFF_PGDN;
constexpr size_t OFF_ACT = OFF_PGDN;
constexpr size_t OFF_FF = OFF_H;
static_assert((size_t)MLAT * DFF * 2 <= OFF_UHT - OFF_PGDN, "act overlay");
constexpr size_t OFF_BAR = al256(WS_END);
constexpr size_t WS_TOTAL = OFF_BAR + 16384;
static_assert(WS_TOTAL <= ((size_t)1 << 30), "workspace over 1 GiB");

struct Params { const float* in[32]; float* out; unsigned char* ws; int ph_lo, ph_hi; };

__device__ __forceinline__ float bf_lo(unsigned w) { return __uint_as_float(w << 16); }
__device__ __forceinline__ float bf_hi(unsigned w) { return __uint_as_float(w & 0xffff0000u); }
__device__ __forceinline__ float bf2f(bf16_t v) { return __uint_as_float(((unsigned)v) << 16); }
__device__ __forceinline__ unsigned pk2(float lo, float hi) { return pg8::cvt_pk_bf16(lo, hi); }
__device__ __forceinline__ unsigned pk2_c(float lo, float hi) { unsigned a = __float_as_uint(lo), b = __float_as_uint(hi);
    a += 0x7fffu + ((a >> 16) & 1u); b += 0x7fffu + ((b >> 16) & 1u); return (a >> 16) | (b & 0xffff0000u); }
__device__ __forceinline__ bf16_t f2bf(float f) { return (bf16_t)(pk2(f, 0.f) & 0xffffu); }
__device__ __forceinline__ float silu(float x) { return x * __builtin_amdgcn_rcpf(1.0f + __expf(-x)); }
__device__ __forceinline__ void unpack8(const uint4 w, float (&f)[8]) {
    f[0] = bf_lo(w.x); f[1] = bf_hi(w.x); f[2] = bf_lo(w.y); f[3] = bf_hi(w.y); f[4] = bf_lo(w.z); f[5] = bf_hi(w.z); f[6] = bf_lo(w.w); f[7] = bf_hi(w.w);
}
__device__ __forceinline__ uint4 pack8(const float (&f)[8]) { uint4 w; w.x = pk2(f[0], f[1]); w.y = pk2(f[2], f[3]); w.z = pk2(f[4], f[5]); w.w = pk2(f[6], f[7]); return w; }
__device__ __forceinline__ float fsin(float x) { return __builtin_amdgcn_sinf(__builtin_amdgcn_fractf(x * 0.15915494309189535f)); }
__device__ __forceinline__ float wave_sum(float v) {
#pragma unroll
    for (int o = 32; o >= 1; o >>= 1) v += __shfl_xor(v, o);
    return v;
}

__device__ __forceinline__ void adaln_block(const Params& p, unsigned char* lds, int cb) {
    float* sc = (float*)lds;
    float* red = (float*)(lds + 5 * DM * 4);
    const int tid = otid();
    const float* c = p.in[1]; const float* cc = p.in[3]; const float* wm = p.in[4]; const float* bm = p.in[5];
    for (int i = tid; i < 5 * DM; i += NT) { const int r = i / DM, k = i % DM; const float v = r < 4 ? c[r * DM + k] : cc[k]; sc[i] = silu(v); }
    __syncthreads();
    const int l4 = tid % 12, kg = tid / 12;
    if (tid < 504) {
        float acc[5][4];
#pragma unroll
        for (int r = 0; r < 5; ++r)
#pragma unroll
            for (int j = 0; j < 4; ++j) acc[r][j] = 0.f;
#pragma unroll 7
        for (int k = kg; k < DM; k += 42) {
            const float4 w = *(const float4*)(wm + (size_t)k * (6 * DM) + cb * 48 + l4 * 4);
#pragma unroll
            for (int r = 0; r < 5; ++r) { const float s = sc[r * DM + k]; acc[r][0] += s * w.x; acc[r][1] += s * w.y; acc[r][2] += s * w.z; acc[r][3] += s * w.w; }
        }
#pragma unroll
        for (int r = 0; r < 5; ++r)
#pragma unroll
            for (int j = 0; j < 4; ++j) red[(kg * 5 + r) * 48 + l4 * 4 + j] = acc[r][j];
    }
    __syncthreads();
    if (tid < 240) {
        const int r = tid / 48, col = tid % 48; float s = 0.f;
        for (int g = 0; g < 42; ++g) s += red[(g * 5 + r) * 48 + col];
        float* MOD = (float*)(p.ws + OFF_MOD);
        MOD[r * (6 * DM) + cb * 48 + col] = s + bm[cb * 48 + col];
    }
    __syncthreads();
}

__device__ __forceinline__ void taps_block(const Params& p, unsigned char* lds, int tile) {
    float* zs = (float*)lds;
    float* h1 = zs + 32 * 33;
    float* h2 = h1 + 32 * 65;
    float* h3 = h2 + 32 * 65;
    float* w4s = (float*)(lds + 32768);
    const int tid = otid(), t0 = tile * 32;
    const float* w1 = p.in[17]; const float* b1 = p.in[18]; const float* f1 = p.in[19];
    const float* w2 = p.in[20]; const float* b2 = p.in[21]; const float* f2 = p.in[22];
    const float* w3 = p.in[23]; const float* b3 = p.in[24]; const float* f3 = p.in[25];
    const float* w4 = p.in[26]; const float* hb = p.in[27];
    float* ws1 = w4s; float* ws2 = w4s + 2112; float* ws3 = ws2 + 4096;
    for (int i = tid; i < 2112 / 4; i += NT) *(float4*)(ws1 + 4 * i) = *(const float4*)(w1 + 4 * i);
    for (int i = tid; i < 1024; i += NT) { *(float4*)(ws2 + 4 * i) = *(const float4*)(w2 + 4 * i); *(float4*)(ws3 + 4 * i) = *(const float4*)(w3 + 4 * i); }
    for (int i = tid; i < 32 * 33; i += NT) {
        const int r = i / 33, f = i % 33; const float t = (float)(t0 + r);
        float v;
        if (f == 0) v = t / 8191.0f;
        else { const int bi = (f - 1) & 15; const float fr = 1e-4f + (float)bi * ((15.0f - 1e-4f) / 15.0f); const float rev = t * fr * (1.0f / 8192.0f);
            v = (f <= 16) ? __builtin_amdgcn_cosf(__builtin_amdgcn_fractf(rev)) : -__builtin_amdgcn_sinf(__builtin_amdgcn_fractf(rev)); }
        zs[i] = v;
    }
    __syncthreads();
    const int row = tid & 31, ug = tid >> 5;
    {   float a[4] = {0.f, 0.f, 0.f, 0.f};
#pragma unroll 3
        for (int k = 0; k < 33; ++k) { const float z = zs[row * 33 + k]; const float4 w = *(const float4*)(ws1 + k * 64 + ug * 4); a[0] += z * w.x; a[1] += z * w.y; a[2] += z * w.z; a[3] += z * w.w; }
#pragma unroll
        for (int j = 0; j < 4; ++j) h1[row * 65 + ug * 4 + j] = fsin(f1[ug * 4 + j] * (a[j] + b1[ug * 4 + j]));
    }
    __syncthreads();
    {   float a[4] = {0.f, 0.f, 0.f, 0.f};
#pragma unroll 4
        for (int k = 0; k < 64; ++k) { const float z = h1[row * 65 + k]; const float4 w = *(const float4*)(ws2 + k * 64 + ug * 4); a[0] += z * w.x; a[1] += z * w.y; a[2] += z * w.z; a[3] += z * w.w; }
#pragma unroll
        for (int j = 0; j < 4; ++j) h2[row * 65 + ug * 4 + j] = fsin(f2[ug * 4 + j] * (a[j] + b2[ug * 4 + j]));
    }
    __syncthreads();
    {   float a[4] = {0.f, 0.f, 0.f, 0.f};
#pragma unroll 4
        for (int k = 0; k < 64; ++k) { const float z = h2[row * 65 + k]; const float4 w = *(const float4*)(ws3 + k * 64 + ug * 4); a[0] += z * w.x; a[1] += z * w.y; a[2] += z * w.z; a[3] += z * w.w; }
#pragma unroll
        for (int j = 0; j < 4; ++j) h3[row * 65 + ug * 4 + j] = fsin(f3[ug * 4 + j] * (a[j] + b3[ug * 4 + j]));
    }
    __syncthreads();
    bf16_t* Ah = (bf16_t*)(lds + 98304); bf16_t* Al = Ah + 32 * 72;
    {   float hv[4]; unsigned short hh[4], hl[4];
#pragma unroll
        for (int j = 0; j < 4; ++j) { hv[j] = h3[row * 65 + ug * 4 + j]; const unsigned u = pk2_c(hv[j], 0.f) & 0xffffu; hh[j] = (unsigned short)u; hl[j] = (unsigned short)(pk2_c(hv[j] - __uint_as_float(u << 16), 0.f) & 0xffffu); }
        uint2 wh, wl; wh.x = hh[0] | ((unsigned)hh[1] << 16); wh.y = hh[2] | ((unsigned)hh[3] << 16); wl.x = hl[0] | ((unsigned)hl[1] << 16); wl.y = hl[2] | ((unsigned)hl[3] << 16);
        *(uint2*)(Ah + row * 72 + ug * 4) = wh; *(uint2*)(Al + row * 72 + ug * 4) = wl; }
    float* TAPS = (float*)(p.ws + OFF_TAPS);
    const float mind = -3.0701134573253946f, maxd = -15.350567286626973f;
    const int lane = tid & 63, wid = __builtin_amdgcn_readfirstlane(tid >> 6), fr = lane & 15, fq = lane >> 4;
    for (int cc = 0; cc < 8; ++cc) {
        for (int i = tid; i < 64 * 64; i += NT) { const int k = i >> 6, c4 = (i & 63) * 4; *(float4*)(w4s + k * 256 + c4) = *(const float4*)(w4 + (size_t)k * 2048 + cc * 256 + c4); }
        __syncthreads();
#pragma unroll 1
        for (int nn = 0; nn < 2; ++nn) {
            const int nt = wid * 2 + nn;
            f32x4 acc[2]; acc[0] = (f32x4){0.f, 0.f, 0.f, 0.f}; acc[1] = (f32x4){0.f, 0.f, 0.f, 0.f};
#pragma unroll
            for (int ks = 0; ks < 2; ++ks) {
                bf16x8 bh, bl;
#pragma unroll
                for (int e = 0; e < 8; ++e) { const float x = w4s[(32 * ks + 8 * fq + e) * 256 + 16 * nt + fr]; const unsigned u = pk2_c(x, 0.f) & 0xffffu;
                    bh[e] = (short)u; bl[e] = (short)(pk2_c(x - __uint_as_float(u << 16), 0.f) & 0xffffu); }
#pragma unroll
                for (int mt = 0; mt < 2; ++mt) {
                    const bf16x8 ah = *(const bf16x8*)(Ah + (16 * mt + fr) * 72 + 32 * ks + 8 * fq), al = *(const bf16x8*)(Al + (16 * mt + fr) * 72 + 32 * ks + 8 * fq);
                    acc[mt] = __builtin_amdgcn_mfma_f32_16x16x32_bf16(ah, bh, acc[mt], 0, 0, 0);
                    acc[mt] = __builtin_amdgcn_mfma_f32_16x16x32_bf16(ah, bl, acc[mt], 0, 0, 0);
                    acc[mt] = __builtin_amdgcn_mfma_f32_16x16x32_bf16(al, bh, acc[mt], 0, 0, 0);
                }
            }
            const int c2 = cc * 256 + 16 * nt + fr, c = c2 & 1023;
            const float delta = fabsf(mind + (float)c * ((maxd - mind) / 1023.0f));
#pragma unroll
            for (int mt = 0; mt < 2; ++mt)
#pragma unroll
                for (int r = 0; r < 4; ++r) {
                    const int t = t0 + 16 * mt + 4 * fq + r; const float t01 = (float)t / 8191.0f;
                    float v = acc[mt][r] * __expf(-t01 * delta);
                    if (c2 < 1024) { if (t == 0) v += hb[c]; TAPS[(size_t)c * 16384 + t] = v; }
                    else { if (t == 0) TAPS[(size_t)c * 16384 + 8192] = 0.f; else TAPS[(size_t)c * 16384 + 16384 - t] = v; }
                }
        }
        __syncthreads();
    }
}

struct TDesc { const float* src; bf16_t* dst; int srcN, scol, K, kt, nt; };
__device__ __forceinline__ void transpose_decode(const Params& p, int idx, int tid, TDesc& d) {
    int mode, nK;
    if (idx < 928) { mode = 0; nK = 8; } else if (idx < 1184) { mode = 1; nK = 8; idx -= 928; } else if (idx < 2592) { mode = 2; nK = 8; idx -= 1184; } else { mode = 3; nK = 22; idx -= 2592; }
    d.kt = idx % nK; d.nt = idx / nK; d.K = (mode == 3) ? DFF : DM;
    d.dst = (bf16_t*)(p.ws + (mode == 0 ? OFF_WIN : mode == 1 ? OFF_WOUT : mode == 2 ? OFF_WGU : OFF_WDOWN));
    const int nc = (tid & 15) * 4, n = d.nt * 64 + nc;
    if (mode == 0) { d.src = p.in[10]; d.srcN = 7200; d.scol = (n < 3072) ? n : (n < 7168) ? n + 32 : (n < 7200) ? n - 4096 : -1; }
    else if (mode == 1) { d.src = p.in[28]; d.srcN = DM; d.scol = n; }
    else if (mode == 2) { const int pn = n >> 8, w = n & 255; d.src = (w < 128) ? p.in[29] : p.in[30]; d.srcN = DFF; d.scol = pn * 128 + (w & 127); }
    else { d.src = p.in[31]; d.srcN = DM; d.scol = n; }
}
__device__ __forceinline__ void transpose_load(const TDesc& d, int tid, float4 (&v)[8]) {
    const int kr = tid >> 4;
#pragma unroll
    for (int it = 0; it < 8; ++it) { v[it] = make_float4(0.f, 0.f, 0.f, 0.f); if (d.scol >= 0) v[it] = *(const float4*)(d.src + (size_t)(d.kt * 256 + kr + it * 32) * d.srcN + d.scol); }
}
__device__ __forceinline__ void transpose_store(const TDesc& d, int tid, const float4 (&v)[8], float* tile  ) {
    const int kr = tid >> 4, nc = (tid & 15) * 4;
#pragma unroll
    for (int it = 0; it < 8; ++it) { float* tp = tile + (kr + it * 32) * 65 + nc; tp[0] = v[it].x; tp[1] = v[it].y; tp[2] = v[it].z; tp[3] = v[it].w; }
    __syncthreads();
    {   const int nn = tid >> 3, k8 = (tid & 7) * 8;
#pragma unroll
        for (int w = 0; w < 4; ++w) { float f[8];
#pragma unroll
            for (int j = 0; j < 8; ++j) f[j] = tile[(k8 + 64 * w + j) * 65 + nn];
            *(uint4*)(d.dst + (size_t)(d.nt * 64 + nn) * d.K + d.kt * 256 + k8 + 64 * w) = pack8(f); }
    }
    __syncthreads();
}

__device__ __forceinline__ void phase_prologue(const Params& p, unsigned char* lds) {
    const int G = gridDim.x, bx = blockIdx.x;
#ifndef P0_MASK
#define P0_MASK 7
#endif
    if (P0_MASK & 1) for (int cb = bx; cb < 256; cb += G) adaln_block(p, lds, cb);
    if (P0_MASK & 2) for (int t = bx; t < 256; t += G) taps_block(p, lds, t);
    if (P0_MASK & 4) {
        const int tid = otid(); float4 v[8], vn[8]; TDesc d, dn; int i = bx;
        if (i < 3296) { transpose_decode(p, i, tid, d); transpose_load(d, tid, v); }
        for (; i < 3296; i += G) {
            if (i + G < 3296) { transpose_decode(p, i + G, tid, dn); transpose_load(dn, tid, vn); }
            transpose_store(d, tid, v, (float*)lds);
            d = dn;
#pragma unroll
            for (int it = 0; it < 8; ++it) v[it] = vn[it];
        }
    }
}

__device__ __forceinline__ void phase_prenorm(const Params& p) {
    const int tid_ = otid(), lane = tid_ & 63, wv = __builtin_amdgcn_readfirstlane(tid_ >> 6);
    const float* MOD = (const float*)(p.ws + OFF_MOD); const float* g = p.in[6];
    bf16_t* H = (bf16_t*)(p.ws + OFF_H);
    const int stride = gridDim.x * 8;
    float4 v[8], vn[8];
#define PRE_SRC(row_) ((row_) < MLAT ? p.in[0] + (size_t)(row_) * DM : p.in[2] + (size_t)((row_) - MLAT) * DM)
    int row = blockIdx.x * 8 + wv;
    if (row < MALL) { const float* src = PRE_SRC(row);
#pragma unroll
        for (int i = 0; i < 8; ++i) v[i] = *(const float4*)(src + 4 * (lane + 64 * i)); }
    for (; row < MALL; row += stride) {
        const int nxt = row + stride;
        if (nxt < MALL) { const float* src = PRE_SRC(nxt);
#pragma unroll
            for (int i = 0; i < 8; ++i) vn[i] = *(const float4*)(src + 4 * (lane + 64 * i)); }
        const int r = row < MLAT ? (row >> 13) : 4;
        const float* sh = MOD + r * (6 * DM); const float* sc = sh + DM;
        float ss = 0.f;
#pragma unroll
        for (int i = 0; i < 8; ++i) ss += v[i].x * v[i].x + v[i].y * v[i].y + v[i].z * v[i].z + v[i].w * v[i].w;
        ss = wave_sum(ss);
        const float rstd = rsqrtf(ss * (1.0f / DM) + EPSF);
#pragma unroll
        for (int i = 0; i < 8; ++i) { const int col = 4 * (lane + 64 * i);
            const float4 gg = *(const float4*)(g + col), s1 = *(const float4*)(sc + col), s0 = *(const float4*)(sh + col);
            uint2 w; w.x = pk2(v[i].x * rstd * gg.x * (1.f + s1.x) + s0.x, v[i].y * rstd * gg.y * (1.f + s1.y) + s0.y);
            w.y = pk2(v[i].z * rstd * gg.z * (1.f + s1.z) + s0.z, v[i].w * rstd * gg.w * (1.f + s1.w) + s0.w);
            *(uint2*)(H + (size_t)row * DM + col) = w; }
#pragma unroll
        for (int i = 0; i < 8; ++i) v[i] = vn[i];
    }
#undef PRE_SRC
}

__device__ __forceinline__ void phase_hy1(const Params& p, unsigned char* lds) {
    float* tile = (float*)lds;
    const int tid = otid();
    const bf16_t* PHY = (const bf16_t*)(p.ws + OFF_PHY); bf16_t* MIX = (bf16_t*)(p.ws + OFF_H); bf16_t* UHT = (bf16_t*)(p.ws + OFF_UHT);
    const float* cw = p.in[15]; const float* cb = p.in[16];
    const bool g16 = (gridDim.x & 15) == 0;
    const int c8 = (tid & 7) * 8, tr = tid >> 3;
    float wr[3][3][8], br[3][8]; int ct_loaded = -1; uint4 raw[3][3], rawn[3][3];
    for (int k = 0;; ++k) {
        int ct, tt;
        if (g16) { ct = blockIdx.x & 15; tt = (int)(blockIdx.x >> 4) + k * (int)(gridDim.x >> 4); if (tt >= 512) break; }
        else { const int tl = blockIdx.x + k * gridDim.x; if (tl >= 512 * 16) break; ct = tl & 15; tt = tl >> 4; }
        const int c0 = ct * 64, row0 = tt * 64;
        if (ct != ct_loaded) { ct_loaded = ct;
#pragma unroll
            for (int gI = 0; gI < 3; ++gI) { const int col = gI * 1024 + c0 + c8;
#pragma unroll
                for (int j = 0; j < 8; ++j) br[gI][j] = cb[col + j];
#pragma unroll
                for (int i = 0; i < 3; ++i)
#pragma unroll
                    for (int j = 0; j < 8; ++j) wr[gI][i][j] = cw[i * 3072 + col + j]; } }
        const int row = row0 + tr, tpos = row & (SL - 1);
        if (k == 0) {
#pragma unroll
            for (int gI = 0; gI < 3; ++gI)
#pragma unroll
                for (int i = 0; i < 3; ++i) { int tp = tpos + i - 1; tp = tp < 0 ? 0 : (tp >= SL ? SL - 1 : tp);
                    raw[gI][i] = *(const uint4*)(PHY + (size_t)(row - tpos + tp) * 3072 + gI * 1024 + c0 + c8); }
        }
        {
            int ctn, ttn; bool have;
            if (g16) { ctn = ct; ttn = tt + (int)(gridDim.x >> 4); have = ttn < 512; } else { const int tl = blockIdx.x + (k + 1) * gridDim.x; have = tl < 512 * 16; ctn = tl & 15; ttn = tl >> 4; }
            if (have) { const int rown = ttn * 64 + tr, tposn = rown & (SL - 1);
#pragma unroll
                for (int gI = 0; gI < 3; ++gI)
#pragma unroll
                    for (int i = 0; i < 3; ++i) { int tp = tposn + i - 1; tp = tp < 0 ? 0 : (tp >= SL ? SL - 1 : tp);
                        rawn[gI][i] = *(const uint4*)(PHY + (size_t)(rown - tposn + tp) * 3072 + gI * 1024 + ctn * 64 + c8); } }
        }
        float res[3][8];
#pragma unroll
        for (int gI = 0; gI < 3; ++gI) {
            float a[8];
#pragma unroll
            for (int j = 0; j < 8; ++j) a[j] = br[gI][j];
#pragma unroll
            for (int i = 0; i < 3; ++i) {
                const int tp = tpos + i - 1; const float msk = (tp >= 0 && tp < SL) ? 1.0f : 0.0f;
                float f[8]; unpack8(raw[gI][i], f);
#pragma unroll
                for (int j = 0; j < 8; ++j) a[j] += (wr[gI][i][j] * msk) * f[j];
            }
#pragma unroll
            for (int j = 0; j < 8; ++j) res[gI][j] = a[j];
        }
#pragma unroll
        for (int gI = 0; gI < 3; ++gI)
#pragma unroll
            for (int i = 0; i < 3; ++i) raw[gI][i] = rawn[gI][i];
        *(uint4*)(MIX + (size_t)row * DM + 1024 + c0 + c8) = pack8(res[0]);
#pragma unroll
        for (int j = 0; j < 8; ++j) tile[(c8 + j) * 65 + tr] = res[1][j] * res[2][j];
        __syncthreads();
        {   const int c = tid >> 3, t8 = (tid & 7) * 8; const int b = row0 >> 13, tb = (row0 & (SL - 1)) + t8;
            bf16_t* dp = UHT + ((size_t)(b * 1024 + c0 + c)) * SL + tb; float f[8];
#pragma unroll
            for (int j = 0; j < 8; ++j) f[j] = tile[c * 65 + t8 + j];
            *(uint4*)dp = pack8(f); }
        __syncthreads();
    }
}

__device__ __forceinline__ void phase_hy3(const Params& p, unsigned char* lds) {
    float* tile = (float*)lds;
    const int tid = otid();
    bf16_t* MIX = (bf16_t*)(p.ws + OFF_H); const bf16_t* UHT = (const bf16_t*)(p.ws + OFF_UHT);
    const int c = tid >> 3, t8 = (tid & 7) * 8, tr = tid >> 3, c8 = (tid & 7) * 8;
    uint4 uy, um, ny, nm;
#define HY3_LOAD(tl_, y_, m_) do { const int ct_ = (tl_) & 15, tt_ = (tl_) >> 4, c0_ = ct_ * 64, row0_ = tt_ * 64; const int b_ = row0_ >> 13, tb_ = (row0_ & (SL - 1)) + t8; \
        y_ = *(const uint4*)(UHT + ((size_t)(b_ * 1024 + c0_ + c)) * SL + tb_); m_ = *(const uint4*)(MIX + (size_t)(row0_ + tr) * DM + 1024 + c0_ + c8); } while (0)
    int tl = blockIdx.x;
    if (tl < 512 * 16) HY3_LOAD(tl, uy, um);
    for (; tl < 512 * 16; tl += gridDim.x) {
        const int ct = tl & 15, tt = tl >> 4, c0 = ct * 64, row0 = tt * 64;
        if (tl + (int)gridDim.x < 512 * 16) HY3_LOAD(tl + (int)gridDim.x, ny, nm);
        {   float f[8]; unpack8(uy, f); float* tp = tile + c * 65 + t8;
#pragma unroll
            for (int j = 0; j < 8; ++j) tp[j] = f[j]; }
        __syncthreads();
        {   bf16_t* mp = MIX + (size_t)(row0 + tr) * DM + 1024 + c0 + c8;
            float f[8]; unpack8(um, f);
#pragma unroll
            for (int j = 0; j < 8; ++j) f[j] *= tile[(c8 + j) * 65 + tr];
            *(uint4*)mp = pack8(f); }
        __syncthreads();
        uy = ny; um = nm;
    }
#undef HY3_LOAD
}


__device__ __forceinline__ float2 cmul(float2 a, float2 b) { return make_float2(a.x * b.x - a.y * b.y, a.x * b.y + a.y * b.x); }
__device__ __forceinline__ int pidx(int i) { return i + ((i >> 6) << 2); }
template <bool INV> __device__ __forceinline__ float2 mulw16(float2 d, int m) {
    const float C1 = 0.9238795325112867f, S1 = 0.3826834323650898f, C2 = 0.7071067811865476f;
    float c, s;
    switch (m & 7) {
        case 0: return d;
        case 1: c = C1; s = S1; break;
        case 2: c = C2; s = C2; break;
        case 3: c = S1; s = C1; break;
        case 4: return INV ? make_float2(-d.y, d.x) : make_float2(d.y, -d.x);
        case 5: c = -S1; s = C1; break;
        case 6: c = -C2; s = C2; break;
        default: c = -C1; s = S1; break;
    }
    if (!INV) s = -s;
    return make_float2(d.x * c - d.y * s, d.x * s + d.y * c);
}
template <int R> __device__ __forceinline__ constexpr int brev(int q) { int r = 0; for (int b = 1, o = R >> 1; b < R; b <<= 1, o >>= 1) if (q & b) r |= o; return r; }
template <int R, int LOG, int S0 = 0> __device__ __forceinline__ void dft_fwd(float2 (&v)[R]) {
#pragma unroll
    for (int s = S0; s < LOG; ++s) {
        const int h = (R / 2) >> s;
#pragma unroll
        for (int j = 0; j < R; ++j) {
            if (j & h) continue;
            const int m = (j & (h - 1)) * (R / (2 * h)) * (16 / R);
            const float2 a = v[j], b = v[j + h];
            v[j] = make_float2(a.x + b.x, a.y + b.y);
            v[j + h] = mulw16<false>(make_float2(a.x - b.x, a.y - b.y), m);
        }
    }
}
template <int R, int LOG, int S0 = 0> __device__ __forceinline__ void dft_inv(float2 (&v)[R]) {
#pragma unroll
    for (int s = LOG - 1; s >= S0; --s) {
        const int h = (R / 2) >> s;
#pragma unroll
        for (int j = 0; j < R; ++j) {
            if (j & h) continue;
            const int m = (j & (h - 1)) * (R / (2 * h)) * (16 / R);
            const float2 a = v[j], b = mulw16<true>(v[j + h], m);
            v[j] = make_float2(a.x + b.x, a.y + b.y);
            v[j + h] = make_float2(a.x - b.x, a.y - b.y);
        }
    }
}
__device__ __forceinline__ void tw_powers(float2 w1, float2 (&w)[16]) {
    w[1] = w1; w[2] = cmul(w1, w1); w[3] = cmul(w[2], w1); w[4] = cmul(w[2], w[2]); w[5] = cmul(w[4], w1); w[6] = cmul(w[4], w[2]); w[7] = cmul(w[4], w[3]);
    w[8] = cmul(w[4], w[4]);
#pragma unroll
    for (int k = 1; k < 8; ++k) w[8 + k] = cmul(w[8], w[k]);
}
template <int n, bool INV, bool HALF = false, bool TW = false> __device__ __forceinline__ void fft_pass16(float2* X, int tid, const float2 (&wpre)[16]) {
    constexpr int st = n / 16, PST = (st >= 64) ? st + 4 * (st / 64) : st;
#pragma unroll 1
    for (int g = tid; g < 1024; g += NT) {
        int lo = g & (st - 1); asm volatile("" : "+v"(lo));
        const int blk = g / st, base = blk * n + lo;
        float2* Xp = X + pidx(base);
        float2 w[16];
        if (TW) {
#pragma unroll
            for (int k = 1; k < 16; ++k) w[k] = make_float2(wpre[k].x, INV ? -wpre[k].y : wpre[k].y);
        } else {   const float rev = (float)lo * (1.0f / n); const float c = __builtin_amdgcn_cosf(rev), s = __builtin_amdgcn_sinf(rev);
            tw_powers(make_float2(c, INV ? s : -s), w); }
        float2 v[16];
        if (!INV) {
            if (HALF) {
#pragma unroll
                for (int j = 0; j < 8; ++j) { v[j] = Xp[j * PST]; v[j + 8] = mulw16<false>(v[j], j); }
                dft_fwd<16, 4, 1>(v);
            } else {
#pragma unroll
                for (int j = 0; j < 16; ++j) v[j] = Xp[j * PST];
                dft_fwd<16, 4>(v);
            }
#pragma unroll
            for (int q = 1; q < 16; ++q) v[q] = cmul(v[q], w[brev<16>(q)]);
#pragma unroll
            for (int q = 0; q < 16; ++q) Xp[brev<16>(q) * PST] = v[q];
        } else {
#pragma unroll
            for (int q = 0; q < 16; ++q) { const int k = brev<16>(q); float2 t = Xp[k * PST]; if (k) t = cmul(t, w[k]); v[q] = t; }
            if (HALF) {
                dft_inv<16, 4, 1>(v);
#pragma unroll
                for (int j = 0; j < 8; ++j) { const float2 b = mulw16<true>(v[j + 8], j); Xp[j * PST] = make_float2(v[j].x + b.x, v[j].y + b.y); }
            } else {
                dft_inv<16, 4>(v);
#pragma unroll
                for (int j = 0; j < 16; ++j) Xp[j * PST] = v[j];
            }
        }
    }
}
__device__ __forceinline__ void phase_hy2(const Params& p, unsigned char* lds) {
    float2* X = (float2*)lds;
    const int tid = otid();
    const float* TAPS = (const float*)(p.ws + OFF_TAPS); bf16_t* UHT = (bf16_t*)(p.ws + OFF_UHT);
    float2 w64[16];
    {   const float r64 = (float)(tid & 3) * (1.0f / 64.0f);
        tw_powers(make_float2(__builtin_amdgcn_cosf(r64), -__builtin_amdgcn_sinf(r64)), w64); w64[0] = make_float2(1.f, 0.f); }
    for (int c = blockIdx.x; c < 1024; c += gridDim.x) {
        float4* KS = (float4*)(p.ws + OFF_KSPEC) + (size_t)blockIdx.x * 8192;
#pragma unroll
        for (int i = 0; i < 8; ++i) { const int t = 4 * (tid + NT * i); const float4 v = *(const float4*)(TAPS + (size_t)c * 16384 + t);
            float4* xp = (float4*)(X + pidx(t)); xp[0] = make_float4(v.x, 0.f, v.y, 0.f); xp[1] = make_float4(v.z, 0.f, v.w, 0.f); }
        __syncthreads();
        fft_pass16<16384, false, false, false>(X, tid, w64); __syncthreads();
        fft_pass16<1024, false, false, false>(X, tid, w64); __syncthreads();
        fft_pass16<64, false, false, true>(X, tid, w64); __syncthreads();
#pragma unroll 2
        for (int i = 0; i < 8; ++i) { const float4* xp = (const float4*)(X + pidx(4 * (tid + NT * i))); const float4 a = xp[0], b = xp[1];
            float2 v[4] = {make_float2(a.x, a.y), make_float2(a.z, a.w), make_float2(b.x, b.y), make_float2(b.z, b.w)};
            dft_fwd<4, 2>(v);
            const float sc = 1.0f / 16384.0f;
            KS[2 * (tid + NT * i)] = make_float4(v[0].x * sc, v[0].y * sc, v[1].x * sc, v[1].y * sc); KS[2 * (tid + NT * i) + 1] = make_float4(v[2].x * sc, v[2].y * sc, v[3].x * sc, v[3].y * sc); }
        __syncthreads();
        for (int pr = 0; pr < 2; ++pr) {
            bf16_t* u1 = UHT + ((size_t)((2 * pr) * 1024 + c)) * SL; bf16_t* u2 = UHT + ((size_t)((2 * pr + 1) * 1024 + c)) * SL;
#pragma unroll
            for (int i = 0; i < 4; ++i) { const int t = 4 * (tid + NT * i); const uint2 ua = *(const uint2*)(u1 + t), ub = *(const uint2*)(u2 + t);
                const float4 a = make_float4(bf_lo(ua.x), bf_hi(ua.x), bf_lo(ua.y), bf_hi(ua.y)), b = make_float4(bf_lo(ub.x), bf_hi(ub.x), bf_lo(ub.y), bf_hi(ub.y));
                float4* xp = (float4*)(X + pidx(t)); xp[0] = make_float4(a.x, b.x, a.y, b.y); xp[1] = make_float4(a.z, b.z, a.w, b.w); }
            __syncthreads();
            fft_pass16<16384, false, true, false>(X, tid, w64); __syncthreads();
            fft_pass16<1024, false, false, false>(X, tid, w64); __syncthreads();
            fft_pass16<64, false, false, true>(X, tid, w64); __syncthreads();
#pragma unroll 2
            for (int i = 0; i < 8; ++i) { float4* xp = (float4*)(X + pidx(4 * (tid + NT * i))); const float4 a = xp[0], b = xp[1];
                float2 v[4] = {make_float2(a.x, a.y), make_float2(a.z, a.w), make_float2(b.x, b.y), make_float2(b.z, b.w)};
                dft_fwd<4, 2>(v);
                const float4 k0 = KS[2 * (tid + NT * i)], k1 = KS[2 * (tid + NT * i) + 1];
                v[0] = cmul(v[0], make_float2(k0.x, k0.y)); v[1] = cmul(v[1], make_float2(k0.z, k0.w)); v[2] = cmul(v[2], make_float2(k1.x, k1.y)); v[3] = cmul(v[3], make_float2(k1.z, k1.w));
                dft_inv<4, 2>(v);
                xp[0] = make_float4(v[0].x, v[0].y, v[1].x, v[1].y); xp[1] = make_float4(v[2].x, v[2].y, v[3].x, v[3].y); }
            __syncthreads();
            fft_pass16<64, true, false, true>(X, tid, w64); __syncthreads();
            fft_pass16<1024, true, false, false>(X, tid, w64); __syncthreads();
            fft_pass16<16384, true, true, false>(X, tid, w64); __syncthreads();
#pragma unroll
            for (int i = 0; i < 4; ++i) { const int t = 4 * (tid + NT * i); const float4* xp = (const float4*)(X + pidx(t)); const float4 a = xp[0], b = xp[1];
                uint2 w1, w2; w1.x = pk2(a.x, a.z); w1.y = pk2(b.x, b.z); w2.x = pk2(a.y, a.w); w2.y = pk2(b.y, b.w);
                *(uint2*)(u1 + t) = w1; *(uint2*)(u2 + t) = w2; }
            __syncthreads();
        }
    }
}


__device__ __forceinline__ void item_decode(int item, int& b, int& n, int& h, int& row0, int& seq0, int& seqlen) {
    h = item & 7; const int cidx = item >> 3; b = cidx / NCHUNK; n = cidx % NCHUNK;
    if (n < 4) { seq0 = MLAT + b * CL; seqlen = CL; row0 = seq0 + n * CHK; } else { seq0 = b * SL; seqlen = SL; row0 = seq0 + (n - 4) * CHK; }
}
constexpr int G2X_A10 = 0, G2X_T11 = 5120, G2X_T00T = 10240, G2X_XT = 20480, G2X_BYTES = 30720;
template <int D> __device__ __forceinline__ void g2_tinv_diag(const float* As, int lane, const float* rsu, const float* rsw, bf16_t* TM, unsigned char* xl) {
    const int blk = lane >> 5, cc = lane & 31;
    int abase = D * 64 * 68 + blk * (32 * 68 + 32); asm volatile("" : "+v"(abase));
    const float* Ad = As + abase;
    {   const float* ap = As + D * 64 * 68 + cc * 68 + 32 + 16 * blk; bf16_t* a10 = (bf16_t*)(xl + G2X_A10) + D * 32 * 40;
#pragma unroll
        for (int q = 0; q < 4; ++q) { const float4 v = *(const float4*)(ap + 4 * q);
            a10[(16 * blk + 4 * q + 0) * 40 + cc] = f2bf(v.x); a10[(16 * blk + 4 * q + 1) * 40 + cc] = f2bf(v.y); a10[(16 * blk + 4 * q + 2) * 40 + cc] = f2bf(v.z); a10[(16 * blk + 4 * q + 3) * 40 + cc] = f2bf(v.w); } }
    float x[32];
#pragma unroll
    for (int i = 0; i < 32; ++i) x[i] = (i == cc) ? 1.0f : 0.0f;
#pragma clang loop unroll(full)
    for (int j = 0; j < 31; ++j) {
        const float xj = x[j];
        int zj = 0; asm volatile("" : "+v"(zj) : "v"(x[j > 0 ? j - 1 : 0])); zj &= ~3;
#pragma clang loop unroll(full)
        for (int i4 = ((j + 1) & ~3); i4 < 32; i4 += 4) {
            const float4 a = *(const float4*)(Ad + zj + j * 68 + i4);
            if (i4 > j) x[i4] -= a.x * xj;
            if (i4 + 1 > j) x[i4 + 1] -= a.y * xj;
            if (i4 + 2 > j) x[i4 + 2] -= a.z * xj;
            x[i4 + 3] -= a.w * xj;
        }
    }
    const int sj = 32 * blk + cc, jo = D ? 63 - sj : sj;
    const float su = rsu[D * 64 + jo], sw = rsw[D * 64 + jo];
    bf16_t* tu = TM + (D * 2 + 0) * 64 * 72 + jo; bf16_t* tw = TM + (D * 2 + 1) * 64 * 72 + jo;
#pragma unroll
    for (int ii = 0; ii < 32; ++ii) { const int si = 32 * blk + ii, io = D ? 63 - si : si; tu[io * 72] = f2bf(x[ii] * su); tw[io * 72] = f2bf(x[ii] * sw); }
    if (blk == 1) {
        bf16_t* t11 = (bf16_t*)(xl + G2X_T11) + D * 32 * 40 + cc;
#pragma unroll
        for (int ii = 0; ii < 32; ++ii) { const int io = D ? 63 - ii : ii; tu[io * 72] = 0; tw[io * 72] = 0; t11[ii * 40] = f2bf(x[ii]); }
    } else {
        bf16_t* t0u = (bf16_t*)(xl + G2X_T00T) + (D * 2 + 0) * 32 * 40 + cc * 40; bf16_t* t0w = (bf16_t*)(xl + G2X_T00T) + (D * 2 + 1) * 32 * 40 + cc * 40;
#pragma unroll
        for (int q = 0; q < 4; ++q) { uint4 wu, ww;
            wu.x = pk2(x[8 * q] * su, x[8 * q + 1] * su); wu.y = pk2(x[8 * q + 2] * su, x[8 * q + 3] * su); wu.z = pk2(x[8 * q + 4] * su, x[8 * q + 5] * su); wu.w = pk2(x[8 * q + 6] * su, x[8 * q + 7] * su);
            ww.x = pk2(x[8 * q] * sw, x[8 * q + 1] * sw); ww.y = pk2(x[8 * q + 2] * sw, x[8 * q + 3] * sw); ww.z = pk2(x[8 * q + 4] * sw, x[8 * q + 5] * sw); ww.w = pk2(x[8 * q + 6] * sw, x[8 * q + 7] * sw);
            *(uint4*)(t0u + 8 * q) = wu; *(uint4*)(t0w + 8 * q) = ww; }
    }
}
constexpr int G2_KB = 0, G2_QB = 17408, G2_TM = 0  , G2_KT = 36864, G2_VT = 55296, G2_AS = 73728, G2_GT = 108544, G2_XL = 110592;
static_assert(G2_GT + 8 * 64 * 4 <= G2_XL && G2_XL + G2X_BYTES <= LDS_BYTES, "G2 LDS");
__device__ __forceinline__ void phase_gdn_prep(const Params& p, unsigned char* lds) {
    bf16_t* kb = (bf16_t*)(lds + G2_KB); bf16_t* qb = (bf16_t*)(lds + G2_QB); bf16_t* kT = (bf16_t*)(lds + G2_KT); bf16_t* vT = (bf16_t*)(lds + G2_VT);
    float* As = (float*)(lds + G2_AS); bf16_t* TM = (bf16_t*)(lds + G2_TM); float* gt = (float*)(lds + G2_GT); unsigned char* xl = lds + G2_XL;
    float* beta_s = gt; float* gc_s = gt + 128; float* rsu = gt + 256; float* rsw = gt + 384;
    const bf16_t* PG = (const bf16_t*)(p.ws + OFF_PGDN); const float* GATES = (const float*)(p.ws + OFF_GATES);
    const float* cw = p.in[11]; const float* a_log = p.in[12]; const float* dt_bias = p.in[13];
    bf16_t* KT = (bf16_t*)(p.ws + OFF_KT); bf16_t* QO = (bf16_t*)(p.ws + OFF_Q); bf16_t* UW = (bf16_t*)(p.ws + OFF_UW); bf16_t* ATT = (bf16_t*)(p.ws + OFF_ATT);
    float* GSC = (float*)(p.ws + OFF_GSC);
    for (int item = blockIdx.x; item < NITEM; item += gridDim.x) {
        int tid = otid();
        const int lane = tid & 63, wid = __builtin_amdgcn_readfirstlane(tid >> 6), fr = lane & 15, fq = lane >> 4;
        int b, n, h, row0, seq0, seqlen; item_decode(item, b, n, h, row0, seq0, seqlen);
        const bool ctx = n < 4;
        float graw_b = 0.f, graw_a = 0.f;
        if (tid < 128) { const int d = tid >> 6, i = d ? 63 - lane : lane; const float* gp = GATES + (size_t)(row0 + i) * 32; graw_b = gp[d * 8 + h]; graw_a = gp[16 + d * 8 + h]; }
        {   const int r = tid >> 3, c16 = (tid & 7) * 16;
            uint4 raw[3][5][2];
#pragma unroll
            for (int mt = 0; mt < 3; ++mt)
#pragma unroll
                for (int i = 0; i < 5; ++i) { int rr = row0 + r + i - 2; rr = rr < seq0 ? seq0 : (rr >= seq0 + seqlen ? seq0 + seqlen - 1 : rr);
                    const bf16_t* sp = PG + (size_t)rr * 3072 + mt * 1024 + h * 128 + c16; raw[mt][i][0] = *(const uint4*)sp; raw[mt][i][1] = *(const uint4*)(sp + 8); }
#pragma unroll
            for (int mt = 0; mt < 3; ++mt) {
                if (mt == 2 && ctx) break;
                const int col = mt * 1024 + h * 128 + c16;
                float a[16];
#pragma unroll
                for (int j = 0; j < 16; ++j) a[j] = 0.f;
#pragma unroll
                for (int i = 0; i < 5; ++i) {
                    const int rr = row0 + r + i - 2;
                    const float msk = (rr >= seq0 && rr < seq0 + seqlen) ? 1.0f : 0.0f;
                    float f0[8], f1[8]; unpack8(raw[mt][i][0], f0); unpack8(raw[mt][i][1], f1);
                    const float* wp = cw + i * 3072 + col;
#pragma unroll
                    for (int j = 0; j < 8; ++j) { a[j] += (wp[j] * msk) * f0[j]; a[8 + j] += (wp[8 + j] * msk) * f1[j]; }
                }
                float ss = 0.f;
#pragma unroll
                for (int j = 0; j < 16; ++j) { a[j] = silu(a[j]); ss += a[j] * a[j]; }
                if (mt != 1) {
                    ss += __shfl_xor(ss, 1); ss += __shfl_xor(ss, 2); ss += __shfl_xor(ss, 4);
                    const float sc = rsqrtf(ss + EPSF) * (mt == 2 ? 0.08838834764831845f : 1.0f);
#pragma unroll
                    for (int j = 0; j < 16; ++j) a[j] *= sc;
                }
                uint4 w0, w1; w0.x = pk2(a[0], a[1]); w0.y = pk2(a[2], a[3]); w0.z = pk2(a[4], a[5]); w0.w = pk2(a[6], a[7]);
                w1.x = pk2(a[8], a[9]); w1.y = pk2(a[10], a[11]); w1.z = pk2(a[12], a[13]); w1.w = pk2(a[14], a[15]);
                if (mt == 0) {
                    *(uint4*)(kb + r * 136 + c16) = w0; *(uint4*)(kb + r * 136 + c16 + 8) = w1;
#pragma unroll
                    for (int j = 0; j < 16; ++j) kT[(c16 + j) * 72 + r] = f2bf(a[j]);
                } else if (mt == 1) {
#pragma unroll
                    for (int j = 0; j < 16; ++j) vT[(c16 + j) * 72 + r] = f2bf(a[j]);
                } else {
                    *(uint4*)(qb + r * 136 + c16) = w0; *(uint4*)(qb + r * 136 + c16 + 8) = w1;
                    bf16_t* qp = QO + (size_t)item * 8192 + r * 128 + c16; *(uint4*)qp = w0; *(uint4*)(qp + 8) = w1;
                }
            }
        }
        if (tid < 128) {
            const int d = tid >> 6, i = d ? 63 - lane : lane;
            const float beta = 1.0f / (1.0f + __expf(-graw_b));
            const float x = graw_a + dt_bias[d * 8 + h];
            const float sp = x > 20.f ? x : __logf(1.0f + __expf(x));
            float g = -__expf(a_log[d * 8 + h]) * sp;
#pragma unroll
            for (int o = 1; o < 64; o <<= 1) { const float t = __shfl_up(g, o); if (lane >= o) g += t; }
            const float glast = __shfl(g, 63);
            const float eg = __expf(g), ee = __expf(glast - g);
            beta_s[d * 64 + i] = beta; gc_s[d * 64 + i] = g; rsu[d * 64 + i] = beta; rsw[d * 64 + i] = beta * eg;
            float* gs = GSC + ((size_t)item * 2 + d) * 192; gs[i] = eg; gs[64 + i] = ee; if (lane == 63) gs[128] = __expf(glast);
        }
        __syncthreads();
#pragma unroll
        for (int i = 0; i < 2; ++i) { const int q16 = tid + NT * i; *(uint4*)(KT + (size_t)item * 8192 + (size_t)q16 * 8) = *(const uint4*)(kT + (q16 >> 3) * 72 + (q16 & 7) * 8); }
        {   const int mt = wid >> 1, ntp = wid & 1;
            f32x4 ckk[2], cqk[2];
#pragma unroll
            for (int e = 0; e < 2; ++e) { ckk[e] = (f32x4){0.f, 0.f, 0.f, 0.f}; cqk[e] = (f32x4){0.f, 0.f, 0.f, 0.f}; }
#pragma unroll
            for (int ks = 0; ks < 4; ++ks) {
                const bf16x8 ak = *(const bf16x8*)(kb + (16 * mt + fr) * 136 + 32 * ks + 8 * fq);
                bf16x8 aq = ak; if (!ctx) aq = *(const bf16x8*)(qb + (16 * mt + fr) * 136 + 32 * ks + 8 * fq);
#pragma unroll
                for (int e = 0; e < 2; ++e) { const bf16x8 bk = *(const bf16x8*)(kb + (16 * (2 * ntp + e) + fr) * 136 + 32 * ks + 8 * fq);
                    ckk[e] = __builtin_amdgcn_mfma_f32_16x16x32_bf16(ak, bk, ckk[e], 0, 0, 0);
                    cqk[e] = __builtin_amdgcn_mfma_f32_16x16x32_bf16(aq, bk, cqk[e], 0, 0, 0); }
            }
#pragma unroll
            for (int e = 0; e < 2; ++e)
#pragma unroll
                for (int r = 0; r < 4; ++r) {
                    const int i = 16 * mt + 4 * fq + r, j = 16 * (2 * ntp + e) + fr;
#pragma unroll
                    for (int d = 0; d < 2; ++d) {
                        const bool before = d ? (j > i) : (j < i); const bool incl = before || (i == j);
                        const float df = incl ? gc_s[d * 64 + i] - gc_s[d * 64 + j] : 0.f; const float ex = __expf(df);
                        const float av = before ? beta_s[d * 64 + i] * ckk[e][r] * ex : 0.f;
                        const int ii = d ? 63 - i : i, jj = d ? 63 - j : j;
                        As[(d * 64 + jj) * 68 + ii] = av;
                        if (!ctx) ATT[((size_t)item * 2 + d) * 4096 + i * 64 + j] = f2bf(incl ? cqk[e][r] * ex : 0.f);
                    }
                }
        }
        __syncthreads();
        if (wid == 0) g2_tinv_diag<0>(As, lane, rsu, rsw, TM, xl);
        else if (wid == 1) g2_tinv_diag<1>(As, lane, rsu, rsw, TM, xl);
        __syncthreads();
        {   const int dd = wid >> 2, vv = (wid >> 1) & 1, mh = wid & 1;
            const bf16_t* a10 = (const bf16_t*)(xl + G2X_A10) + dd * 32 * 40; const bf16_t* t11 = (const bf16_t*)(xl + G2X_T11) + dd * 32 * 40;
            const bf16_t* t0t = (const bf16_t*)(xl + G2X_T00T) + (dd * 2 + vv) * 32 * 40; bf16_t* xt = (bf16_t*)(xl + G2X_XT) + (dd * 2 + vv) * 32 * 40;
            const bf16x8 aA = *(const bf16x8*)(a10 + (16 * mh + fr) * 40 + 8 * fq);
#pragma unroll
            for (int nt = 0; nt < 2; ++nt) { const bf16x8 bT = *(const bf16x8*)(t0t + (16 * nt + fr) * 40 + 8 * fq);
                f32x4 acc = (f32x4){0.f, 0.f, 0.f, 0.f}; acc = __builtin_amdgcn_mfma_f32_16x16x32_bf16(aA, bT, acc, 0, 0, 0);
                uint2 w; w.x = pk2_c(acc[0], acc[1]); w.y = pk2_c(acc[2], acc[3]);
                *(uint2*)(xt + (16 * nt + fr) * 40 + 16 * mh + 4 * fq) = w; }
            __syncthreads();
            const bf16x8 aT = *(const bf16x8*)(t11 + (16 * mh + fr) * 40 + 8 * fq);
            bf16_t* tm = TM + (dd * 2 + vv) * 64 * 72;
#pragma unroll
            for (int nt = 0; nt < 2; ++nt) { const bf16x8 bX = *(const bf16x8*)(xt + (16 * nt + fr) * 40 + 8 * fq);
                f32x4 acc = (f32x4){0.f, 0.f, 0.f, 0.f}; acc = __builtin_amdgcn_mfma_f32_16x16x32_bf16(aT, bX, acc, 0, 0, 0);
                const int sj = 16 * nt + fr, jo = dd ? 63 - sj : sj;
#pragma unroll
                for (int r = 0; r < 4; ++r) { const int si = 32 + 16 * mh + 4 * fq + r, io = dd ? 63 - si : si; tm[io * 72 + jo] = (bf16_t)(pk2_c(-acc[r], 0.f) & 0xffffu); } }
        }
        __syncthreads();
        {   const int mi = wid >> 1, half = wid & 1, uw = mi & 1;
            const bf16_t* Tm = TM + mi * 64 * 72; const bf16_t* Bm = uw ? kT : vT;
            bf16_t* dst = UW + ((size_t)item * 4 + mi) * 8192;
#pragma unroll
            for (int mm = 0; mm < 2; ++mm) {
                const int mt = 2 * half + mm;
                const bf16x8 a0 = *(const bf16x8*)(Tm + (16 * mt + fr) * 72 + 8 * fq), a1 = *(const bf16x8*)(Tm + (16 * mt + fr) * 72 + 32 + 8 * fq);
#pragma unroll
                for (int nt = 0; nt < 8; ++nt) {
                    const bf16x8 b0 = *(const bf16x8*)(Bm + (16 * nt + fr) * 72 + 8 * fq), b1 = *(const bf16x8*)(Bm + (16 * nt + fr) * 72 + 32 + 8 * fq);
                    f32x4 acc = (f32x4){0.f, 0.f, 0.f, 0.f};
                    acc = __builtin_amdgcn_mfma_f32_16x16x32_bf16(b0, a0, acc, 0, 0, 0);
                    acc = __builtin_amdgcn_mfma_f32_16x16x32_bf16(b1, a1, acc, 0, 0, 0);
                    uint2 w; w.x = pk2_c(acc[0], acc[1]); w.y = pk2_c(acc[2], acc[3]);
                    *(uint2*)(dst + (16 * mt + fr) * 128 + 16 * nt + 4 * fq) = w;
                }
            }
        }
        __syncthreads();
    }
}

constexpr int SC_BUF = 68224, SC_W = 0, SC_KT = 17408, SC_Q = 35840, SC_AT = 53248, SC_U = 62464  , SC_S = 67584  ,
              SC_ST = 2 * SC_BUF, SC_VT = SC_ST + 8704, SC_VE = SC_VT + 4608;
static_assert(SC_S + 132 * 4 <= SC_BUF && SC_VE + 4608 <= LDS_BYTES - 16, "scan LDS");
struct ScanLd { uint4 w[4], k[4], q[4], a[2], u; float sc; };
struct ScanCtx { const bf16_t* KT; const bf16_t* QO; const bf16_t* UW; const bf16_t* ATT; const float* GSC; int lt, fr, fq, wid, sl, d, h, b; };
__device__ __forceinline__ void scan_item(const ScanCtx& c, int s, int& item, bool& ctx, int& row0) {
    const int n = c.d ? (s < 4 ? 3 - s : 135 - s) : s; item = ((c.b * NCHUNK + n) << 3) + c.h; ctx = n < 4;
    row0 = ctx ? MLAT + c.b * CL + n * CHK : c.b * SL + (n - 4) * CHK;
}
__device__ __forceinline__ void scan_load(const ScanCtx& c, ScanLd& L, int s) {
    int it, r0; bool cx; scan_item(c, s, it, cx, r0); (void)cx; (void)r0;
    const bf16_t* wp = c.UW + (((size_t)it * 2 + c.d) * 2 + 1) * 8192; const bf16_t* up = c.UW + (((size_t)it * 2 + c.d) * 2) * 8192;
    const bf16_t* kp = c.KT + (size_t)it * 8192; const bf16_t* qp = c.QO + (size_t)it * 8192; const bf16_t* ap = c.ATT + ((size_t)it * 2 + c.d) * 4096;
    const float* gs = c.GSC + ((size_t)it * 2 + c.d) * 192;
    const unsigned o16 = (unsigned)c.lt * 16u;
#pragma unroll
    for (int i = 0; i < 4; ++i) { const unsigned q = o16 + 4096u * i; L.w[i] = *(const uint4*)((const char*)wp + q); L.k[i] = *(const uint4*)((const char*)kp + q); L.q[i] = *(const uint4*)((const char*)qp + q); }
#pragma unroll
    for (int i = 0; i < 2; ++i) L.a[i] = *(const uint4*)((const char*)ap + o16 + 4096u * i);
    L.u = *(const uint4*)((const char*)up + (unsigned)((c.lt >> 2) * 256 + 64 * c.sl + (c.lt & 3) * 16));
    L.sc = gs[c.lt < 129 ? c.lt : 128];
}
__device__ __forceinline__ void scan_store(const ScanCtx& c, const ScanLd& L, unsigned char* bp) {
#pragma unroll
    for (int i = 0; i < 4; ++i) { const int q = c.lt + 256 * i;
        *(uint4*)(bp + SC_W + (q >> 4) * 272 + (q & 15) * 16) = L.w[i];
        *(uint4*)(bp + SC_KT + (q >> 3) * 144 + (q & 7) * 16) = L.k[i];
        *(uint4*)(bp + SC_Q + (q >> 4) * 272 + (q & 15) * 16) = L.q[i]; }
#pragma unroll
    for (int i = 0; i < 2; ++i) { const int q = c.lt + 256 * i; *(uint4*)(bp + SC_AT + (q >> 3) * 144 + (q & 7) * 16) = L.a[i]; }
    *(uint4*)(bp + SC_U + (c.lt >> 2) * 80 + (c.lt & 3) * 16) = L.u;
    if (c.lt < 129) *(float*)(bp + SC_S + c.lt * 4) = L.sc;
}
__device__ __forceinline__ void scan_alpha(const ScanCtx& c, unsigned char* lds, const unsigned char* bc, bool ctx, f32x4 (&O1)[2]) {
    const int fr = c.fr, fq = c.fq, mt = c.wid;
    f32x4 P[2]; P[0] = (f32x4){0.f, 0.f, 0.f, 0.f}; P[1] = (f32x4){0.f, 0.f, 0.f, 0.f}; O1[0] = (f32x4){0.f, 0.f, 0.f, 0.f}; O1[1] = (f32x4){0.f, 0.f, 0.f, 0.f};
#pragma unroll
    for (int ks = 0; ks < 4; ++ks) {
        const bf16x8 aW = *(const bf16x8*)(bc + SC_W + (16 * mt + fr) * 272 + (32 * ks + 8 * fq) * 2);
        bf16x8 aQ = aW; if (!ctx) aQ = *(const bf16x8*)(bc + SC_Q + (16 * mt + fr) * 272 + (32 * ks + 8 * fq) * 2);
#pragma unroll
        for (int nt = 0; nt < 2; ++nt) {
            const bf16x8 bS = *(const bf16x8*)(lds + SC_ST + (16 * nt + fr) * 272 + (32 * ks + 8 * fq) * 2);
            P[nt] = __builtin_amdgcn_mfma_f32_16x16x32_bf16(aW, bS, P[nt], 0, 0, 0);
            if (!ctx) O1[nt] = __builtin_amdgcn_mfma_f32_16x16x32_bf16(bS, aQ, O1[nt], 0, 0, 0);
        }
    }
    float eec[4];
#pragma unroll
    for (int r = 0; r < 4; ++r) eec[r] = *(const float*)(bc + SC_S + (64 + 16 * mt + 4 * fq + r) * 4);
#pragma unroll
    for (int nt = 0; nt < 2; ++nt) {
        float vn[4];
#pragma unroll
        for (int r = 0; r < 4; ++r) vn[r] = bf2f(*(const bf16_t*)(bc + SC_U + (16 * mt + 4 * fq + r) * 80 + (16 * nt + fr) * 2)) - P[nt][r];
        uint2 w; w.x = pk2(vn[0], vn[1]); w.y = pk2(vn[2], vn[3]);
        *(uint2*)(lds + SC_VT + (16 * nt + fr) * 144 + (16 * mt + 4 * fq) * 2) = w;
        w.x = pk2(vn[0] * eec[0], vn[1] * eec[1]); w.y = pk2(vn[2] * eec[2], vn[3] * eec[3]);
        *(uint2*)(lds + SC_VE + (16 * nt + fr) * 144 + (16 * mt + 4 * fq) * 2) = w;
    }
}
__device__ __forceinline__ void scan_beta(const ScanCtx& c, unsigned char* lds, const unsigned char* bc, bool ctx, int row0, const f32x4 (&O1)[2], f32x4 (&Sacc)[2][2], bf16_t* OD) {
    const int fr = c.fr, fq = c.fq, mt = c.wid;
    const float decc = *(const float*)(bc + SC_S + 128 * 4);
#pragma unroll
    for (int j = 0; j < 2; ++j) {
        const int dt = 2 * c.wid + j;
        const bf16x8 aK0 = *(const bf16x8*)(bc + SC_KT + (16 * dt + fr) * 144 + (8 * fq) * 2), aK1 = *(const bf16x8*)(bc + SC_KT + (16 * dt + fr) * 144 + (32 + 8 * fq) * 2);
#pragma unroll
        for (int e = 0; e < 2; ++e) {
            f32x4 a = Sacc[j][e] * decc;
            const bf16x8 b0 = *(const bf16x8*)(lds + SC_VE + (16 * e + fr) * 144 + (8 * fq) * 2), b1 = *(const bf16x8*)(lds + SC_VE + (16 * e + fr) * 144 + (32 + 8 * fq) * 2);
            a = __builtin_amdgcn_mfma_f32_16x16x32_bf16(aK0, b0, a, 0, 0, 0);
            a = __builtin_amdgcn_mfma_f32_16x16x32_bf16(aK1, b1, a, 0, 0, 0);
            Sacc[j][e] = a;
        }
    }
    if (!ctx) {
        const bf16x8 aA0 = *(const bf16x8*)(bc + SC_AT + (16 * mt + fr) * 144 + (8 * fq) * 2), aA1 = *(const bf16x8*)(bc + SC_AT + (16 * mt + fr) * 144 + (32 + 8 * fq) * 2);
        const float ego = *(const float*)(bc + SC_S + (16 * mt + fr) * 4);
#pragma unroll
        for (int nt = 0; nt < 2; ++nt) {
            const bf16x8 b0 = *(const bf16x8*)(lds + SC_VT + (16 * nt + fr) * 144 + (8 * fq) * 2), b1 = *(const bf16x8*)(lds + SC_VT + (16 * nt + fr) * 144 + (32 + 8 * fq) * 2);
            f32x4 O2 = (f32x4){0.f, 0.f, 0.f, 0.f};
            O2 = __builtin_amdgcn_mfma_f32_16x16x32_bf16(b0, aA0, O2, 0, 0, 0);
            O2 = __builtin_amdgcn_mfma_f32_16x16x32_bf16(b1, aA1, O2, 0, 0, 0);
            uint2 w; w.x = pk2_c(ego * O1[nt][0] + O2[0], ego * O1[nt][1] + O2[1]); w.y = pk2_c(ego * O1[nt][2] + O2[2], ego * O1[nt][3] + O2[3]);
            *(uint2*)(OD + (size_t)(row0 + 16 * mt + fr) * 1024 + c.h * 128 + 32 * c.sl + 16 * nt + 4 * fq) = w;
        }
    }
#pragma unroll
    for (int j = 0; j < 2; ++j)
#pragma unroll
        for (int e = 0; e < 2; ++e) { uint2 w; w.x = pk2_c(Sacc[j][e][0], Sacc[j][e][1]); w.y = pk2_c(Sacc[j][e][2], Sacc[j][e][3]);
            *(uint2*)(lds + SC_ST + (16 * e + fr) * 272 + (16 * (2 * c.wid + j) + 4 * fq) * 2) = w; }
}
__device__ __forceinline__ void phase_gdn_scan(const Params& p, unsigned char* lds) {
    ScanCtx c;
    const int tid = otid(), lane = tid & 63; c.wid = __builtin_amdgcn_readfirstlane(tid >> 6); c.fr = lane & 15; c.fq = lane >> 4;
    const bool loader = c.wid >= 4; c.lt = tid - 256;
    c.KT = (const bf16_t*)(p.ws + OFF_KT); c.QO = (const bf16_t*)(p.ws + OFF_Q); c.UW = (const bf16_t*)(p.ws + OFF_UW);
    c.ATT = (const bf16_t*)(p.ws + OFF_ATT); c.GSC = (const float*)(p.ws + OFF_GSC);
    for (int work = blockIdx.x; work < 256; work += gridDim.x) {
        const int xcd_ = work & 7, idx_ = work >> 3, grp_ = (idx_ >> 2) * 8 + xcd_;
        c.sl = idx_ & 3; c.d = grp_ & 1; c.h = (grp_ >> 1) & 7; c.b = grp_ >> 4;
        bf16_t* OD = (bf16_t*)(p.ws + (c.d ? OFF_OB : OFF_OF));
        for (int i = tid; i < 8704 / 4; i += NT) ((unsigned*)(lds + SC_ST))[i] = 0u;
        if (loader) {
            ScanLd L0, L1;
#define SCAN_ZERO(L_) do { _Pragma("unroll") for (int i = 0; i < 4; ++i) { L_.w[i] = make_uint4(0u, 0u, 0u, 0u); L_.k[i] = make_uint4(0u, 0u, 0u, 0u); L_.q[i] = make_uint4(0u, 0u, 0u, 0u); } \
                L_.a[0] = make_uint4(0u, 0u, 0u, 0u); L_.a[1] = make_uint4(0u, 0u, 0u, 0u); L_.u = make_uint4(0u, 0u, 0u, 0u); L_.sc = 0.f; } while (0)
            SCAN_ZERO(L0); SCAN_ZERO(L1);
#undef SCAN_ZERO
            scan_load(c, L0, 0); scan_store(c, L0, lds); scan_load(c, L1, 1);
            __syncthreads();
#define SCAN_LSTEP(s_, LD_, ST_) do { const int ss_ = (s_); if (ss_ + 2 < NCHUNK) scan_load(c, LD_, ss_ + 2); __syncthreads(); \
                if (ss_ + 1 < NCHUNK) scan_store(c, ST_, lds + ((ss_ + 1) & 1) * SC_BUF); __syncthreads(); } while (0)
#pragma unroll 1
            for (int s = 0; s < NCHUNK; s += 2) {
                SCAN_LSTEP(s, L0, L1); SCAN_LSTEP(s + 1, L1, L0); }
#undef SCAN_LSTEP
        } else {
            f32x4 Sacc[2][2];
#pragma unroll
            for (int j = 0; j < 2; ++j) { Sacc[j][0] = (f32x4){0.f, 0.f, 0.f, 0.f}; Sacc[j][1] = (f32x4){0.f, 0.f, 0.f, 0.f}; }
            __syncthreads();
#pragma unroll 1
            for (int s = 0; s < NCHUNK; ++s) {
                int item, row0; bool ctx; scan_item(c, s, item, ctx, row0); (void)item;
                const unsigned char* bc = lds + (s & 1) * SC_BUF; f32x4 O1[2];
                scan_alpha(c, lds, bc, ctx, O1);
                __syncthreads();
                scan_beta(c, lds, bc, ctx, row0, O1, Sacc, OD);
                __syncthreads();
            }
        }
    }
}

__device__ __forceinline__ void phase_gdn_out(const Params& p) {
    const bf16_t* OFp = (const bf16_t*)(p.ws + OFF_OF); const bf16_t* OBp = (const bf16_t*)(p.ws + OFF_OB); const bf16_t* PZ = (const bf16_t*)(p.ws + OFF_PZ);
    bf16_t* MIX = (bf16_t*)(p.ws + OFF_H); const float* gn = p.in[14];
    const size_t total = (size_t)MLAT * 128, stride = (size_t)gridDim.x * NT;
    size_t e = (size_t)blockIdx.x * NT + otid();
    uint4 ua, ub, uz, na, nb, nz;
    if (e < total) { const size_t row = e >> 7; const int c8 = (int)(e & 127) * 8; ua = *(const uint4*)(OFp + row * 1024 + c8); ub = *(const uint4*)(OBp + row * 1024 + c8); uz = *(const uint4*)(PZ + row * 1024 + c8); }
    for (; e < total; e += stride) {
        const size_t en = e + stride;
        if (en < total) { const size_t row = en >> 7; const int c8 = (int)(en & 127) * 8; na = *(const uint4*)(OFp + row * 1024 + c8); nb = *(const uint4*)(OBp + row * 1024 + c8); nz = *(const uint4*)(PZ + row * 1024 + c8); }
        const size_t row = e >> 7; const int c8 = (int)(e & 127) * 8;
        float a[8], bq[8], z[8];
        unpack8(ua, a); unpack8(ub, bq); unpack8(uz, z);
        float ss = 0.f;
#pragma unroll
        for (int j = 0; j < 8; ++j) { a[j] += bq[j]; ss += a[j] * a[j]; }
        ss += __shfl_xor(ss, 1); ss += __shfl_xor(ss, 2); ss += __shfl_xor(ss, 4); ss += __shfl_xor(ss, 8);
        const float rstd = rsqrtf(ss * (1.0f / 128.0f) + EPSF);
#pragma unroll
        for (int j = 0; j < 8; ++j) a[j] = a[j] * rstd * gn[(c8 & 127) + j] * silu(z[j]);
        *(uint4*)(MIX + row * DM + c8) = pack8(a);
        ua = na; ub = nb; uz = nz;
    }
}

__device__ __forceinline__ void phase_postmix(const Params& p) {
    const int tid_ = otid(), lane = tid_ & 63, wv = __builtin_amdgcn_readfirstlane(tid_ >> 6);
    const float* MOD = (const float*)(p.ws + OFF_MOD); const float* w1 = p.in[7]; const float* w2 = p.in[8];
    const bf16_t* OUT = (const bf16_t*)(p.ws + OFF_OUT); bf16_t* H = (bf16_t*)(p.ws + OFF_H); bf16_t* S1B = (bf16_t*)(p.ws + OFF_S1B);
    const int stride = gridDim.x * 8;
    uint4 ov[4], ovn[4]; float4 xv[8], xvn[8];
    int row = blockIdx.x * 8 + wv;
    if (row < MLAT) {
#pragma unroll
        for (int i = 0; i < 4; ++i) { ov[i] = *(const uint4*)(OUT + (size_t)row * DM + 8 * (lane + 64 * i));
            xv[2 * i] = *(const float4*)(p.in[0] + (size_t)row * DM + 8 * (lane + 64 * i)); xv[2 * i + 1] = *(const float4*)(p.in[0] + (size_t)row * DM + 8 * (lane + 64 * i) + 4); } }
    for (; row < MLAT; row += stride) {
        const int nxt = row + stride;
        if (nxt < MLAT) {
#pragma unroll
            for (int i = 0; i < 4; ++i) { ovn[i] = *(const uint4*)(OUT + (size_t)nxt * DM + 8 * (lane + 64 * i));
                xvn[2 * i] = *(const float4*)(p.in[0] + (size_t)nxt * DM + 8 * (lane + 64 * i)); xvn[2 * i + 1] = *(const float4*)(p.in[0] + (size_t)nxt * DM + 8 * (lane + 64 * i) + 4); } }
        const int b = row >> 13; const float* mb = MOD + b * (6 * DM);
        const float* ga = mb + 2 * DM; const float* shf = mb + 3 * DM; const float* scf = mb + 4 * DM;
        float o[4][8]; float ss = 0.f;
#pragma unroll
        for (int i = 0; i < 4; ++i) { unpack8(ov[i], o[i]);
#pragma unroll
            for (int j = 0; j < 8; ++j) ss += o[i][j] * o[i][j]; }
        ss = wave_sum(ss); const float rstd = rsqrtf(ss * (1.0f / DM) + EPSF);
        float ss2 = 0.f;
#pragma unroll
        for (int i = 0; i < 4; ++i) { const int col = 8 * (lane + 64 * i);
#pragma unroll
            for (int hh = 0; hh < 2; ++hh) { const float4 xq = xv[2 * i + hh], wv4 = *(const float4*)(w1 + col + 4 * hh), gv = *(const float4*)(ga + col + 4 * hh);
                float4 s; s.x = xq.x + gv.x * o[i][4 * hh] * rstd * wv4.x; s.y = xq.y + gv.y * o[i][4 * hh + 1] * rstd * wv4.y; s.z = xq.z + gv.z * o[i][4 * hh + 2] * rstd * wv4.z; s.w = xq.w + gv.w * o[i][4 * hh + 3] * rstd * wv4.w;
                o[i][4 * hh] = s.x; o[i][4 * hh + 1] = s.y; o[i][4 * hh + 2] = s.z; o[i][4 * hh + 3] = s.w;
                ss2 += s.x * s.x + s.y * s.y + s.z * s.z + s.w * s.w; } }
        ss2 = wave_sum(ss2); const float rstd2 = rsqrtf(ss2 * (1.0f / DM) + EPSF);
#pragma unroll
        for (int i = 0; i < 4; ++i) { const int col = 8 * (lane + 64 * i); float f[8];
#pragma unroll
            for (int j = 0; j < 8; ++j) f[j] = o[i][j] * rstd2 * w2[col + j] * (1.f + scf[col + j]) + shf[col + j];
            *(uint4*)(H + (size_t)row * DM + col) = pack8(f); *(uint4*)(S1B + (size_t)row * DM + col) = pack8(o[i]); }
#pragma unroll
        for (int i = 0; i < 4; ++i) { ov[i] = ovn[i]; xv[2 * i] = xvn[2 * i]; xv[2 * i + 1] = xvn[2 * i + 1]; }
    }
}

__device__ __forceinline__ void phase_final(const Params& p) {
    const int tid_ = otid(), lane = tid_ & 63, wv = __builtin_amdgcn_readfirstlane(tid_ >> 6);
    const float* MOD = (const float*)(p.ws + OFF_MOD); const float* w = p.in[9]; const bf16_t* FF = (const bf16_t*)(p.ws + OFF_FF); const bf16_t* S1B = (const bf16_t*)(p.ws + OFF_S1B);
    const int stride = gridDim.x * 8;
    uint4 fv[4], fvn[4], sv[4], svn[4];
    int row = blockIdx.x * 8 + wv;
    if (row < MLAT) {
#pragma unroll
        for (int i = 0; i < 4; ++i) { fv[i] = *(const uint4*)(FF + (size_t)row * DM + 8 * (lane + 64 * i)); sv[i] = *(const uint4*)(S1B + (size_t)row * DM + 8 * (lane + 64 * i)); } }
    for (; row < MLAT; row += stride) {
        const int nxt = row + stride;
        if (nxt < MLAT) {
#pragma unroll
            for (int i = 0; i < 4; ++i) { fvn[i] = *(const uint4*)(FF + (size_t)nxt * DM + 8 * (lane + 64 * i)); svn[i] = *(const uint4*)(S1B + (size_t)nxt * DM + 8 * (lane + 64 * i)); } }
        const int b = row >> 13; const float* gf = MOD + b * (6 * DM) + 5 * DM;
        float o[4][8]; float ss = 0.f;
#pragma unroll
        for (int i = 0; i < 4; ++i) { unpack8(fv[i], o[i]);
#pragma unroll
            for (int j = 0; j < 8; ++j) ss += o[i][j] * o[i][j]; }
        ss = wave_sum(ss); const float rstd = rsqrtf(ss * (1.0f / DM) + EPSF);
#pragma unroll
        for (int i = 0; i < 4; ++i) { const int col = 8 * (lane + 64 * i); float s1[8]; unpack8(sv[i], s1);
#pragma unroll
            for (int hh = 0; hh < 2; ++hh) { const float4 wv4 = *(const float4*)(w + col + 4 * hh), gv = *(const float4*)(gf + col + 4 * hh); float4 s;
                s.x = s1[4 * hh] + gv.x * o[i][4 * hh] * rstd * wv4.x; s.y = s1[4 * hh + 1] + gv.y * o[i][4 * hh + 1] * rstd * wv4.y;
                s.z = s1[4 * hh + 2] + gv.z * o[i][4 * hh + 2] * rstd * wv4.z; s.w = s1[4 * hh + 3] + gv.w * o[i][4 * hh + 3] * rstd * wv4.w;
                *(float4*)(p.out + (size_t)row * DM + col + 4 * hh) = s; } }
#pragma unroll
        for (int i = 0; i < 4; ++i) { fv[i] = fvn[i]; sv[i] = svn[i]; }
    }
}

#define XB_TMO      128
#define XB_XCNT(j)  (256  + 64 * (j))
#define XB_XSUB(j)  (1280 + 64 * (j))
#define XB_XGEN(j)  (2304 + 64 * (j))
#define XB_TOP      3328
#define XB_TOPGEN   3392
#define XCD_BAR_WORDS 3456
#define XB_SPIN_CAP (1u << 18)
#define LAS __attribute__((address_space(3)))

__device__ __forceinline__ unsigned xb_ld(unsigned* p)              { return __hip_atomic_load(p, __ATOMIC_RELAXED, __HIP_MEMORY_SCOPE_AGENT); }
__device__ __forceinline__ unsigned xb_add(unsigned* p, unsigned v) { return __hip_atomic_fetch_add(p, v, __ATOMIC_RELAXED, __HIP_MEMORY_SCOPE_AGENT); }
__device__ __forceinline__ unsigned xb_xcc_id() { return (unsigned)__builtin_amdgcn_s_getreg((3 << 11) | 20) & 0xFu; }
#define XB_SPIN(cond, bar) do { unsigned _sp = 0; while (cond) { __builtin_amdgcn_s_sleep(1); \
    if ((++_sp & 255u) == 0u) { if (xb_ld(&(bar)[XB_TMO])) break; if (_sp > XB_SPIN_CAP) { atomicAdd(&(bar)[XB_TMO], 1u); break; } } } } while (0)

struct XcdBarrier {
    unsigned* bar; unsigned x;
    volatile LAS unsigned* st;
};

__device__ __forceinline__ XcdBarrier xcd_barrier_post(unsigned* bar, volatile LAS unsigned* st) {
    XcdBarrier b; b.bar = bar; b.x = xb_xcc_id(); b.st = st;
    if (threadIdx.x == 0) (void)xb_add(&bar[XB_XCNT(b.x)], 1u);
    return b;
}
__device__ __forceinline__ void xcd_barrier_complete(unsigned* bar, unsigned x, unsigned& nloc, unsigned& nx) {
    const unsigned G = gridDim.x * gridDim.y * gridDim.z;
    unsigned sum, cnt, mine, sp = 0u;
    for (;;) {
        sum = 0u; cnt = 0u; mine = 0u;
#pragma unroll
        for (unsigned j = 0; j < 16; ++j) { const unsigned c = xb_ld(&bar[XB_XCNT(j)]); sum += c; cnt += (c > 0u) ? 1u : 0u; mine = (j == x) ? c : mine; }
        if (sum == G) break;
        __builtin_amdgcn_s_sleep(1);
        if ((++sp & 255u) == 0u) { if (xb_ld(&bar[XB_TMO])) break; if (sp > XB_SPIN_CAP) { atomicAdd(&bar[XB_TMO], 1u); break; } }
    }
    nloc = mine > 0u ? mine : 1u; nx = cnt > 0u ? cnt : 1u;
}

__device__ __forceinline__ void xcd_barrier(const XcdBarrier& b) {
    asm volatile("s_waitcnt vmcnt(0)" ::: "memory");
    __syncthreads();
    if (threadIdx.x == 0) {
        unsigned* bar = b.bar;
        __builtin_amdgcn_s_waitcnt(0);
        unsigned nloc = b.st[0], nx = b.st[1];
        if (nloc == 0u) { xcd_barrier_complete(bar, b.x, nloc, nx); b.st[0] = nloc; b.st[1] = nx; }
        const unsigned old = xb_add(&bar[XB_XSUB(b.x)], 1u);
        const unsigned gen = old / nloc;
        if (old + 1u == (gen + 1u) * nloc) {
            __builtin_amdgcn_fence(__ATOMIC_RELEASE, "agent");
            asm volatile("s_waitcnt vmcnt(0)" ::: "memory");
            const unsigned og = xb_add(&bar[XB_TOP], 1u);
            const unsigned tg = og / nx;
            if (og + 1u == (tg + 1u) * nx) xb_add(&bar[XB_TOPGEN], 1u);
            else XB_SPIN(xb_ld(&bar[XB_TOPGEN]) == tg, bar);
            __builtin_amdgcn_fence(__ATOMIC_ACQUIRE, "agent");
            xb_add(&bar[XB_XGEN(b.x)], 1u);
            asm volatile("s_waitcnt vmcnt(0)" ::: "memory");
        } else {
            XB_SPIN(xb_ld(&bar[XB_XGEN(b.x)]) == gen, bar);
            __builtin_amdgcn_fence(__ATOMIC_ACQUIRE, "agent");
            asm volatile("s_waitcnt vmcnt(0)" ::: "memory");
        }
    }
    __syncthreads();
}


constexpr int NPHASE = 14;
template <class Epi> __device__ __forceinline__ void run_gemm(unsigned char* lds, const bf16_t* A, const bf16_t* Bt, int M, int N, int K, const Epi& E) {
    pg8::Gemm g{A, Bt, M, N, K}; pg8::StaticOrder S; S.init(M, N, (int)gridDim.x, (int)blockIdx.x);
    pg8::gemm_phase<Epi, pg8::StaticOrder, true, true>((PG8_LAS unsigned char*)lds, g, S, E);
}
__global__ void __launch_bounds__(NT, 2) fwd_kernel(Params p) {
    extern __shared__ __attribute__((aligned(16))) unsigned char lds[];
    cg::grid_group grid = cg::this_grid();
    const int lo = p.ph_lo, hi = p.ph_hi;
    unsigned char* ws = p.ws;
    if (lo < 0) grid.sync();
    if (threadIdx.x == 0) *(uint4*)(lds + LDS_BYTES - 16) = make_uint4(0u, 0u, 0u, 0u);
    __syncthreads();
    XcdBarrier xbar = xcd_barrier_post((unsigned*)(ws + OFF_BAR), (volatile LAS unsigned*)((LAS unsigned char*)lds + (LDS_BYTES - 16)));
#ifndef PH_MASK
#define PH_MASK 0xffff
#endif
#ifndef REP_MASK
#define REP_MASK 0
#endif
#define IN(k) ((((PH_MASK) >> (k)) & 1) && lo <= (k) && (k) < hi)
#define REP(k, stmt) do { if (IN(k)) { const int nrep_ = 1 + ((REP_MASK >> (k)) & 1); _Pragma("unroll 1") for (int rep_ = 0; rep_ < nrep_; ++rep_) { if (rep_) xcd_barrier(xbar); stmt; } } } while (0)
#define SEAM(k) do { if (IN(k) && IN((k) + 1)) xcd_barrier(xbar); } while (0)
    REP(0, phase_prologue(p, lds));
    SEAM(0);
    REP(1, phase_prenorm(p));
    SEAM(1);
    { pg8::EpiProj E{(bf16_t*)(ws + OFF_PGDN), (bf16_t*)(ws + OFF_PZ), (bf16_t*)(ws + OFF_PHY), (float*)(ws + OFF_GATES)};
        REP(2, run_gemm(lds, (const bf16_t*)(ws + OFF_H), (const bf16_t*)(ws + OFF_WIN), MALL, N1, DM, E)); }
    SEAM(2);
#pragma unroll 1
    for (int rep_ = 0; rep_ < 1 + ((REP_MASK >> 3) & 1); ++rep_) {
    if (IN(3)) phase_hy1(p, lds);
    SEAM(3);
    if (IN(4)) phase_hy2(p, lds);
    SEAM(4);
    if (IN(5)) phase_hy3(p, lds);
    SEAM(5);
    }
    REP(6, phase_gdn_prep(p, lds));
    SEAM(6);
    REP(7, phase_gdn_scan(p, lds));
    SEAM(7);
    REP(8, phase_gdn_out(p));
    SEAM(8);
    { pg8::EpiPlain E{(bf16_t*)(ws + OFF_OUT), DM};
        REP(9, run_gemm(lds, (const bf16_t*)(ws + OFF_H), (const bf16_t*)(ws + OFF_WOUT), MLAT, DM, DM, E)); }
    SEAM(9);
    REP(10, phase_postmix(p));
    SEAM(10);
    { pg8::EpiSwiglu E{(bf16_t*)(ws + OFF_ACT), DFF};
        REP(11, run_gemm(lds, (const bf16_t*)(ws + OFF_H), (const bf16_t*)(ws + OFF_WGU), MLAT, 2 * DFF, DM, E)); }
    SEAM(11);
    { pg8::EpiPlain E{(bf16_t*)(ws + OFF_FF), DM};
        REP(12, run_gemm(lds, (const bf16_t*)(ws + OFF_ACT), (const bf16_t*)(ws + OFF_WDOWN), MLAT, DM, DFF, E)); }
    SEAM(12);
    if (IN(13)) phase_final(p);
#undef IN
#undef REP
#undef SEAM
}

extern "C" void kernel_launch(void* const* d_in, const int* in_sizes, int n_in, void* d_out, int out_size, void* d_ws, size_t ws_size, hipStream_t stream) {
    static int grid = 0;
    if (grid == 0) {
        if (n_in != 32 || ws_size < WS_TOTAL) { fprintf(stderr, "kernel_launch: need 32 inputs and %zu bytes of workspace (got %d, %zu)\n", (size_t)WS_TOTAL, n_in, ws_size); grid = -1; return; }
        int dev = 0, cus = 0, per_cu = 0;
        hipGetDevice(&dev); hipDeviceGetAttribute(&cus, hipDeviceAttributeMultiprocessorCount, dev);
        if (hipFuncSetAttribute((const void*)fwd_kernel, hipFuncAttributeMaxDynamicSharedMemorySize, LDS_BYTES) != hipSuccess) { fprintf(stderr, "kernel_launch: hipFuncSetAttribute failed\n"); grid = -1; return; }
        if (hipOccupancyMaxActiveBlocksPerMultiprocessor(&per_cu, (const void*)fwd_kernel, NT, LDS_BYTES) != hipSuccess || per_cu < 1) { fprintf(stderr, "kernel_launch: occupancy query gave %d\n", per_cu); per_cu = 1; }
        (void)hipGetLastError();
        grid = cus * per_cu;
    }
    if (grid < 0) return;
    if (hipMemsetAsync((unsigned char*)d_ws + OFF_BAR, 0, XCD_BAR_WORDS * 4, stream) != hipSuccess) { fprintf(stderr, "kernel_launch: memset of the barrier words failed\n"); return; }
    Params p{};
    for (int i = 0; i < 32; ++i) p.in[i] = (const float*)d_in[i];
    p.out = (float*)d_out; p.ws = (unsigned char*)d_ws;
#if MULTI_LAUNCH
    for (int ph = 0; ph < NPHASE; ++ph) { p.ph_lo = ph; p.ph_hi = ph + 1;
        hipLaunchKernelGGL(fwd_kernel, dim3(grid), dim3(NT), LDS_BYTES, stream, p); }
#else
    p.ph_lo = 0; p.ph_hi = NPHASE;
    void* args[] = {&p};
    hipError_t e = hipLaunchCooperativeKernel((const void*)fwd_kernel, dim3(grid), dim3(NT), args, LDS_BYTES, stream);
    if (e != hipSuccess) fprintf(stderr, "cooperative launch failed: %s (grid %d)\n", hipGetErrorString(e), grid);
#endif
}
```

```cpp
#include <hip/hip_runtime.h>
#include <hip/hip_cooperative_groups.h>
#include <cstdio>
#include <cstdint>
namespace cg = cooperative_groups;

#ifndef MULTI_LAUNCH
#define MULTI_LAUNCH 0
#endif

__device__ __forceinline__ int otid() { int t = threadIdx.x; asm volatile("" : "+v"(t)); return t; }

#undef MULTI_LAUNCH
#define MULTI_LAUNCH 0
#define REP_MASK 0
namespace pg8 {
#define PG8_LAS __attribute__((address_space(3)))
typedef unsigned short bf16_t;
typedef short bf16x8 __attribute__((ext_vector_type(8)));
typedef float f32x4 __attribute__((ext_vector_type(4)));
typedef unsigned u32x4 __attribute__((ext_vector_type(4)));
constexpr int BM = 256, BK = 64, HALF = 128, HTB = HALF * BK * 2  , STAGE_BYTES = 8 * HTB, NXCD = 8, WGM = 8;

__host__ __device__ __forceinline__ int lds_byte(int r, int c) { const int st = (r >> 4) * 2 + (c >> 5), rr = r & 15, cc = c & 31, ob = rr * 64 + cc * 2; return st * 1024 + (ob ^ (((ob >> 9) & 1) << 5)); }
__host__ __device__ __forceinline__ void stage_rc(int b, int& R, int& C) { const int st = b / 1024, sb = b % 1024, swz = sb ^ (((sb >> 9) & 1) << 5); R = (st >> 1) * 16 + swz / 64; C = (st & 1) * 32 + (swz % 64) / 2; }
__host__ __device__ __forceinline__ int perm32(int rho) { const int n = rho >> 4, i = rho & 15; return 8 * (i >> 2) + 4 * n + (i & 3); }

struct Unit { int pm, pn; };
struct Gemm { const bf16_t* A; const bf16_t* Bt; int M, N, K; };

struct StaticOrder {
    int nM, nN, nwg, G, c;
    __host__ __device__ void init(int M, int N, int G_, int c_) { nM = M / BM; nN = N / BM; nwg = nM * nN; G = G_; c = c_; }
    __host__ __device__ bool next(int i, Unit& u) const {
        const long L = (long)i * G + c; if (L >= nwg) return false;
        int wgid = (int)L; { const int q = nwg / NXCD, r = nwg % NXCD, xcd = wgid % NXCD, off = wgid / NXCD; wgid = (xcd < r ? xcd * (q + 1) : r * (q + 1) + (xcd - r) * q) + off; }
        const int nig = WGM * nN, gid = wgid / nig, fm = gid * WGM, gsz = (nM - fm) < WGM ? (nM - fm) : WGM;
        u.pm = fm + ((wgid % nig) % gsz); u.pn = (wgid % nig) / gsz; return true;
    }
    __device__ __forceinline__ void a_ready(const Unit&) const {}
    __device__ __forceinline__ void done(const Unit&) const {}
};

__device__ __forceinline__ unsigned cvt_pk_bf16(float lo, float hi) { unsigned r; asm volatile("v_cvt_pk_bf16_f32 %0, %1, %2" : "=v"(r) : "v"(lo), "v"(hi)); return r; }
__device__ __forceinline__ float silu_f(float x) { return x * __builtin_amdgcn_rcpf(1.0f + __expf(-x)); }

struct EpiPlain {
    static constexpr bool PERM = true, AFTER_DRAIN = false;
    bf16_t* O; int ldc;
    __device__ __forceinline__ void operator()(const f32x4 (&acc)[2][2][4][2], const Unit& u, int wr, int wc, int fr, int fq) const {
        const int row0 = u.pm * BM + wr * 64 + fr, col0 = u.pn * BM + wc * 32 + 8 * fq;
#pragma unroll
        for (int ai = 0; ai < 2; ++ai)
#pragma unroll
            for (int m = 0; m < 4; ++m) { bf16_t* rowp = O + (size_t)(row0 + ai * HALF + m * 16) * ldc + col0;
#pragma unroll
                for (int bj = 0; bj < 2; ++bj) { const f32x4 v0 = acc[ai][bj][m][0], v1 = acc[ai][bj][m][1];
                    u32x4 w; w.x = cvt_pk_bf16(v0[0], v0[1]); w.y = cvt_pk_bf16(v0[2], v0[3]); w.z = cvt_pk_bf16(v1[0], v1[1]); w.w = cvt_pk_bf16(v1[2], v1[3]);
                    *(u32x4*)(rowp + bj * HALF) = w; } }
    }
};
struct EpiProj {
    static constexpr bool PERM = true, AFTER_DRAIN = false;
    bf16_t* pgdn; bf16_t* pz; bf16_t* phy; float* gates;
    __device__ __forceinline__ void operator()(const f32x4 (&acc)[2][2][4][2], const Unit& u, int wr, int wc, int fr, int fq) const {
        const int row0 = u.pm * BM + wr * 64 + fr, pn = u.pn;
        if (pn < 28) {
            bf16_t* base; int ld, colt;
            if (pn < 12) { base = pgdn; ld = 3072; colt = pn * 256; }
            else if (pn < 16) { base = pz; ld = 1024; colt = (pn - 12) * 256; }
            else { base = phy; ld = 3072; colt = (pn - 16) * 256; }
            const int col0 = colt + wc * 32 + 8 * fq;
#pragma unroll
            for (int ai = 0; ai < 2; ++ai)
#pragma unroll
                for (int m = 0; m < 4; ++m) { bf16_t* rowp = base + (size_t)(row0 + ai * HALF + m * 16) * ld + col0;
#pragma unroll
                    for (int bj = 0; bj < 2; ++bj) { const f32x4 v0 = acc[ai][bj][m][0], v1 = acc[ai][bj][m][1];
                        u32x4 w; w.x = cvt_pk_bf16(v0[0], v0[1]); w.y = cvt_pk_bf16(v0[2], v0[3]); w.z = cvt_pk_bf16(v1[0], v1[1]); w.w = cvt_pk_bf16(v1[2], v1[3]);
                        *(u32x4*)(rowp + bj * HALF) = w; } }
        } else if (wc == 0) {
#pragma unroll
            for (int ai = 0; ai < 2; ++ai)
#pragma unroll
                for (int m = 0; m < 4; ++m) { float* rowp = gates + (size_t)(row0 + ai * HALF + m * 16) * 32 + 8 * fq;
                    *(f32x4*)(rowp) = acc[ai][0][m][0]; *(f32x4*)(rowp + 4) = acc[ai][0][m][1]; }
        }
    }
};
struct EpiSwiglu {
    static constexpr bool PERM = true, AFTER_DRAIN = false;
    bf16_t* O; int ldc;
    __device__ __forceinline__ void operator()(const f32x4 (&acc)[2][2][4][2], const Unit& u, int wr, int wc, int fr, int fq) const {
        const int row0 = u.pm * BM + wr * 64 + fr, col0 = u.pn * HALF + wc * 32 + 8 * fq;
#pragma unroll
        for (int ai = 0; ai < 2; ++ai)
#pragma unroll
            for (int m = 0; m < 4; ++m) { bf16_t* rowp = O + (size_t)(row0 + ai * HALF + m * 16) * ldc + col0;
                const f32x4 g0 = acc[ai][0][m][0], g1 = acc[ai][0][m][1], u0 = acc[ai][1][m][0], u1 = acc[ai][1][m][1];
                u32x4 w;
                w.x = cvt_pk_bf16(silu_f(g0[0]) * u0[0], silu_f(g0[1]) * u0[1]); w.y = cvt_pk_bf16(silu_f(g0[2]) * u0[2], silu_f(g0[3]) * u0[3]);
                w.z = cvt_pk_bf16(silu_f(g1[0]) * u1[0], silu_f(g1[1]) * u1[1]); w.w = cvt_pk_bf16(silu_f(g1[2]) * u1[2], silu_f(g1[3]) * u1[3]);
                *(u32x4*)(rowp) = w; }
    }
};

template <class Epi, class Sched, bool ALIGN_EPI = false, bool SP2 = false>
__device__ __forceinline__ void gemm_phase(PG8_LAS unsigned char* lds, const Gemm g, const Sched& S, const Epi& E) {
    const int tid = otid(), wid = __builtin_amdgcn_readfirstlane(tid >> 6), lane = tid & 63, wr = wid >> 2, wc = wid & 3, fr = lane & 15, fq = lane >> 4;
    const int K = g.K, nt = K / BK;
    unsigned voffA[2], voffB[2];
#pragma unroll
    for (int i = 0; i < 2; ++i) { int R, C; stage_rc(tid * 16 + i * 8192, R, C); const int Rb = Epi::PERM ? ((R & ~31) + perm32(R & 31)) : R;
        voffA[i] = (unsigned)(R * K + C) * 2u; voffB[i] = (unsigned)(Rb * K + C) * 2u; }
    const size_t kstep = (size_t)(BK * 2);
    const size_t hstep = (size_t)HALF * K * 2;
    const size_t tstep = 2 * hstep;
    const unsigned ldsw = (unsigned)wid * 1024u;
    const int aoff = lds_byte(wr * 64 + fr, fq * 8), boff = lds_byte(wc * 32 + fr, fq * 8);
#define PG8_SA(b, h) (((b) * 2 + (h)) * HTB)
#define PG8_SB(b, h) ((4 + (b) * 2 + (h)) * HTB)
#define PG8_STAGE(bufoff, gbase, voff) do { _Pragma("unroll") for (int _i = 0; _i < 2; ++_i) \
        __builtin_amdgcn_global_load_lds((const unsigned*)((const char*)(gbase) + (voff)[_i]), (PG8_LAS unsigned*)(lds + (bufoff) + ldsw + _i * 8192), 16, 0, 0); } while (0)
#define PG8_LDA(dst, b, h) do { _Pragma("unroll") for (int m = 0; m < 4; ++m) _Pragma("unroll") for (int k = 0; k < 2; ++k) dst[m][k] = *(const PG8_LAS bf16x8*)(lds + PG8_SA(b, h) + aoff + m * 2048 + k * 1024); } while (0)
#define PG8_LDB(dst, b, h) do { _Pragma("unroll") for (int n = 0; n < 2; ++n) _Pragma("unroll") for (int k = 0; k < 2; ++k) dst[n][k] = *(const PG8_LAS bf16x8*)(lds + PG8_SB(b, h) + boff + n * 2048 + k * 1024); } while (0)
#define PG8_MMA(ai, bj, At, Bt) do { __builtin_amdgcn_s_setprio(1); _Pragma("unroll") for (int m = 0; m < 4; ++m) _Pragma("unroll") for (int n = 0; n < 2; ++n) _Pragma("unroll") for (int k = 0; k < 2; ++k) \
        acc[ai][bj][m][n] = __builtin_amdgcn_mfma_f32_16x16x32_bf16(Bt[n][k], At[m][k], acc[ai][bj][m][n], 0, 0, 0); __builtin_amdgcn_s_setprio(0); } while (0)
#define PG8_WAIT_V(n) asm volatile("s_waitcnt vmcnt(" #n ")" ::: "memory")
#define PG8_WAIT_L(n) asm volatile("s_waitcnt lgkmcnt(" #n ")" ::: "memory")
#define PG8_BAR __builtin_amdgcn_s_barrier()
#define PG8_SCHED __builtin_amdgcn_sched_barrier(0)
    Unit cur, nxt; int ui = 0;
    if (!S.next(0, cur)) return;
    f32x4 acc[2][2][4][2];
#pragma unroll
    for (int a = 0; a < 2; ++a)
#pragma unroll
        for (int b = 0; b < 2; ++b)
#pragma unroll
            for (int m = 0; m < 4; ++m)
#pragma unroll
                for (int n = 0; n < 2; ++n) acc[a][b][m][n] = (f32x4){0.f, 0.f, 0.f, 0.f};
    bf16x8 At[4][2], B0[2][2], B1[2][2];
    const char* cA = (const char*)g.A + (size_t)cur.pm * tstep; const char* cB = (const char*)g.Bt + (size_t)cur.pn * tstep;
    S.a_ready(cur);
    if constexpr (SP2) {
        PG8_STAGE(PG8_SB(0, 0), cB, voffB); PG8_STAGE(PG8_SB(0, 1), cB + hstep, voffB); PG8_STAGE(PG8_SA(0, 0), cA, voffA); PG8_STAGE(PG8_SA(0, 1), cA + hstep, voffA);
        if (wr == 1) PG8_BAR;
        PG8_WAIT_V(2); PG8_BAR;
        PG8_STAGE(PG8_SB(1, 0), cB + kstep, voffB); PG8_STAGE(PG8_SA(1, 0), cA + kstep, voffA); PG8_STAGE(PG8_SB(1, 1), cB + hstep + kstep, voffB);
        PG8_WAIT_V(6); PG8_BAR;
    } else {
        PG8_STAGE(PG8_SB(0, 0), cB, voffB); PG8_STAGE(PG8_SA(0, 0), cA, voffA); PG8_STAGE(PG8_SB(0, 1), cB + hstep, voffB); PG8_STAGE(PG8_SA(0, 1), cA + hstep, voffA);
        if (wr == 1) PG8_BAR;
        PG8_WAIT_V(4); PG8_BAR;
        PG8_STAGE(PG8_SB(1, 0), cB + kstep, voffB); PG8_STAGE(PG8_SA(1, 0), cA + kstep, voffA); PG8_STAGE(PG8_SB(1, 1), cB + hstep + kstep, voffB);
        PG8_WAIT_V(6); PG8_BAR;
    }
    for (;;) {
        const bool has_next = S.next(ui + 1, nxt);
        const char* nA = has_next ? (const char*)g.A + (size_t)nxt.pm * tstep : cA; const char* nB = has_next ? (const char*)g.Bt + (size_t)nxt.pn * tstep : cB;
        for (int t = 0; t < nt; t += 2) {
            const bool last = (t == nt - 2);
            const char* a1 = cA + (size_t)(t + 1) * kstep;
            const char* a2 = last ? nA : cA + (size_t)(t + 2) * kstep; const char* b2 = last ? nB : cB + (size_t)(t + 2) * kstep;
            const char* a3 = a2 + kstep; const char* b3 = b2 + kstep;
            if (last && has_next) S.a_ready(nxt);
            if constexpr (SP2) {
            PG8_LDB(B0, 0, 0); PG8_LDB(B1, 0, 1); PG8_SCHED; PG8_LDA(At, 0, 0); PG8_STAGE(PG8_SA(1, 1), a1 + hstep, voffA);
            PG8_WAIT_V(8); PG8_WAIT_L(0); PG8_BAR; PG8_MMA(0, 0, At, B0); PG8_MMA(0, 1, At, B1); PG8_BAR; PG8_SCHED;
            PG8_LDA(At, 0, 1); PG8_STAGE(PG8_SB(0, 0), b2, voffB); PG8_STAGE(PG8_SB(0, 1), b2 + hstep, voffB); PG8_STAGE(PG8_SA(0, 0), a2, voffA);
            PG8_WAIT_V(8); PG8_WAIT_L(0); PG8_BAR; PG8_MMA(1, 0, At, B0); PG8_MMA(1, 1, At, B1); PG8_BAR; PG8_SCHED;
            PG8_LDB(B0, 1, 0); PG8_LDB(B1, 1, 1); PG8_SCHED; PG8_LDA(At, 1, 0); PG8_STAGE(PG8_SA(0, 1), a2 + hstep, voffA);
            PG8_WAIT_V(8); PG8_WAIT_L(0); PG8_BAR; PG8_MMA(0, 0, At, B0); PG8_MMA(0, 1, At, B1); PG8_BAR; PG8_SCHED;
            PG8_LDA(At, 1, 1); PG8_STAGE(PG8_SB(1, 0), b3, voffB); PG8_STAGE(PG8_SB(1, 1), b3 + hstep, voffB); PG8_STAGE(PG8_SA(1, 0), a3, voffA);
            PG8_WAIT_V(8); PG8_WAIT_L(0); PG8_BAR; PG8_MMA(1, 0, At, B0); PG8_MMA(1, 1, At, B1); PG8_BAR; PG8_SCHED;
            } else {
            PG8_LDB(B0, 0, 0); PG8_SCHED; PG8_LDA(At, 0, 0); PG8_STAGE(PG8_SA(1, 1), a1 + hstep, voffA);
            PG8_WAIT_L(8); PG8_BAR; PG8_WAIT_L(0); PG8_MMA(0, 0, At, B0); PG8_BAR; PG8_SCHED;
            PG8_LDB(B1, 0, 1); PG8_STAGE(PG8_SB(0, 0), b2, voffB);
            PG8_BAR; PG8_WAIT_L(0); PG8_MMA(0, 1, At, B1); PG8_BAR;
            PG8_LDA(At, 0, 1); PG8_STAGE(PG8_SA(0, 0), a2, voffA);
            PG8_BAR; PG8_WAIT_L(0); PG8_MMA(1, 0, At, B0); PG8_BAR; PG8_SCHED;
            PG8_STAGE(PG8_SB(0, 1), b2 + hstep, voffB);
            PG8_WAIT_V(6); PG8_BAR; PG8_MMA(1, 1, At, B1); PG8_BAR;
            PG8_LDB(B0, 1, 0); PG8_SCHED; PG8_LDA(At, 1, 0); PG8_STAGE(PG8_SA(0, 1), a2 + hstep, voffA);
            PG8_WAIT_L(8); PG8_BAR; PG8_WAIT_L(0); PG8_MMA(0, 0, At, B0); PG8_BAR; PG8_SCHED;
            PG8_LDB(B1, 1, 1); PG8_STAGE(PG8_SB(1, 0), b3, voffB);
            PG8_BAR; PG8_WAIT_L(0); PG8_MMA(0, 1, At, B1); PG8_BAR;
            PG8_LDA(At, 1, 1); PG8_STAGE(PG8_SA(1, 0), a3, voffA);
            PG8_BAR; PG8_WAIT_L(0); PG8_MMA(1, 0, At, B0); PG8_BAR; PG8_SCHED;
            PG8_STAGE(PG8_SB(1, 1), b3 + hstep, voffB);
            PG8_WAIT_V(6); PG8_BAR; PG8_MMA(1, 1, At, B1); PG8_BAR;
            }
        }
        if constexpr (ALIGN_EPI) { if (wr == 0) PG8_BAR; }
        if constexpr (!Epi::AFTER_DRAIN) { E(acc, cur, wr, wc, fr, fq); S.done(cur); }
        if (!has_next) break;
#pragma unroll
        for (int a = 0; a < 2; ++a)
#pragma unroll
            for (int b = 0; b < 2; ++b)
#pragma unroll
                for (int m = 0; m < 4; ++m)
#pragma unroll
                    for (int n = 0; n < 2; ++n) acc[a][b][m][n] = (f32x4){0.f, 0.f, 0.f, 0.f};
        cur = nxt; cA = nA; cB = nB; ++ui;
        if constexpr (ALIGN_EPI) { if (wr == 1) PG8_BAR; }
    }
    PG8_WAIT_V(0);
    if constexpr (!ALIGN_EPI) { if (wr == 0) PG8_BAR; }
    PG8_BAR;
    if constexpr (Epi::AFTER_DRAIN) { E.fused(acc, cur, wr, wc, fr, fq, lds, wid, lane); S.done(cur); }
#undef PG8_SA
#undef PG8_SB
#undef PG8_STAGE
#undef PG8_LDA
#undef PG8_LDB
#undef PG8_MMA
#undef PG8_WAIT_V
#undef PG8_WAIT_L
#undef PG8_BAR
#undef PG8_SCHED
}
}

typedef unsigned short bf16_t;
typedef short bf16x8 __attribute__((ext_vector_type(8)));
typedef float f32x4 __attribute__((ext_vector_type(4)));
constexpr int NT = 512;
constexpr int DM = 2048, NB = 4, SL = 8192, CL = 256, MLAT = NB * SL, MCTX = NB * CL, MALL = MLAT + MCTX;
constexpr int NHD = 8, HD = 128, CHK = 64, DFF = 5632, N1 = 7424;
constexpr int NCHUNK = 132;
constexpr int NITEM = NB * NCHUNK * NHD;
constexpr float EPSF = 1e-6f;
constexpr int LDS_BYTES = 156 * 1024;

constexpr size_t al256(size_t x) { return (x + 255) & ~(size_t)255; }
constexpr size_t OFF_MOD = 0;
constexpr size_t OFF_GSC = OFF_MOD + al256((size_t)5 * 6 * DM * 4);
constexpr size_t OFF_GATES = OFF_GSC + al256((size_t)NITEM * 2 * 192 * 4);
constexpr size_t OFF_WIN = OFF_GATES + al256((size_t)MALL * 32 * 4);
constexpr size_t OFF_WOUT = OFF_WIN + al256((size_t)N1 * DM * 2);
constexpr size_t OFF_WGU = OFF_WOUT + al256((size_t)DM * DM * 2);
constexpr size_t OFF_WDOWN = OFF_WGU + al256((size_t)2 * DFF * DM * 2);
constexpr size_t OFF_H = OFF_WDOWN + al256((size_t)DM * DFF * 2);
constexpr size_t OFF_PGDN = OFF_H + al256((size_t)MALL * DM * 2);
constexpr size_t OFF_PZ = OFF_PGDN + al256((size_t)MALL * 3072 * 2);
constexpr size_t OFF_PHY = OFF_PZ + al256((size_t)MALL * 1024 * 2);
constexpr size_t OFF_UHT = OFF_PHY + al256((size_t)MALL * 3072 * 2);
constexpr size_t OFF_TAPS = OFF_UHT + al256((size_t)NB * 1024 * SL * 4);
constexpr size_t END_TAPS = OFF_TAPS + al256((size_t)1024 * 16384 * 4);
constexpr size_t OFF_KSPEC = END_TAPS;
constexpr size_t OFF_KT = OFF_PHY;
constexpr size_t OFF_Q = OFF_KT + (size_t)NITEM * 16384;
constexpr size_t OFF_UW = OFF_Q + (size_t)NITEM * 16384;
constexpr size_t OFF_ATT = OFF_UW + (size_t)NITEM * 2 * 32768;
constexpr size_t END_G2 = OFF_ATT + (size_t)NITEM * 2 * 8192;
constexpr size_t WS_END = END_G2 > END_TAPS ? END_G2 : END_TAPS;
constexpr size_t OFF_S1B = OFF_UHT;
constexpr size_t OFF_OF = OFF_PGDN;
constexpr size_t OFF_OB = OFF_PGDN + (size_t)MLAT * 1024 * 2;
constexpr size_t OFF_OUT = OFF_PGDN;
constexpr size_t OFF_ACT = OFF_PGDN;
constexpr size_t OFF_FF = OFF_H;
static_assert((size_t)MLAT * DFF * 2 <= OFF_UHT - OFF_PGDN, "act overlay");
constexpr size_t OFF_BAR = al256(WS_END);
constexpr size_t WS_TOTAL = OFF_BAR + 16384;
static_assert(WS_TOTAL <= ((size_t)1 << 30), "workspace over 1 GiB");

struct Params { const float* in[32]; float* out; unsigned char* ws; int ph_lo, ph_hi; };

__device__ __forceinline__ float bf_lo(unsigned w) { return __uint_as_float(w << 16); }
__device__ __forceinline__ float bf_hi(unsigned w) { return __uint_as_float(w & 0xffff0000u); }
__device__ __forceinline__ float bf2f(bf16_t v) { return __uint_as_float(((unsigned)v) << 16); }
__device__ __forceinline__ unsigned pk2(float lo, float hi) { return pg8::cvt_pk_bf16(lo, hi); }
__device__ __forceinline__ unsigned pk2_c(float lo, float hi) { unsigned a = __float_as_uint(lo), b = __float_as_uint(hi);
    a += 0x7fffu + ((a >> 16) & 1u); b += 0x7fffu + ((b >> 16) & 1u); return (a >> 16) | (b & 0xffff0000u); }
__device__ __forceinline__ bf16_t f2bf(float f) { return (bf16_t)(pk2(f, 0.f) & 0xffffu); }
__device__ __forceinline__ float silu(float x) { return x * __builtin_amdgcn_rcpf(1.0f + __expf(-x)); }
__device__ __forceinline__ void unpack8(const uint4 w, float (&f)[8]) {
    f[0] = bf_lo(w.x); f[1] = bf_hi(w.x); f[2] = bf_lo(w.y); f[3] = bf_hi(w.y); f[4] = bf_lo(w.z); f[5] = bf_hi(w.z); f[6] = bf_lo(w.w); f[7] = bf_hi(w.w);
}
__device__ __forceinline__ uint4 pack8(const float (&f)[8]) { uint4 w; w.x = pk2(f[0], f[1]); w.y = pk2(f[2], f[3]); w.z = pk2(f[4], f[5]); w.w = pk2(f[6], f[7]); return w; }
__device__ __forceinline__ float fsin(float x) { return __builtin_amdgcn_sinf(__builtin_amdgcn_fractf(x * 0.15915494309189535f)); }
__device__ __forceinline__ float wave_sum(float v) {
#pragma unroll
    for (int o = 32; o >= 1; o >>= 1) v += __shfl_xor(v, o);
    return v;
}

__device__ __forceinline__ void adaln_block(const Params& p, unsigned char* lds, int cb) {
    float* sc = (float*)lds;
    float* red = (float*)(lds + 5 * DM * 4);
    const int tid = otid();
    const float* c = p.in[1]; const float* cc = p.in[3]; const float* wm = p.in[4]; const float* bm = p.in[5];
    for (int i = tid; i < 5 * DM; i += NT) { const int r = i / DM, k = i % DM; const float v = r < 4 ? c[r * DM + k] : cc[k]; sc[i] = silu(v); }
    __syncthreads();
    const int l4 = tid % 12, kg = tid / 12;
    if (tid < 504) {
        float acc[5][4];
#pragma unroll
        for (int r = 0; r < 5; ++r)
#pragma unroll
            for (int j = 0; j < 4; ++j) acc[r][j] = 0.f;
#pragma unroll 7
        for (int k = kg; k < DM; k += 42) {
            const float4 w = *(const float4*)(wm + (size_t)k * (6 * DM) + cb * 48 + l4 * 4);
#pragma unroll
            for (int r = 0; r < 5; ++r) { const float s = sc[r * DM + k]; acc[r][0] += s * w.x; acc[r][1] += s * w.y; acc[r][2] += s * w.z; acc[r][3] += s * w.w; }
        }
#pragma unroll
        for (int r = 0; r < 5; ++r)
#pragma unroll
            for (int j = 0; j < 4; ++j) red[(kg * 5 + r) * 48 + l4 * 4 + j] = acc[r][j];
    }
    __syncthreads();
    if (tid < 240) {
        const int r = tid / 48, col = tid % 48; float s = 0.f;
        for (int g = 0; g < 42; ++g) s += red[(g * 5 + r) * 48 + col];
        float* MOD = (float*)(p.ws + OFF_MOD);
        MOD[r * (6 * DM) + cb * 48 + col] = s + bm[cb * 48 + col];
    }
    __syncthreads();
}

__device__ __forceinline__ void taps_block(const Params& p, unsigned char* lds, int tile) {
    float* zs = (float*)lds;
    float* h1 = zs + 32 * 33;
    float* h2 = h1 + 32 * 65;
    float* h3 = h2 + 32 * 65;
    float* w4s = (float*)(lds + 32768);
    const int tid = otid(), t0 = tile * 32;
    const float* w1 = p.in[17]; const float* b1 = p.in[18]; const float* f1 = p.in[19];
    const float* w2 = p.in[20]; const float* b2 = p.in[21]; const float* f2 = p.in[22];
    const float* w3 = p.in[23]; const float* b3 = p.in[24]; const float* f3 = p.in[25];
    const float* w4 = p.in[26]; const float* hb = p.in[27];
    float* ws1 = w4s; float* ws2 = w4s + 2112; float* ws3 = ws2 + 4096;
    for (int i = tid; i < 2112 / 4; i += NT) *(float4*)(ws1 + 4 * i) = *(const float4*)(w1 + 4 * i);
    for (int i = tid; i < 1024; i += NT) { *(float4*)(ws2 + 4 * i) = *(const float4*)(w2 + 4 * i); *(float4*)(ws3 + 4 * i) = *(const float4*)(w3 + 4 * i); }
    for (int i = tid; i < 32 * 33; i += NT) {
        const int r = i / 33, f = i % 33; const float t = (float)(t0 + r);
        float v;
        if (f == 0) v = t / 8191.0f;
        else { const int bi = (f - 1) & 15; const float fr = 1e-4f + (float)bi * ((15.0f - 1e-4f) / 15.0f); const float rev = t * fr * (1.0f / 8192.0f);
            v = (f <= 16) ? __builtin_amdgcn_cosf(__builtin_amdgcn_fractf(rev)) : -__builtin_amdgcn_sinf(__builtin_amdgcn_fractf(rev)); }
        zs[i] = v;
    }
    __syncthreads();
    const int row = tid & 31, ug = tid >> 5;
    {   float a[4] = {0.f, 0.f, 0.f, 0.f};
#pragma unroll 3
        for (int k = 0; k < 33; ++k) { const float z = zs[row * 33 + k]; const float4 w = *(const float4*)(ws1 + k * 64 + ug * 4); a[0] += z * w.x; a[1] += z * w.y; a[2] += z * w.z; a[3] += z * w.w; }
#pragma unroll
        for (int j = 0; j < 4; ++j) h1[row * 65 + ug * 4 + j] = fsin(f1[ug * 4 + j] * (a[j] + b1[ug * 4 + j]));
    }
    __syncthreads();
    {   float a[4] = {0.f, 0.f, 0.f, 0.f};
#pragma unroll 4
        for (int k = 0; k < 64; ++k) { const float z = h1[row * 65 + k]; const float4 w = *(const float4*)(ws2 + k * 64 + ug * 4); a[0] += z * w.x; a[1] += z * w.y; a[2] += z * w.z; a[3] += z * w.w; }
#pragma unroll
        for (int j = 0; j < 4; ++j) h2[row * 65 + ug * 4 + j] = fsin(f2[ug * 4 + j] * (a[j] + b2[ug * 4 + j]));
    }
    __syncthreads();
    {   float a[4] = {0.f, 0.f, 0.f, 0.f};
#pragma unroll 4
        for (int k = 0; k < 64; ++k) { const float z = h2[row * 65 + k]; const float4 w = *(const float4*)(ws3 + k * 64 + ug * 4); a[0] += z * w.x; a[1] += z * w.y; a[2] += z * w.z; a[3] += z * w.w; }
#pragma unroll
        for (int j = 0; j < 4; ++j) h3[row * 65 + ug * 4 + j] = fsin(f3[ug * 4 + j] * (a[j] + b3[ug * 4 + j]));
    }
    __syncthreads();
    bf16_t* Ah = (bf16_t*)(lds + 98304); bf16_t* Al = Ah + 32 * 72;
    {   float hv[4]; unsigned short hh[4], hl[4];
#pragma unroll
        for (int j = 0; j < 4; ++j) { hv[j] = h3[row * 65 + ug * 4 + j]; const unsigned u = pk2_c(hv[j], 0.f) & 0xffffu; hh[j] = (unsigned short)u; hl[j] = (unsigned short)(pk2_c(hv[j] - __uint_as_float(u << 16), 0.f) & 0xffffu); }
        uint2 wh, wl; wh.x = hh[0] | ((unsigned)hh[1] << 16); wh.y = hh[2] | ((unsigned)hh[3] << 16); wl.x = hl[0] | ((unsigned)hl[1] << 16); wl.y = hl[2] | ((unsigned)hl[3] << 16);
        *(uint2*)(Ah + row * 72 + ug * 4) = wh; *(uint2*)(Al + row * 72 + ug * 4) = wl; }
    float* TAPS = (float*)(p.ws + OFF_TAPS);
    const float mind = -3.0701134573253946f, maxd = -15.350567286626973f;
    const int lane = tid & 63, wid = __builtin_amdgcn_readfirstlane(tid >> 6), fr = lane & 15, fq = lane >> 4;
    for (int cc = 0; cc < 8; ++cc) {
        for (int i = tid; i < 64 * 64; i += NT) { const int k = i >> 6, c4 = (i & 63) * 4; *(float4*)(w4s + k * 256 + c4) = *(const float4*)(w4 + (size_t)k * 2048 + cc * 256 + c4); }
        __syncthreads();
#pragma unroll 1
        for (int nn = 0; nn < 2; ++nn) {
            const int nt = wid * 2 + nn;
            f32x4 acc[2]; acc[0] = (f32x4){0.f, 0.f, 0.f, 0.f}; acc[1] = (f32x4){0.f, 0.f, 0.f, 0.f};
#pragma unroll
            for (int ks = 0; ks < 2; ++ks) {
                bf16x8 bh, bl;
#pragma unroll
                for (int e = 0; e < 8; ++e) { const float x = w4s[(32 * ks + 8 * fq + e) * 256 + 16 * nt + fr]; const unsigned u = pk2_c(x, 0.f) & 0xffffu;
                    bh[e] = (short)u; bl[e] = (short)(pk2_c(x - __uint_as_float(u << 16), 0.f) & 0xffffu); }
#pragma unroll
                for (int mt = 0; mt < 2; ++mt) {
                    const bf16x8 ah = *(const bf16x8*)(Ah + (16 * mt + fr) * 72 + 32 * ks + 8 * fq), al = *(const bf16x8*)(Al + (16 * mt + fr) * 72 + 32 * ks + 8 * fq);
                    acc[mt] = __builtin_amdgcn_mfma_f32_16x16x32_bf16(ah, bh, acc[mt], 0, 0, 0);
                    acc[mt] = __builtin_amdgcn_mfma_f32_16x16x32_bf16(ah, bl, acc[mt], 0, 0, 0);
                    acc[mt] = __builtin_amdgcn_mfma_f32_16x16x32_bf16(al, bh, acc[mt], 0, 0, 0);
                }
            }
            const int c2 = cc * 256 + 16 * nt + fr, c = c2 & 1023;
            const float delta = fabsf(mind + (float)c * ((maxd - mind) / 1023.0f));
#pragma unroll
            for (int mt = 0; mt < 2; ++mt)
#pragma unroll
                for (int r = 0; r < 4; ++r) {
                    const int t = t0 + 16 * mt + 4 * fq + r; const float t01 = (float)t / 8191.0f;
                    float v = acc[mt][r] * __expf(-t01 * delta);
                    if (c2 < 1024) { if (t == 0) v += hb[c]; TAPS[(size_t)c * 16384 + t] = v; }
                    else { if (t == 0) TAPS[(size_t)c * 16384 + 8192] = 0.f; else TAPS[(size_t)c * 16384 + 16384 - t] = v; }
                }
        }
        __syncthreads();
    }
}

struct TDesc { const float* src; bf16_t* dst; int srcN, scol, K, kt, nt; };
__device__ __forceinline__ void transpose_decode(const Params& p, int idx, int tid, TDesc& d) {
    int mode, nK;
    if (idx < 928) { mode = 0; nK = 8; } else if (idx < 1184) { mode = 1; nK = 8; idx -= 928; } else if (idx < 2592) { mode = 2; nK = 8; idx -= 1184; } else { mode = 3; nK = 22; idx -= 2592; }
    d.kt = idx % nK; d.nt = idx / nK; d.K = (mode == 3) ? DFF : DM;
    d.dst = (bf16_t*)(p.ws + (mode == 0 ? OFF_WIN : mode == 1 ? OFF_WOUT : mode == 2 ? OFF_WGU : OFF_WDOWN));
    const int nc = (tid & 15) * 4, n = d.nt * 64 + nc;
    if (mode == 0) { d.src = p.in[10]; d.srcN = 7200; d.scol = (n < 3072) ? n : (n < 7168) ? n + 32 : (n < 7200) ? n - 4096 : -1; }
    else if (mode == 1) { d.src = p.in[28]; d.srcN = DM; d.scol = n; }
    else if (mode == 2) { const int pn = n >> 8, w = n & 255; d.src = (w < 128) ? p.in[29] : p.in[30]; d.srcN = DFF; d.scol = pn * 128 + (w & 127); }
    else { d.src = p.in[31]; d.srcN = DM; d.scol = n; }
}
__device__ __forceinline__ void transpose_load(const TDesc& d, int tid, float4 (&v)[8]) {
    const int kr = tid >> 4;
#pragma unroll
    for (int it = 0; it < 8; ++it) { v[it] = make_float4(0.f, 0.f, 0.f, 0.f); if (d.scol >= 0) v[it] = *(const float4*)(d.src + (size_t)(d.kt * 256 + kr + it * 32) * d.srcN + d.scol); }
}
__device__ __forceinline__ void transpose_store(const TDesc& d, int tid, const float4 (&v)[8], float* tile  ) {
    const int kr = tid >> 4, nc = (tid & 15) * 4;
#pragma unroll
    for (int it = 0; it < 8; ++it) { float* tp = tile + (kr + it * 32) * 65 + nc; tp[0] = v[it].x; tp[1] = v[it].y; tp[2] = v[it].z; tp[3] = v[it].w; }
    __syncthreads();
    {   const int nn = tid >> 3, k8 = (tid & 7) * 8;
#pragma unroll
        for (int w = 0; w < 4; ++w) { float f[8];
#pragma unroll
            for (int j = 0; j < 8; ++j) f[j] = tile[(k8 + 64 * w + j) * 65 + nn];
            *(uint4*)(d.dst + (size_t)(d.nt * 64 + nn) * d.K + d.kt * 256 + k8 + 64 * w) = pack8(f); }
    }
    __syncthreads();
}

__device__ __forceinline__ void phase_prologue(const Params& p, unsigned char* lds) {
    const int G = gridDim.x, bx = blockIdx.x;
#ifndef P0_MASK
#define P0_MASK 7
#endif
    if (P0_MASK & 1) for (int cb = bx; cb < 256; cb += G) adaln_block(p, lds, cb);
    if (P0_MASK & 2) for (int t = bx; t < 256; t += G) taps_block(p, lds, t);
    if (P0_MASK & 4) {
        const int tid = otid(); float4 v[8], vn[8]; TDesc d, dn; int i = bx;
        if (i < 3296) { transpose_decode(p, i, tid, d); transpose_load(d, tid, v); }
        for (; i < 3296; i += G) {
            if (i + G < 3296) { transpose_decode(p, i + G, tid, dn); transpose_load(dn, tid, vn); }
            transpose_store(d, tid, v, (float*)lds);
            d = dn;
#pragma unroll
            for (int it = 0; it < 8; ++it) v[it] = vn[it];
        }
    }
}

__device__ __forceinline__ void phase_prenorm(const Params& p) {
    const int tid_ = otid(), lane = tid_ & 63, wv = __builtin_amdgcn_readfirstlane(tid_ >> 6);
    const float* MOD = (const float*)(p.ws + OFF_MOD); const float* g = p.in[6];
    bf16_t* H = (bf16_t*)(p.ws + OFF_H);
    const int stride = gridDim.x * 8;
    float4 v[8], vn[8];
#define PRE_SRC(row_) ((row_) < MLAT ? p.in[0] + (size_t)(row_) * DM : p.in[2] + (size_t)((row_) - MLAT) * DM)
    int row = blockIdx.x * 8 + wv;
    if (row < MALL) { const float* src = PRE_SRC(row);
#pragma unroll
        for (int i = 0; i < 8; ++i) v[i] = *(const float4*)(src + 4 * (lane + 64 * i)); }
    for (; row < MALL; row += stride) {
        const int nxt = row + stride;
        if (nxt < MALL) { const float* src = PRE_SRC(nxt);
#pragma unroll
            for (int i = 0; i < 8; ++i) vn[i] = *(const float4*)(src + 4 * (lane + 64 * i)); }
        const int r = row < MLAT ? (row >> 13) : 4;
        const float* sh = MOD + r * (6 * DM); const float* sc = sh + DM;
        float ss = 0.f;
#pragma unroll
        for (int i = 0; i < 8; ++i) ss += v[i].x * v[i].x + v[i].y * v[i].y + v[i].z * v[i].z + v[i].w * v[i].w;
        ss = wave_sum(ss);
        const float rstd = rsqrtf(ss * (1.0f / DM) + EPSF);
#pragma unroll
        for (int i = 0; i < 8; ++i) { const int col = 4 * (lane + 64 * i);
            const float4 gg = *(const float4*)(g + col), s1 = *(const float4*)(sc + col), s0 = *(const float4*)(sh + col);
            uint2 w; w.x = pk2(v[i].x * rstd * gg.x * (1.f + s1.x) + s0.x, v[i].y * rstd * gg.y * (1.f + s1.y) + s0.y);
            w.y = pk2(v[i].z * rstd * gg.z * (1.f + s1.z) + s0.z, v[i].w * rstd * gg.w * (1.f + s1.w) + s0.w);
            *(uint2*)(H + (size_t)row * DM + col) = w; }
#pragma unroll
        for (int i = 0; i < 8; ++i) v[i] = vn[i];
    }
#undef PRE_SRC
}

__device__ __forceinline__ void phase_hy1(const Params& p, unsigned char* lds) {
    float* tile = (float*)lds;
    const int tid = otid();
    const bf16_t* PHY = (const bf16_t*)(p.ws + OFF_PHY); bf16_t* MIX = (bf16_t*)(p.ws + OFF_H); bf16_t* UHT = (bf16_t*)(p.ws + OFF_UHT);
    const float* cw = p.in[15]; const float* cb = p.in[16];
    const bool g16 = (gridDim.x & 15) == 0;
    const int c8 = (tid & 7) * 8, tr = tid >> 3;
    float wr[3][3][8], br[3][8]; int ct_loaded = -1; uint4 raw[3][3], rawn[3][3];
    for (int k = 0;; ++k) {
        int ct, tt;
        if (g16) { ct = blockIdx.x & 15; tt = (int)(blockIdx.x >> 4) + k * (int)(gridDim.x >> 4); if (tt >= 512) break; }
        else { const int tl = blockIdx.x + k * gridDim.x; if (tl >= 512 * 16) break; ct = tl & 15; tt = tl >> 4; }
        const int c0 = ct * 64, row0 = tt * 64;
        if (ct != ct_loaded) { ct_loaded = ct;
#pragma unroll
            for (int gI = 0; gI < 3; ++gI) { const int col = gI * 1024 + c0 + c8;
#pragma unroll
                for (int j = 0; j < 8; ++j) br[gI][j] = cb[col + j];
#pragma unroll
                for (int i = 0; i < 3; ++i)
#pragma unroll
                    for (int j = 0; j < 8; ++j) wr[gI][i][j] = cw[i * 3072 + col + j]; } }
        const int row = row0 + tr, tpos = row & (SL - 1);
        if (k == 0) {
#pragma unroll
            for (int gI = 0; gI < 3; ++gI)
#pragma unroll
                for (int i = 0; i < 3; ++i) { int tp = tpos + i - 1; tp = tp < 0 ? 0 : (tp >= SL ? SL - 1 : tp);
                    raw[gI][i] = *(const uint4*)(PHY + (size_t)(row - tpos + tp) * 3072 + gI * 1024 + c0 + c8); }
        }
        {
            int ctn, ttn; bool have;
            if (g16) { ctn = ct; ttn = tt + (int)(gridDim.x >> 4); have = ttn < 512; } else { const int tl = blockIdx.x + (k + 1) * gridDim.x; have = tl < 512 * 16; ctn = tl & 15; ttn = tl >> 4; }
            if (have) { const int rown = ttn * 64 + tr, tposn = rown & (SL - 1);
#pragma unroll
                for (int gI = 0; gI < 3; ++gI)
#pragma unroll
                    for (int i = 0; i < 3; ++i) { int tp = tposn + i - 1; tp = tp < 0 ? 0 : (tp >= SL ? SL - 1 : tp);
                        rawn[gI][i] = *(const uint4*)(PHY + (size_t)(rown - tposn + tp) * 3072 + gI * 1024 + ctn * 64 + c8); } }
        }
        float res[3][8];
#pragma unroll
        for (int gI = 0; gI < 3; ++gI) {
            float a[8];
#pragma unroll
            for (int j = 0; j < 8; ++j) a[j] = br[gI][j];
#pragma unroll
            for (int i = 0; i < 3; ++i) {
                const int tp = tpos + i - 1; const float msk = (tp >= 0 && tp < SL) ? 1.0f : 0.0f;
                float f[8]; unpack8(raw[gI][i], f);
#pragma unroll
                for (int j = 0; j < 8; ++j) a[j] += (wr[gI][i][j] * msk) * f[j];
            }
#pragma unroll
            for (int j = 0; j < 8; ++j) res[gI][j] = a[j];
        }
#pragma unroll
        for (int gI = 0; gI < 3; ++gI)
#pragma unroll
            for (int i = 0; i < 3; ++i) raw[gI][i] = rawn[gI][i];
        *(uint4*)(MIX + (size_t)row * DM + 1024 + c0 + c8) = pack8(res[0]);
#pragma unroll
        for (int j = 0; j < 8; ++j) tile[(c8 + j) * 65 + tr] = res[1][j] * res[2][j];
        __syncthreads();
        {   const int c = tid >> 3, t8 = (tid & 7) * 8; const int b = row0 >> 13, tb = (row0 & (SL - 1)) + t8;
            bf16_t* dp = UHT + ((size_t)(b * 1024 + c0 + c)) * SL + tb; float f[8];
#pragma unroll
            for (int j = 0; j < 8; ++j) f[j] = tile[c * 65 + t8 + j];
            *(uint4*)dp = pack8(f); }
        __syncthreads();
    }
}

__device__ __forceinline__ void phase_hy3(const Params& p, unsigned char* lds) {
    float* tile = (float*)lds;
    const int tid = otid();
    bf16_t* MIX = (bf16_t*)(p.ws + OFF_H); const bf16_t* UHT = (const bf16_t*)(p.ws + OFF_UHT);
    const int c = tid >> 3, t8 = (tid & 7) * 8, tr = tid >> 3, c8 = (tid & 7) * 8;
    uint4 uy, um, ny, nm;
#define HY3_LOAD(tl_, y_, m_) do { const int ct_ = (tl_) & 15, tt_ = (tl_) >> 4, c0_ = ct_ * 64, row0_ = tt_ * 64; const int b_ = row0_ >> 13, tb_ = (row0_ & (SL - 1)) + t8; \
        y_ = *(const uint4*)(UHT + ((size_t)(b_ * 1024 + c0_ + c)) * SL + tb_); m_ = *(const uint4*)(MIX + (size_t)(row0_ + tr) * DM + 1024 + c0_ + c8); } while (0)
    int tl = blockIdx.x;
    if (tl < 512 * 16) HY3_LOAD(tl, uy, um);
    for (; tl < 512 * 16; tl += gridDim.x) {
        const int ct = tl & 15, tt = tl >> 4, c0 = ct * 64, row0 = tt * 64;
        if (tl + (int)gridDim.x < 512 * 16) HY3_LOAD(tl + (int)gridDim.x, ny, nm);
        {   float f[8]; unpack8(uy, f); float* tp = tile + c * 65 + t8;
#pragma unroll
            for (int j = 0; j < 8; ++j) tp[j] = f[j]; }
        __syncthreads();
        {   bf16_t* mp = MIX + (size_t)(row0 + tr) * DM + 1024 + c0 + c8;
            float f[8]; unpack8(um, f);
#pragma unroll
            for (int j = 0; j < 8; ++j) f[j] *= tile[(c8 + j) * 65 + tr];
            *(uint4*)mp = pack8(f); }
        __syncthreads();
        uy = ny; um = nm;
    }
#undef HY3_LOAD
}


__device__ __forceinline__ float2 cmul(float2 a, float2 b) { return make_float2(a.x * b.x - a.y * b.y, a.x * b.y + a.y * b.x); }
__device__ __forceinline__ int pidx(int i) { return i + ((i >> 6) << 2); }
template <bool INV> __device__ __forceinline__ float2 mulw16(float2 d, int m) {
    const float C1 = 0.9238795325112867f, S1 = 0.3826834323650898f, C2 = 0.7071067811865476f;
    float c, s;
    switch (m & 7) {
        case 0: return d;
        case 1: c = C1; s = S1; break;
        case 2: c = C2; s = C2; break;
        case 3: c = S1; s = C1; break;
        case 4: return INV ? make_float2(-d.y, d.x) : make_float2(d.y, -d.x);
        case 5: c = -S1; s = C1; break;
        case 6: c = -C2; s = C2; break;
        default: c = -C1; s = S1; break;
    }
    if (!INV) s = -s;
    return make_float2(d.x * c - d.y * s, d.x * s + d.y * c);
}
template <int R> __device__ __forceinline__ constexpr int brev(int q) { int r = 0; for (int b = 1, o = R >> 1; b < R; b <<= 1, o >>= 1) if (q & b) r |= o; return r; }
template <int R, int LOG, int S0 = 0> __device__ __forceinline__ void dft_fwd(float2 (&v)[R]) {
#pragma unroll
    for (int s = S0; s < LOG; ++s) {
        const int h = (R / 2) >> s;
#pragma unroll
        for (int j = 0; j < R; ++j) {
            if (j & h) continue;
            const int m = (j & (h - 1)) * (R / (2 * h)) * (16 / R);
            const float2 a = v[j], b = v[j + h];
            v[j] = make_float2(a.x + b.x, a.y + b.y);
            v[j + h] = mulw16<false>(make_float2(a.x - b.x, a.y - b.y), m);
        }
    }
}
template <int R, int LOG, int S0 = 0> __device__ __forceinline__ void dft_inv(float2 (&v)[R]) {
#pragma unroll
    for (int s = LOG - 1; s >= S0; --s) {
        const int h = (R / 2) >> s;
#pragma unroll
        for (int j = 0; j < R; ++j) {
            if (j & h) continue;
            const int m = (j & (h - 1)) * (R / (2 * h)) * (16 / R);
            const float2 a = v[j], b = mulw16<true>(v[j + h], m);
            v[j] = make_float2(a.x + b.x, a.y + b.y);
            v[j + h] = make_float2(a.x - b.x, a.y - b.y);
        }
    }
}
__device__ __forceinline__ void tw_powers(float2 w1, float2 (&w)[16]) {
    w[1] = w1; w[2] = cmul(w1, w1); w[3] = cmul(w[2], w1); w[4] = cmul(w[2], w[2]); w[5] = cmul(w[4], w1); w[6] = cmul(w[4], w[2]); w[7] = cmul(w[4], w[3]);
    w[8] = cmul(w[4], w[4]);
#pragma unroll
    for (int k = 1; k < 8; ++k) w[8 + k] = cmul(w[8], w[k]);
}
template <int n, bool INV, bool HALF = false, bool TW = false> __device__ __forceinline__ void fft_pass16(float2* X, int tid, const float2 (&wpre)[16]) {
    constexpr int st = n / 16, PST = (st >= 64) ? st + 4 * (st / 64) : st;
#pragma unroll 1
    for (int g = tid; g < 1024; g += NT) {
        int lo = g & (st - 1); asm volatile("" : "+v"(lo));
        const int blk = g / st, base = blk * n + lo;
        float2* Xp = X + pidx(base);
        float2 w[16];
        if (TW) {
#pragma unroll
            for (int k = 1; k < 16; ++k) w[k] = make_float2(wpre[k].x, INV ? -wpre[k].y : wpre[k].y);
        } else {   const float rev = (float)lo * (1.0f / n); const float c = __builtin_amdgcn_cosf(rev), s = __builtin_amdgcn_sinf(rev);
            tw_powers(make_float2(c, INV ? s : -s), w); }
        float2 v[16];
        if (!INV) {
            if (HALF) {
#pragma unroll
                for (int j = 0; j < 8; ++j) { v[j] = Xp[j * PST]; v[j + 8] = mulw16<false>(v[j], j); }
                dft_fwd<16, 4, 1>(v);
            } else {
#pragma unroll
                for (int j = 0; j < 16; ++j) v[j] = Xp[j * PST];
                dft_fwd<16, 4>(v);
            }
#pragma unroll
            for (int q = 1; q < 16; ++q) v[q] = cmul(v[q], w[brev<16>(q)]);
#pragma unroll
            for (int q = 0; q < 16; ++q) Xp[brev<16>(q) * PST] = v[q];
        } else {
#pragma unroll
            for (int q = 0; q < 16; ++q) { const int k = brev<16>(q); float2 t = Xp[k * PST]; if (k) t = cmul(t, w[k]); v[q] = t; }
            if (HALF) {
                dft_inv<16, 4, 1>(v);
#pragma unroll
                for (int j = 0; j < 8; ++j) { const float2 b = mulw16<true>(v[j + 8], j); Xp[j * PST] = make_float2(v[j].x + b.x, v[j].y + b.y); }
            } else {
                dft_inv<16, 4>(v);
#pragma unroll
                for (int j = 0; j < 16; ++j) Xp[j * PST] = v[j];
            }
        }
    }
}
__device__ __forceinline__ void phase_hy2(const Params& p, unsigned char* lds) {
    float2* X = (float2*)lds;
    const int tid = otid();
    const float* TAPS = (const float*)(p.ws + OFF_TAPS); bf16_t* UHT = (bf16_t*)(p.ws + OFF_UHT);
    float2 w64[16];
    {   const float r64 = (float)(tid & 3) * (1.0f / 64.0f);
        tw_powers(make_float2(__builtin_amdgcn_cosf(r64), -__builtin_amdgcn_sinf(r64)), w64); w64[0] = make_float2(1.f, 0.f); }
    for (int c = blockIdx.x; c < 1024; c += gridDim.x) {
        float4* KS = (float4*)(p.ws + OFF_KSPEC) + (size_t)blockIdx.x * 8192;
#pragma unroll
        for (int i = 0; i < 8; ++i) { const int t = 4 * (tid + NT * i); const float4 v = *(const float4*)(TAPS + (size_t)c * 16384 + t);
            float4* xp = (float4*)(X + pidx(t)); xp[0] = make_float4(v.x, 0.f, v.y, 0.f); xp[1] = make_float4(v.z, 0.f, v.w, 0.f); }
        __syncthreads();
        fft_pass16<16384, false, false, false>(X, tid, w64); __syncthreads();
        fft_pass16<1024, false, false, false>(X, tid, w64); __syncthreads();
        fft_pass16<64, false, false, true>(X, tid, w64); __syncthreads();
#pragma unroll 2
        for (int i = 0; i < 8; ++i) { const float4* xp = (const float4*)(X + pidx(4 * (tid + NT * i))); const float4 a = xp[0], b = xp[1];
            float2 v[4] = {make_float2(a.x, a.y), make_float2(a.z, a.w), make_float2(b.x, b.y), make_float2(b.z, b.w)};
            dft_fwd<4, 2>(v);
            const float sc = 1.0f / 16384.0f;
            KS[2 * (tid + NT * i)] = make_float4(v[0].x * sc, v[0].y * sc, v[1].x * sc, v[1].y * sc); KS[2 * (tid + NT * i) + 1] = make_float4(v[2].x * sc, v[2].y * sc, v[3].x * sc, v[3].y * sc); }
        __syncthreads();
        for (int pr = 0; pr < 2; ++pr) {
            bf16_t* u1 = UHT + ((size_t)((2 * pr) * 1024 + c)) * SL; bf16_t* u2 = UHT + ((size_t)((2 * pr + 1) * 1024 + c)) * SL;
#pragma unroll
            for (int i = 0; i < 4; ++i) { const int t = 4 * (tid + NT * i); const uint2 ua = *(const uint2*)(u1 + t), ub = *(const uint2*)(u2 + t);
                const float4 a = make_float4(bf_lo(ua.x), bf_hi(ua.x), bf_lo(ua.y), bf_hi(ua.y)), b = make_float4(bf_lo(ub.x), bf_hi(ub.x), bf_lo(ub.y), bf_hi(ub.y));
                float4* xp = (float4*)(X + pidx(t)); xp[0] = make_float4(a.x, b.x, a.y, b.y); xp[1] = make_float4(a.z, b.z, a.w, b.w); }
            __syncthreads();
            fft_pass16<16384, false, true, false>(X, tid, w64); __syncthreads();
            fft_pass16<1024, false, false, false>(X, tid, w64); __syncthreads();
            fft_pass16<64, false, false, true>(X, tid, w64); __syncthreads();
            float4 kk[8][2];
#pragma unroll
            for (int i = 0; i < 8; ++i) { kk[i][0] = KS[2 * (tid + NT * i)]; kk[i][1] = KS[2 * (tid + NT * i) + 1]; }
#pragma unroll
            for (int i = 0; i < 8; ++i) { float4* xp = (float4*)(X + pidx(4 * (tid + NT * i))); const float4 a = xp[0], b = xp[1];
                float2 v[4] = {make_float2(a.x, a.y), make_float2(a.z, a.w), make_float2(b.x, b.y), make_float2(b.z, b.w)};
                dft_fwd<4, 2>(v);
                const float4 k0 = kk[i][0], k1 = kk[i][1];
                v[0] = cmul(v[0], make_float2(k0.x, k0.y)); v[1] = cmul(v[1], make_float2(k0.z, k0.w)); v[2] = cmul(v[2], make_float2(k1.x, k1.y)); v[3] = cmul(v[3], make_float2(k1.z, k1.w));
                dft_inv<4, 2>(v);
                xp[0] = make_float4(v[0].x, v[0].y, v[1].x, v[1].y); xp[1] = make_float4(v[2].x, v[2].y, v[3].x, v[3].y); }
            __syncthreads();
            fft_pass16<64, true, false, true>(X, tid, w64); __syncthreads();
            fft_pass16<1024, true, false, false>(X, tid, w64); __syncthreads();
            fft_pass16<16384, true, true, false>(X, tid, w64); __syncthreads();
#pragma unroll
            for (int i = 0; i < 4; ++i) { const int t = 4 * (tid + NT * i); const float4* xp = (const float4*)(X + pidx(t)); const float4 a = xp[0], b = xp[1];
                uint2 w1, w2; w1.x = pk2(a.x, a.z); w1.y = pk2(b.x, b.z); w2.x = pk2(a.y, a.w); w2.y = pk2(b.y, b.w);
                *(uint2*)(u1 + t) = w1; *(uint2*)(u2 + t) = w2; }
            __syncthreads();
        }
    }
}


__device__ __forceinline__ void item_decode(int item, int& b, int& n, int& h, int& row0, int& seq0, int& seqlen) {
    h = item & 7; const int cidx = item >> 3; b = cidx / NCHUNK; n = cidx % NCHUNK;
    if (n < 4) { seq0 = MLAT + b * CL; seqlen = CL; row0 = seq0 + n * CHK; } else { seq0 = b * SL; seqlen = SL; row0 = seq0 + (n - 4) * CHK; }
}
constexpr int G2X_A10 = 0, G2X_T11 = 5120, G2X_T00T = 10240, G2X_XT = 20480, G2X_BYTES = 30720;
template <int D> __device__ __forceinline__ void g2_tinv_diag(const float* As, int lane, const float* rsu, const float* rsw, bf16_t* TM, unsigned char* xl) {
    const int blk = lane >> 5, cc = lane & 31;
    int abase = D * 64 * 68 + blk * (32 * 68 + 32); asm volatile("" : "+v"(abase));
    const float* Ad = As + abase;
    {   const float* ap = As + D * 64 * 68 + cc * 68 + 32 + 16 * blk; bf16_t* a10 = (bf16_t*)(xl + G2X_A10) + D * 32 * 40;
#pragma unroll
        for (int q = 0; q < 4; ++q) { const float4 v = *(const float4*)(ap + 4 * q);
            a10[(16 * blk + 4 * q + 0) * 40 + cc] = f2bf(v.x); a10[(16 * blk + 4 * q + 1) * 40 + cc] = f2bf(v.y); a10[(16 * blk + 4 * q + 2) * 40 + cc] = f2bf(v.z); a10[(16 * blk + 4 * q + 3) * 40 + cc] = f2bf(v.w); } }
    float x[32];
#pragma unroll
    for (int i = 0; i < 32; ++i) x[i] = (i == cc) ? 1.0f : 0.0f;
#pragma clang loop unroll(full)
    for (int j = 0; j < 31; ++j) {
        const float xj = x[j];
        int zj = 0; asm volatile("" : "+v"(zj) : "v"(x[j > 0 ? j - 1 : 0])); zj &= ~3;
#pragma clang loop unroll(full)
        for (int i4 = ((j + 1) & ~3); i4 < 32; i4 += 4) {
            const float4 a = *(const float4*)(Ad + zj + j * 68 + i4);
            if (i4 > j) x[i4] -= a.x * xj;
            if (i4 + 1 > j) x[i4 + 1] -= a.y * xj;
            if (i4 + 2 > j) x[i4 + 2] -= a.z * xj;
            x[i4 + 3] -= a.w * xj;
        }
    }
    const int sj = 32 * blk + cc, jo = D ? 63 - sj : sj;
    const float su = rsu[D * 64 + jo], sw = rsw[D * 64 + jo];
    bf16_t* tu = TM + (D * 2 + 0) * 64 * 72 + jo; bf16_t* tw = TM + (D * 2 + 1) * 64 * 72 + jo;
#pragma unroll
    for (int ii = 0; ii < 32; ++ii) { const int si = 32 * blk + ii, io = D ? 63 - si : si; tu[io * 72] = f2bf(x[ii] * su); tw[io * 72] = f2bf(x[ii] * sw); }
    if (blk == 1) {
        bf16_t* t11 = (bf16_t*)(xl + G2X_T11) + D * 32 * 40 + cc;
#pragma unroll
        for (int ii = 0; ii < 32; ++ii) { const int io = D ? 63 - ii : ii; tu[io * 72] = 0; tw[io * 72] = 0; t11[ii * 40] = f2bf(x[ii]); }
    } else {
        bf16_t* t0u = (bf16_t*)(xl + G2X_T00T) + (D * 2 + 0) * 32 * 40 + cc * 40; bf16_t* t0w = (bf16_t*)(xl + G2X_T00T) + (D * 2 + 1) * 32 * 40 + cc * 40;
#pragma unroll
        for (int q = 0; q < 4; ++q) { uint4 wu, ww;
            wu.x = pk2(x[8 * q] * su, x[8 * q + 1] * su); wu.y = pk2(x[8 * q + 2] * su, x[8 * q + 3] * su); wu.z = pk2(x[8 * q + 4] * su, x[8 * q + 5] * su); wu.w = pk2(x[8 * q + 6] * su, x[8 * q + 7] * su);
            ww.x = pk2(x[8 * q] * sw, x[8 * q + 1] * sw); ww.y = pk2(x[8 * q + 2] * sw, x[8 * q + 3] * sw); ww.z = pk2(x[8 * q + 4] * sw, x[8 * q + 5] * sw); ww.w = pk2(x[8 * q + 6] * sw, x[8 * q + 7] * sw);
            *(uint4*)(t0u + 8 * q) = wu; *(uint4*)(t0w + 8 * q) = ww; }
    }
}
constexpr int G2_KB = 0, G2_QB = 17408, G2_TM = 0  , G2_KT = 36864, G2_VT = 55296, G2_AS = 73728, G2_GT = 108544, G2_XL = 110592;
static_assert(G2_GT + 8 * 64 * 4 <= G2_XL && G2_XL + G2X_BYTES <= LDS_BYTES, "G2 LDS");
__device__ __forceinline__ void phase_gdn_prep(const Params& p, unsigned char* lds) {
    bf16_t* kb = (bf16_t*)(lds + G2_KB); bf16_t* qb = (bf16_t*)(lds + G2_QB); bf16_t* kT = (bf16_t*)(lds + G2_KT); bf16_t* vT = (bf16_t*)(lds + G2_VT);
    float* As = (float*)(lds + G2_AS); bf16_t* TM = (bf16_t*)(lds + G2_TM); float* gt = (float*)(lds + G2_GT); unsigned char* xl = lds + G2_XL;
    float* beta_s = gt; float* gc_s = gt + 128; float* rsu = gt + 256; float* rsw = gt + 384;
    const bf16_t* PG = (const bf16_t*)(p.ws + OFF_PGDN); const float* GATES = (const float*)(p.ws + OFF_GATES);
    const float* cw = p.in[11]; const float* a_log = p.in[12]; const float* dt_bias = p.in[13];
    bf16_t* KT = (bf16_t*)(p.ws + OFF_KT); bf16_t* QO = (bf16_t*)(p.ws + OFF_Q); bf16_t* UW = (bf16_t*)(p.ws + OFF_UW); bf16_t* ATT = (bf16_t*)(p.ws + OFF_ATT);
    float* GSC = (float*)(p.ws + OFF_GSC);
    for (int item = blockIdx.x; item < NITEM; item += gridDim.x) {
        int tid = otid();
        const int lane = tid & 63, wid = __builtin_amdgcn_readfirstlane(tid >> 6), fr = lane & 15, fq = lane >> 4;
        int b, n, h, row0, seq0, seqlen; item_decode(item, b, n, h, row0, seq0, seqlen);
        const bool ctx = n < 4;
        float graw_b = 0.f, graw_a = 0.f;
        if (tid < 128) { const int d = tid >> 6, i = d ? 63 - lane : lane; const float* gp = GATES + (size_t)(row0 + i) * 32; graw_b = gp[d * 8 + h]; graw_a = gp[16 + d * 8 + h]; }
        {   const int r = tid >> 3, c16 = (tid & 7) * 16;
            uint4 raw[3][5][2];
#pragma unroll
            for (int mt = 0; mt < 3; ++mt)
#pragma unroll
                for (int i = 0; i < 5; ++i) { int rr = row0 + r + i - 2; rr = rr < seq0 ? seq0 : (rr >= seq0 + seqlen ? seq0 + seqlen - 1 : rr);
                    const bf16_t* sp = PG + (size_t)rr * 3072 + mt * 1024 + h * 128 + c16; raw[mt][i][0] = *(const uint4*)sp; raw[mt][i][1] = *(const uint4*)(sp + 8); }
#pragma unroll
            for (int mt = 0; mt < 3; ++mt) {
                if (mt == 2 && ctx) break;
                const int col = mt * 1024 + h * 128 + c16;
                float a[16];
#pragma unroll
                for (int j = 0; j < 16; ++j) a[j] = 0.f;
#pragma unroll
                for (int i = 0; i < 5; ++i) {
                    const int rr = row0 + r + i - 2;
                    const float msk = (rr >= seq0 && rr < seq0 + seqlen) ? 1.0f : 0.0f;
                    float f0[8], f1[8]; unpack8(raw[mt][i][0], f0); unpack8(raw[mt][i][1], f1);
                    const float* wp = cw + i * 3072 + col;
#pragma unroll
                    for (int j = 0; j < 8; ++j) { a[j] += (wp[j] * msk) * f0[j]; a[8 + j] += (wp[8 + j] * msk) * f1[j]; }
                }
                float ss = 0.f;
#pragma unroll
                for (int j = 0; j < 16; ++j) { a[j] = silu(a[j]); ss += a[j] * a[j]; }
                if (mt != 1) {
                    ss += __shfl_xor(ss, 1); ss += __shfl_xor(ss, 2); ss += __shfl_xor(ss, 4);
                    const float sc = rsqrtf(ss + EPSF) * (mt == 2 ? 0.08838834764831845f : 1.0f);
#pragma unroll
                    for (int j = 0; j < 16; ++j) a[j] *= sc;
                }
                uint4 w0, w1; w0.x = pk2(a[0], a[1]); w0.y = pk2(a[2], a[3]); w0.z = pk2(a[4], a[5]); w0.w = pk2(a[6], a[7]);
                w1.x = pk2(a[8], a[9]); w1.y = pk2(a[10], a[11]); w1.z = pk2(a[12], a[13]); w1.w = pk2(a[14], a[15]);
                if (mt == 0) {
                    *(uint4*)(kb + r * 136 + c16) = w0; *(uint4*)(kb + r * 136 + c16 + 8) = w1;
#pragma unroll
                    for (int j = 0; j < 16; ++j) kT[(c16 + j) * 72 + r] = f2bf(a[j]);
                } else if (mt == 1) {
#pragma unroll
                    for (int j = 0; j < 16; ++j) vT[(c16 + j) * 72 + r] = f2bf(a[j]);
                } else {
                    *(uint4*)(qb + r * 136 + c16) = w0; *(uint4*)(qb + r * 136 + c16 + 8) = w1;
                    bf16_t* qp = QO + (size_t)item * 8192 + r * 128 + c16; *(uint4*)qp = w0; *(uint4*)(qp + 8) = w1;
                }
            }
        }
        if (tid < 128) {
            const int d = tid >> 6, i = d ? 63 - lane : lane;
            const float beta = 1.0f / (1.0f + __expf(-graw_b));
            const float x = graw_a + dt_bias[d * 8 + h];
            const float sp = x > 20.f ? x : __logf(1.0f + __expf(x));
            float g = -__expf(a_log[d * 8 + h]) * sp;
#pragma unroll
            for (int o = 1; o < 64; o <<= 1) { const float t = __shfl_up(g, o); if (lane >= o) g += t; }
            const float glast = __shfl(g, 63);
            const float eg = __expf(g), ee = __expf(glast - g);
            beta_s[d * 64 + i] = beta; gc_s[d * 64 + i] = g; rsu[d * 64 + i] = beta; rsw[d * 64 + i] = beta * eg;
            float* gs = GSC + ((size_t)item * 2 + d) * 192; gs[i] = eg; gs[64 + i] = ee; if (lane == 63) gs[128] = __expf(glast);
        }
        __syncthreads();
#pragma unroll
        for (int i = 0; i < 2; ++i) { const int q16 = tid + NT * i; *(uint4*)(KT + (size_t)item * 8192 + (size_t)q16 * 8) = *(const uint4*)(kT + (q16 >> 3) * 72 + (q16 & 7) * 8); }
        {   const int mt = wid >> 1, ntp = wid & 1;
            f32x4 ckk[2], cqk[2];
#pragma unroll
            for (int e = 0; e < 2; ++e) { ckk[e] = (f32x4){0.f, 0.f, 0.f, 0.f}; cqk[e] = (f32x4){0.f, 0.f, 0.f, 0.f}; }
#pragma unroll
            for (int ks = 0; ks < 4; ++ks) {
                const bf16x8 ak = *(const bf16x8*)(kb + (16 * mt + fr) * 136 + 32 * ks + 8 * fq);
                bf16x8 aq = ak; if (!ctx) aq = *(const bf16x8*)(qb + (16 * mt + fr) * 136 + 32 * ks + 8 * fq);
#pragma unroll
                for (int e = 0; e < 2; ++e) { const bf16x8 bk = *(const bf16x8*)(kb + (16 * (2 * ntp + e) + fr) * 136 + 32 * ks + 8 * fq);
                    ckk[e] = __builtin_amdgcn_mfma_f32_16x16x32_bf16(ak, bk, ckk[e], 0, 0, 0);
                    cqk[e] = __builtin_amdgcn_mfma_f32_16x16x32_bf16(aq, bk, cqk[e], 0, 0, 0); }
            }
#pragma unroll
            for (int e = 0; e < 2; ++e)
#pragma unroll
                for (int r = 0; r < 4; ++r) {
                    const int i = 16 * mt + 4 * fq + r, j = 16 * (2 * ntp + e) + fr;
#pragma unroll
                    for (int d = 0; d < 2; ++d) {
                        const bool before = d ? (j > i) : (j < i); const bool incl = before || (i == j);
                        const float df = incl ? gc_s[d * 64 + i] - gc_s[d * 64 + j] : 0.f; const float ex = __expf(df);
                        const float av = before ? beta_s[d * 64 + i] * ckk[e][r] * ex : 0.f;
                        const int ii = d ? 63 - i : i, jj = d ? 63 - j : j;
                        As[(d * 64 + jj) * 68 + ii] = av;
                        if (!ctx) ATT[((size_t)item * 2 + d) * 4096 + i * 64 + j] = f2bf(incl ? cqk[e][r] * ex : 0.f);
                    }
                }
        }
        __syncthreads();
        if (wid == 0) g2_tinv_diag<0>(As, lane, rsu, rsw, TM, xl);
        else if (wid == 1) g2_tinv_diag<1>(As, lane, rsu, rsw, TM, xl);
        __syncthreads();
        {   const int dd = wid >> 2, vv = (wid >> 1) & 1, mh = wid & 1;
            const bf16_t* a10 = (const bf16_t*)(xl + G2X_A10) + dd * 32 * 40; const bf16_t* t11 = (const bf16_t*)(xl + G2X_T11) + dd * 32 * 40;
            const bf16_t* t0t = (const bf16_t*)(xl + G2X_T00T) + (dd * 2 + vv) * 32 * 40; bf16_t* xt = (bf16_t*)(xl + G2X_XT) + (dd * 2 + vv) * 32 * 40;
            const bf16x8 aA = *(const bf16x8*)(a10 + (16 * mh + fr) * 40 + 8 * fq);
#pragma unroll
            for (int nt = 0; nt < 2; ++nt) { const bf16x8 bT = *(const bf16x8*)(t0t + (16 * nt + fr) * 40 + 8 * fq);
                f32x4 acc = (f32x4){0.f, 0.f, 0.f, 0.f}; acc = __builtin_amdgcn_mfma_f32_16x16x32_bf16(aA, bT, acc, 0, 0, 0);
                uint2 w; w.x = pk2_c(acc[0], acc[1]); w.y = pk2_c(acc[2], acc[3]);
                *(uint2*)(xt + (16 * nt + fr) * 40 + 16 * mh + 4 * fq) = w; }
            __syncthreads();
            const bf16x8 aT = *(const bf16x8*)(t11 + (16 * mh + fr) * 40 + 8 * fq);
            bf16_t* tm = TM + (dd * 2 + vv) * 64 * 72;
#pragma unroll
            for (int nt = 0; nt < 2; ++nt) { const bf16x8 bX = *(const bf16x8*)(xt + (16 * nt + fr) * 40 + 8 * fq);
                f32x4 acc = (f32x4){0.f, 0.f, 0.f, 0.f}; acc = __builtin_amdgcn_mfma_f32_16x16x32_bf16(aT, bX, acc, 0, 0, 0);
                const int sj = 16 * nt + fr, jo = dd ? 63 - sj : sj;
#pragma unroll
                for (int r = 0; r < 4; ++r) { const int si = 32 + 16 * mh + 4 * fq + r, io = dd ? 63 - si : si; tm[io * 72 + jo] = (bf16_t)(pk2_c(-acc[r], 0.f) & 0xffffu); } }
        }
        __syncthreads();
        {   const int mi = wid >> 1, half = wid & 1, uw = mi & 1;
            const bf16_t* Tm = TM + mi * 64 * 72; const bf16_t* Bm = uw ? kT : vT;
            bf16_t* dst = UW + ((size_t)item * 4 + mi) * 8192;
#pragma unroll
            for (int mm = 0; mm < 2; ++mm) {
                const int mt = 2 * half + mm;
                const bf16x8 a0 = *(const bf16x8*)(Tm + (16 * mt + fr) * 72 + 8 * fq), a1 = *(const bf16x8*)(Tm + (16 * mt + fr) * 72 + 32 + 8 * fq);
#pragma unroll
                for (int nt = 0; nt < 8; ++nt) {
                    const bf16x8 b0 = *(const bf16x8*)(Bm + (16 * nt + fr) * 72 + 8 * fq), b1 = *(const bf16x8*)(Bm + (16 * nt + fr) * 72 + 32 + 8 * fq);
                    f32x4 acc = (f32x4){0.f, 0.f, 0.f, 0.f};
                    acc = __builtin_amdgcn_mfma_f32_16x16x32_bf16(b0, a0, acc, 0, 0, 0);
                    acc = __builtin_amdgcn_mfma_f32_16x16x32_bf16(b1, a1, acc, 0, 0, 0);
                    uint2 w; w.x = pk2_c(acc[0], acc[1]); w.y = pk2_c(acc[2], acc[3]);
                    *(uint2*)(dst + (16 * mt + fr) * 128 + 16 * nt + 4 * fq) = w;
                }
            }
        }
        __syncthreads();
    }
}

constexpr int SC_BUF = 68224, SC_W = 0, SC_KT = 17408, SC_Q = 35840, SC_AT = 53248, SC_U = 62464  , SC_S = 67584  ,
              SC_ST = 2 * SC_BUF, SC_VT = SC_ST + 8704, SC_VE = SC_VT + 4608;
static_assert(SC_S + 132 * 4 <= SC_BUF && SC_VE + 4608 <= LDS_BYTES - 16, "scan LDS");
struct ScanLd { uint4 w[4], k[4], q[4], a[2], u; float sc; };
struct ScanCtx { const bf16_t* KT; const bf16_t* QO; const bf16_t* UW; const bf16_t* ATT; const float* GSC; int lt, fr, fq, wid, sl, d, h, b; };
__device__ __forceinline__ void scan_item(const ScanCtx& c, int s, int& item, bool& ctx, int& row0) {
    const int n = c.d ? (s < 4 ? 3 - s : 135 - s) : s; item = ((c.b * NCHUNK + n) << 3) + c.h; ctx = n < 4;
    row0 = ctx ? MLAT + c.b * CL + n * CHK : c.b * SL + (n - 4) * CHK;
}
__device__ __forceinline__ void scan_load(const ScanCtx& c, ScanLd& L, int s) {
    int it, r0; bool cx; scan_item(c, s, it, cx, r0); (void)cx; (void)r0;
    const bf16_t* wp = c.UW + (((size_t)it * 2 + c.d) * 2 + 1) * 8192; const bf16_t* up = c.UW + (((size_t)it * 2 + c.d) * 2) * 8192;
    const bf16_t* kp = c.KT + (size_t)it * 8192; const bf16_t* qp = c.QO + (size_t)it * 8192; const bf16_t* ap = c.ATT + ((size_t)it * 2 + c.d) * 4096;
    const float* gs = c.GSC + ((size_t)it * 2 + c.d) * 192;
    const unsigned o16 = (unsigned)c.lt * 16u;
#pragma unroll
    for (int i = 0; i < 4; ++i) { const unsigned q = o16 + 4096u * i; L.w[i] = *(const uint4*)((const char*)wp + q); L.k[i] = *(const uint4*)((const char*)kp + q); L.q[i] = *(const uint4*)((const char*)qp + q); }
#pragma unroll
    for (int i = 0; i < 2; ++i) L.a[i] = *(const uint4*)((const char*)ap + o16 + 4096u * i);
    L.u = *(const uint4*)((const char*)up + (unsigned)((c.lt >> 2) * 256 + 64 * c.sl + (c.lt & 3) * 16));
    L.sc = gs[c.lt < 129 ? c.lt : 128];
}
__device__ __forceinline__ void scan_store(const ScanCtx& c, const ScanLd& L, unsigned char* bp) {
#pragma unroll
    for (int i = 0; i < 4; ++i) { const int q = c.lt + 256 * i;
        *(uint4*)(bp + SC_W + (q >> 4) * 272 + (q & 15) * 16) = L.w[i];
        *(uint4*)(bp + SC_KT + (q >> 3) * 144 + (q & 7) * 16) = L.k[i];
        *(uint4*)(bp + SC_Q + (q >> 4) * 272 + (q & 15) * 16) = L.q[i]; }
#pragma unroll
    for (int i = 0; i < 2; ++i) { const int q = c.lt + 256 * i; *(uint4*)(bp + SC_AT + (q >> 3) * 144 + (q & 7) * 16) = L.a[i]; }
    *(uint4*)(bp + SC_U + (c.lt >> 2) * 80 + (c.lt & 3) * 16) = L.u;
    if (c.lt < 129) *(float*)(bp + SC_S + c.lt * 4) = L.sc;
}
__device__ __forceinline__ void scan_alpha(const ScanCtx& c, unsigned char* lds, const unsigned char* bc, bool ctx, f32x4 (&O1)[2]) {
    const int fr = c.fr, fq = c.fq, mt = c.wid;
    f32x4 P[2]; P[0] = (f32x4){0.f, 0.f, 0.f, 0.f}; P[1] = (f32x4){0.f, 0.f, 0.f, 0.f}; O1[0] = (f32x4){0.f, 0.f, 0.f, 0.f}; O1[1] = (f32x4){0.f, 0.f, 0.f, 0.f};
#pragma unroll
    for (int ks = 0; ks < 4; ++ks) {
        const bf16x8 aW = *(const bf16x8*)(bc + SC_W + (16 * mt + fr) * 272 + (32 * ks + 8 * fq) * 2);
        bf16x8 aQ = aW; if (!ctx) aQ = *(const bf16x8*)(bc + SC_Q + (16 * mt + fr) * 272 + (32 * ks + 8 * fq) * 2);
#pragma unroll
        for (int nt = 0; nt < 2; ++nt) {
            const bf16x8 bS = *(const bf16x8*)(lds + SC_ST + (16 * nt + fr) * 272 + (32 * ks + 8 * fq) * 2);
            P[nt] = __builtin_amdgcn_mfma_f32_16x16x32_bf16(aW, bS, P[nt], 0, 0, 0);
            if (!ctx) O1[nt] = __builtin_amdgcn_mfma_f32_16x16x32_bf16(aQ, bS, O1[nt], 0, 0, 0);
        }
    }
    float eec[4];
#pragma unroll
    for (int r = 0; r < 4; ++r) eec[r] = *(const float*)(bc + SC_S + (64 + 16 * mt + 4 * fq + r) * 4);
#pragma unroll
    for (int nt = 0; nt < 2; ++nt) {
        float vn[4];
#pragma unroll
        for (int r = 0; r < 4; ++r) vn[r] = bf2f(*(const bf16_t*)(bc + SC_U + (16 * mt + 4 * fq + r) * 80 + (16 * nt + fr) * 2)) - P[nt][r];
        uint2 w; w.x = pk2(vn[0], vn[1]); w.y = pk2(vn[2], vn[3]);
        *(uint2*)(lds + SC_VT + (16 * nt + fr) * 144 + (16 * mt + 4 * fq) * 2) = w;
        w.x = pk2(vn[0] * eec[0], vn[1] * eec[1]); w.y = pk2(vn[2] * eec[2], vn[3] * eec[3]);
        *(uint2*)(lds + SC_VE + (16 * nt + fr) * 144 + (16 * mt + 4 * fq) * 2) = w;
    }
}
__device__ __forceinline__ void scan_beta(const ScanCtx& c, unsigned char* lds, const unsigned char* bc, bool ctx, int row0, const f32x4 (&O1)[2], f32x4 (&Sacc)[2][2], bf16_t* OD) {
    const int fr = c.fr, fq = c.fq, mt = c.wid;
    const float decc = *(const float*)(bc + SC_S + 128 * 4);
#pragma unroll
    for (int j = 0; j < 2; ++j) {
        const int dt = 2 * c.wid + j;
        const bf16x8 aK0 = *(const bf16x8*)(bc + SC_KT + (16 * dt + fr) * 144 + (8 * fq) * 2), aK1 = *(const bf16x8*)(bc + SC_KT + (16 * dt + fr) * 144 + (32 + 8 * fq) * 2);
#pragma unroll
        for (int e = 0; e < 2; ++e) {
            f32x4 a = Sacc[j][e] * decc;
            const bf16x8 b0 = *(const bf16x8*)(lds + SC_VE + (16 * e + fr) * 144 + (8 * fq) * 2), b1 = *(const bf16x8*)(lds + SC_VE + (16 * e + fr) * 144 + (32 + 8 * fq) * 2);
            a = __builtin_amdgcn_mfma_f32_16x16x32_bf16(aK0, b0, a, 0, 0, 0);
            a = __builtin_amdgcn_mfma_f32_16x16x32_bf16(aK1, b1, a, 0, 0, 0);
            Sacc[j][e] = a;
        }
    }
    if (!ctx) {
        const bf16x8 aA0 = *(const bf16x8*)(bc + SC_AT + (16 * mt + fr) * 144 + (8 * fq) * 2), aA1 = *(const bf16x8*)(bc + SC_AT + (16 * mt + fr) * 144 + (32 + 8 * fq) * 2);
        float egc[4];
#pragma unroll
        for (int r = 0; r < 4; ++r) egc[r] = *(const float*)(bc + SC_S + (16 * mt + 4 * fq + r) * 4);
#pragma unroll
        for (int nt = 0; nt < 2; ++nt) {
            const bf16x8 b0 = *(const bf16x8*)(lds + SC_VT + (16 * nt + fr) * 144 + (8 * fq) * 2), b1 = *(const bf16x8*)(lds + SC_VT + (16 * nt + fr) * 144 + (32 + 8 * fq) * 2);
            f32x4 O2 = (f32x4){0.f, 0.f, 0.f, 0.f};
            O2 = __builtin_amdgcn_mfma_f32_16x16x32_bf16(aA0, b0, O2, 0, 0, 0);
            O2 = __builtin_amdgcn_mfma_f32_16x16x32_bf16(aA1, b1, O2, 0, 0, 0);
#pragma unroll
            for (int r = 0; r < 4; ++r) OD[(size_t)(row0 + 16 * mt + 4 * fq + r) * 1024 + c.h * 128 + 32 * c.sl + 16 * nt + fr] = f2bf(egc[r] * O1[nt][r] + O2[r]);
        }
    }
#pragma unroll
    for (int j = 0; j < 2; ++j)
#pragma unroll
        for (int e = 0; e < 2; ++e) { uint2 w; w.x = pk2_c(Sacc[j][e][0], Sacc[j][e][1]); w.y = pk2_c(Sacc[j][e][2], Sacc[j][e][3]);
            *(uint2*)(lds + SC_ST + (16 * e + fr) * 272 + (16 * (2 * c.wid + j) + 4 * fq) * 2) = w; }
}
__device__ __forceinline__ void phase_gdn_scan(const Params& p, unsigned char* lds) {
    ScanCtx c;
    const int tid = otid(), lane = tid & 63; c.wid = __builtin_amdgcn_readfirstlane(tid >> 6); c.fr = lane & 15; c.fq = lane >> 4;
    const bool loader = c.wid >= 4; c.lt = tid - 256;
    c.KT = (const bf16_t*)(p.ws + OFF_KT); c.QO = (const bf16_t*)(p.ws + OFF_Q); c.UW = (const bf16_t*)(p.ws + OFF_UW);
    c.ATT = (const bf16_t*)(p.ws + OFF_ATT); c.GSC = (const float*)(p.ws + OFF_GSC);
    for (int work = blockIdx.x; work < 256; work += gridDim.x) {
        const int xcd_ = work & 7, idx_ = work >> 3, grp_ = (idx_ >> 2) * 8 + xcd_;
        c.sl = idx_ & 3; c.d = grp_ & 1; c.h = (grp_ >> 1) & 7; c.b = grp_ >> 4;
        bf16_t* OD = (bf16_t*)(p.ws + (c.d ? OFF_OB : OFF_OF));
        for (int i = tid; i < 8704 / 4; i += NT) ((unsigned*)(lds + SC_ST))[i] = 0u;
        if (loader) {
            ScanLd L0, L1;
#define SCAN_ZERO(L_) do { _Pragma("unroll") for (int i = 0; i < 4; ++i) { L_.w[i] = make_uint4(0u, 0u, 0u, 0u); L_.k[i] = make_uint4(0u, 0u, 0u, 0u); L_.q[i] = make_uint4(0u, 0u, 0u, 0u); } \
                L_.a[0] = make_uint4(0u, 0u, 0u, 0u); L_.a[1] = make_uint4(0u, 0u, 0u, 0u); L_.u = make_uint4(0u, 0u, 0u, 0u); L_.sc = 0.f; } while (0)
            SCAN_ZERO(L0); SCAN_ZERO(L1);
#undef SCAN_ZERO
            scan_load(c, L0, 0); scan_store(c, L0, lds); scan_load(c, L1, 1);
            __syncthreads();
#define SCAN_LSTEP(s_, LD_, ST_) do { const int ss_ = (s_); if (ss_ + 2 < NCHUNK) scan_load(c, LD_, ss_ + 2); __syncthreads(); \
                if (ss_ + 1 < NCHUNK) scan_store(c, ST_, lds + ((ss_ + 1) & 1) * SC_BUF); __syncthreads(); } while (0)
#pragma unroll 1
            for (int s = 0; s < NCHUNK; s += 2) {
                SCAN_LSTEP(s, L0, L1); SCAN_LSTEP(s + 1, L1, L0); }
#undef SCAN_LSTEP
        } else {
            f32x4 Sacc[2][2];
#pragma unroll
            for (int j = 0; j < 2; ++j) { Sacc[j][0] = (f32x4){0.f, 0.f, 0.f, 0.f}; Sacc[j][1] = (f32x4){0.f, 0.f, 0.f, 0.f}; }
            __syncthreads();
#pragma unroll 1
            for (int s = 0; s < NCHUNK; ++s) {
                int item, row0; bool ctx; scan_item(c, s, item, ctx, row0); (void)item;
                const unsigned char* bc = lds + (s & 1) * SC_BUF; f32x4 O1[2];
                scan_alpha(c, lds, bc, ctx, O1);
                __syncthreads();
                scan_beta(c, lds, bc, ctx, row0, O1, Sacc, OD);
                __syncthreads();
            }
        }
    }
}

__device__ __forceinline__ void phase_gdn_out(const Params& p) {
    const bf16_t* OFp = (const bf16_t*)(p.ws + OFF_OF); const bf16_t* OBp = (const bf16_t*)(p.ws + OFF_OB); const bf16_t* PZ = (const bf16_t*)(p.ws + OFF_PZ);
    bf16_t* MIX = (bf16_t*)(p.ws + OFF_H); const float* gn = p.in[14];
    const size_t total = (size_t)MLAT * 128, stride = (size_t)gridDim.x * NT;
    size_t e = (size_t)blockIdx.x * NT + otid();
    uint4 ua, ub, uz, na, nb, nz;
    if (e < total) { const size_t row = e >> 7; const int c8 = (int)(e & 127) * 8; ua = *(const uint4*)(OFp + row * 1024 + c8); ub = *(const uint4*)(OBp + row * 1024 + c8); uz = *(const uint4*)(PZ + row * 1024 + c8); }
    for (; e < total; e += stride) {
        const size_t en = e + stride;
        if (en < total) { const size_t row = en >> 7; const int c8 = (int)(en & 127) * 8; na = *(const uint4*)(OFp + row * 1024 + c8); nb = *(const uint4*)(OBp + row * 1024 + c8); nz = *(const uint4*)(PZ + row * 1024 + c8); }
        const size_t row = e >> 7; const int c8 = (int)(e & 127) * 8;
        float a[8], bq[8], z[8];
        unpack8(ua, a); unpack8(ub, bq); unpack8(uz, z);
        float ss = 0.f;
#pragma unroll
        for (int j = 0; j < 8; ++j) { a[j] += bq[j]; ss += a[j] * a[j]; }
        ss += __shfl_xor(ss, 1); ss += __shfl_xor(ss, 2); ss += __shfl_xor(ss, 4); ss += __shfl_xor(ss, 8);
        const float rstd = rsqrtf(ss * (1.0f / 128.0f) + EPSF);
#pragma unroll
        for (int j = 0; j < 8; ++j) a[j] = a[j] * rstd * gn[(c8 & 127) + j] * silu(z[j]);
        *(uint4*)(MIX + row * DM + c8) = pack8(a);
        ua = na; ub = nb; uz = nz;
    }
}

__device__ __forceinline__ void phase_postmix(const Params& p) {
    const int tid_ = otid(), lane = tid_ & 63, wv = __builtin_amdgcn_readfirstlane(tid_ >> 6);
    const float* MOD = (const float*)(p.ws + OFF_MOD); const float* w1 = p.in[7]; const float* w2 = p.in[8];
    const bf16_t* OUT = (const bf16_t*)(p.ws + OFF_OUT); bf16_t* H = (bf16_t*)(p.ws + OFF_H); bf16_t* S1B = (bf16_t*)(p.ws + OFF_S1B);
    const int stride = gridDim.x * 8;
    uint4 ov[4], ovn[4]; float4 xv[8], xvn[8];
    int row = blockIdx.x * 8 + wv;
    if (row < MLAT) {
#pragma unroll
        for (int i = 0; i < 4; ++i) { ov[i] = *(const uint4*)(OUT + (size_t)row * DM + 8 * (lane + 64 * i));
            xv[2 * i] = *(const float4*)(p.in[0] + (size_t)row * DM + 8 * (lane + 64 * i)); xv[2 * i + 1] = *(const float4*)(p.in[0] + (size_t)row * DM + 8 * (lane + 64 * i) + 4); } }
    for (; row < MLAT; row += stride) {
        const int nxt = row + stride;
        if (nxt < MLAT) {
#pragma unroll
            for (int i = 0; i < 4; ++i) { ovn[i] = *(const uint4*)(OUT + (size_t)nxt * DM + 8 * (lane + 64 * i));
                xvn[2 * i] = *(const float4*)(p.in[0] + (size_t)nxt * DM + 8 * (lane + 64 * i)); xvn[2 * i + 1] = *(const float4*)(p.in[0] + (size_t)nxt * DM + 8 * (lane + 64 * i) + 4); } }
        const int b = row >> 13; const float* mb = MOD + b * (6 * DM);
        const float* ga = mb + 2 * DM; const float* shf = mb + 3 * DM; const float* scf = mb + 4 * DM;
        float o[4][8]; float ss = 0.f;
#pragma unroll
        for (int i = 0; i < 4; ++i) { unpack8(ov[i], o[i]);
#pragma unroll
            for (int j = 0; j < 8; ++j) ss += o[i][j] * o[i][j]; }
        ss = wave_sum(ss); const float rstd = rsqrtf(ss * (1.0f / DM) + EPSF);
        float ss2 = 0.f;
#pragma unroll
        for (int i = 0; i < 4; ++i) { const int col = 8 * (lane + 64 * i);
#pragma unroll
            for (int hh = 0; hh < 2; ++hh) { const float4 xq = xv[2 * i + hh], wv4 = *(const float4*)(w1 + col + 4 * hh), gv = *(const float4*)(ga + col + 4 * hh);
                float4 s; s.x = xq.x + gv.x * o[i][4 * hh] * rstd * wv4.x; s.y = xq.y + gv.y * o[i][4 * hh + 1] * rstd * wv4.y; s.z = xq.z + gv.z * o[i][4 * hh + 2] * rstd * wv4.z; s.w = xq.w + gv.w * o[i][4 * hh + 3] * rstd * wv4.w;
                o[i][4 * hh] = s.x; o[i][4 * hh + 1] = s.y; o[i][4 * hh + 2] = s.z; o[i][4 * hh + 3] = s.w;
                ss2 += s.x * s.x + s.y * s.y + s.z * s.z + s.w * s.w; } }
        ss2 = wave_sum(ss2); const float rstd2 = rsqrtf(ss2 * (1.0f / DM) + EPSF);
#pragma unroll
        for (int i = 0; i < 4; ++i) { const int col = 8 * (lane + 64 * i); float f[8];
#pragma unroll
            for (int j = 0; j < 8; ++j) f[j] = o[i][j] * rstd2 * w2[col + j] * (1.f + scf[col + j]) + shf[col + j];
            *(uint4*)(H + (size_t)row * DM + col) = pack8(f); *(uint4*)(S1B + (size_t)row * DM + col) = pack8(o[i]); }
#pragma unroll
        for (int i = 0; i < 4; ++i) { ov[i] = ovn[i]; xv[2 * i] = xvn[2 * i]; xv[2 * i + 1] = xvn[2 * i + 1]; }
    }
}

__device__ __forceinline__ void phase_final(const Params& p) {
    const int tid_ = otid(), lane = tid_ & 63, wv = __builtin_amdgcn_readfirstlane(tid_ >> 6);
    const float* MOD = (const float*)(p.ws + OFF_MOD); const float* w = p.in[9]; const bf16_t* FF = (const bf16_t*)(p.ws + OFF_FF); const bf16_t* S1B = (const bf16_t*)(p.ws + OFF_S1B);
    const int stride = gridDim.x * 8;
    uint4 fv[4], fvn[4], sv[4], svn[4];
    int row = blockIdx.x * 8 + wv;
    if (row < MLAT) {
#pragma unroll
        for (int i = 0; i < 4; ++i) { fv[i] = *(const uint4*)(FF + (size_t)row * DM + 8 * (lane + 64 * i)); sv[i] = *(const uint4*)(S1B + (size_t)row * DM + 8 * (lane + 64 * i)); } }
    for (; row < MLAT; row += stride) {
        const int nxt = row + stride;
        if (nxt < MLAT) {
#pragma unroll
            for (int i = 0; i < 4; ++i) { fvn[i] = *(const uint4*)(FF + (size_t)nxt * DM + 8 * (lane + 64 * i)); svn[i] = *(const uint4*)(S1B + (size_t)nxt * DM + 8 * (lane + 64 * i)); } }
        const int b = row >> 13; const float* gf = MOD + b * (6 * DM) + 5 * DM;
        float o[4][8]; float ss = 0.f;
#pragma unroll
        for (int i = 0; i < 4; ++i) { unpack8(fv[i], o[i]);
#pragma unroll
            for (int j = 0; j < 8; ++j) ss += o[i][j] * o[i][j]; }
        ss = wave_sum(ss); const float rstd = rsqrtf(ss * (1.0f / DM) + EPSF);
#pragma unroll
        for (int i = 0; i < 4; ++i) { const int col = 8 * (lane + 64 * i); float s1[8]; unpack8(sv[i], s1);
#pragma unroll
            for (int hh = 0; hh < 2; ++hh) { const float4 wv4 = *(const float4*)(w + col + 4 * hh), gv = *(const float4*)(gf + col + 4 * hh); float4 s;
                s.x = s1[4 * hh] + gv.x * o[i][4 * hh] * rstd * wv4.x; s.y = s1[4 * hh + 1] + gv.y * o[i][4 * hh + 1] * rstd * wv4.y;
                s.z = s1[4 * hh + 2] + gv.z * o[i][4 * hh + 2] * rstd * wv4.z; s.w = s1[4 * hh + 3] + gv.w * o[i][4 * hh + 3] * rstd * wv4.w;
                *(float4*)(p.out + (size_t)row * DM + col + 4 * hh) = s; } }
#pragma unroll
        for (int i = 0; i < 4; ++i) { fv[i] = fvn[i]; sv[i] = svn[i]; }
    }
}

#define XB_TMO      128
#define XB_XCNT(j)  (256  + 64 * (j))
#define XB_XSUB(j)  (1280 + 64 * (j))
#define XB_XGEN(j)  (2304 + 64 * (j))
#define XB_TOP      3328
#define XB_TOPGEN   3392
#define XCD_BAR_WORDS 3456
#define XB_SPIN_CAP (1u << 18)
#define LAS __attribute__((address_space(3)))

__device__ __forceinline__ unsigned xb_ld(unsigned* p)              { return __hip_atomic_load(p, __ATOMIC_RELAXED, __HIP_MEMORY_SCOPE_AGENT); }
__device__ __forceinline__ unsigned xb_add(unsigned* p, unsigned v) { return __hip_atomic_fetch_add(p, v, __ATOMIC_RELAXED, __HIP_MEMORY_SCOPE_AGENT); }
__device__ __forceinline__ unsigned xb_xcc_id() { return (unsigned)__builtin_amdgcn_s_getreg((3 << 11) | 20) & 0xFu; }
#define XB_SPIN(cond, bar) do { unsigned _sp = 0; while (cond) { __builtin_amdgcn_s_sleep(1); \
    if ((++_sp & 255u) == 0u) { if (xb_ld(&(bar)[XB_TMO])) break; if (_sp > XB_SPIN_CAP) { atomicAdd(&(bar)[XB_TMO], 1u); break; } } } } while (0)

struct XcdBarrier {
    unsigned* bar; unsigned x;
    volatile LAS unsigned* st;
};

__device__ __forceinline__ XcdBarrier xcd_barrier_post(unsigned* bar, volatile LAS unsigned* st) {
    XcdBarrier b; b.bar = bar; b.x = xb_xcc_id(); b.st = st;
    if (threadIdx.x == 0) (void)xb_add(&bar[XB_XCNT(b.x)], 1u);
    return b;
}
__device__ __forceinline__ void xcd_barrier_complete(unsigned* bar, unsigned x, unsigned& nloc, unsigned& nx) {
    const unsigned G = gridDim.x * gridDim.y * gridDim.z;
    unsigned sum, cnt, mine, sp = 0u;
    for (;;) {
        sum = 0u; cnt = 0u; mine = 0u;
#pragma unroll
        for (unsigned j = 0; j < 16; ++j) { const unsigned c = xb_ld(&bar[XB_XCNT(j)]); sum += c; cnt += (c > 0u) ? 1u : 0u; mine = (j == x) ? c : mine; }
        if (sum == G) break;
        __builtin_amdgcn_s_sleep(1);
        if ((++sp & 255u) == 0u) { if (xb_ld(&bar[XB_TMO])) break; if (sp > XB_SPIN_CAP) { atomicAdd(&bar[XB_TMO], 1u); break; } }
    }
    nloc = mine > 0u ? mine : 1u; nx = cnt > 0u ? cnt : 1u;
}

__device__ __forceinline__ void xcd_barrier(const XcdBarrier& b) {
    asm volatile("s_waitcnt vmcnt(0)" ::: "memory");
    __syncthreads();
    if (threadIdx.x == 0) {
        unsigned* bar = b.bar;
        __builtin_amdgcn_s_waitcnt(0);
        unsigned nloc = b.st[0], nx = b.st[1];
        if (nloc == 0u) { xcd_barrier_complete(bar, b.x, nloc, nx); b.st[0] = nloc; b.st[1] = nx; }
        const unsigned old = xb_add(&bar[XB_XSUB(b.x)], 1u);
        const unsigned gen = old / nloc;
        if (old + 1u == (gen + 1u) * nloc) {
            __builtin_amdgcn_fence(__ATOMIC_RELEASE, "agent");
            asm volatile("s_waitcnt vmcnt(0)" ::: "memory");
            const unsigned og = xb_add(&bar[XB_TOP], 1u);
            const unsigned tg = og / nx;
            if (og + 1u == (tg + 1u) * nx) xb_add(&bar[XB_TOPGEN], 1u);
            else XB_SPIN(xb_ld(&bar[XB_TOPGEN]) == tg, bar);
            __builtin_amdgcn_fence(__ATOMIC_ACQUIRE, "agent");
            xb_add(&bar[XB_XGEN(b.x)], 1u);
            asm volatile("s_waitcnt vmcnt(0)" ::: "memory");
        } else {
            XB_SPIN(xb_ld(&bar[XB_XGEN(b.x)]) == gen, bar);
            __builtin_amdgcn_fence(__ATOMIC_ACQUIRE, "agent");
            asm volatile("s_waitcnt vmcnt(0)" ::: "memory");
        }
    }
    __syncthreads();
}


constexpr int NPHASE = 14;
template <class Epi> __device__ __forceinline__ void run_gemm(unsigned char* lds, const bf16_t* A, const bf16_t* Bt, int M, int N, int K, const Epi& E) {
    pg8::Gemm g{A, Bt, M, N, K}; pg8::StaticOrder S; S.init(M, N, (int)gridDim.x, (int)blockIdx.x);
    pg8::gemm_phase<Epi, pg8::StaticOrder, true, true>((PG8_LAS unsigned char*)lds, g, S, E);
}
__global__ void __launch_bounds__(NT, 2) fwd_kernel(Params p) {
    extern __shared__ __attribute__((aligned(16))) unsigned char lds[];
    cg::grid_group grid = cg::this_grid();
    const int lo = p.ph_lo, hi = p.ph_hi;
    unsigned char* ws = p.ws;
    if (lo < 0) grid.sync();
    if (threadIdx.x == 0) *(uint4*)(lds + LDS_BYTES - 16) = make_uint4(0u, 0u, 0u, 0u);
    __syncthreads();
    XcdBarrier xbar = xcd_barrier_post((unsigned*)(ws + OFF_BAR), (volatile LAS unsigned*)((LAS unsigned char*)lds + (LDS_BYTES - 16)));
#ifndef PH_MASK
#define PH_MASK 0xffff
#endif
#ifndef REP_MASK
#define REP_MASK 0
#endif
#define IN(k) ((((PH_MASK) >> (k)) & 1) && lo <= (k) && (k) < hi)
#define REP(k, stmt) do { if (IN(k)) { const int nrep_ = 1 + ((REP_MASK >> (k)) & 1); _Pragma("unroll 1") for (int rep_ = 0; rep_ < nrep_; ++rep_) { if (rep_) xcd_barrier(xbar); stmt; } } } while (0)
#define SEAM(k) do { if (IN(k) && IN((k) + 1)) xcd_barrier(xbar); } while (0)
    REP(0, phase_prologue(p, lds));
    SEAM(0);
    REP(1, phase_prenorm(p));
    SEAM(1);
    { pg8::EpiProj E{(bf16_t*)(ws + OFF_PGDN), (bf16_t*)(ws + OFF_PZ), (bf16_t*)(ws + OFF_PHY), (float*)(ws + OFF_GATES)};
        REP(2, run_gemm(lds, (const bf16_t*)(ws + OFF_H), (const bf16_t*)(ws + OFF_WIN), MALL, N1, DM, E)); }
    SEAM(2);
#pragma unroll 1
    for (int rep_ = 0; rep_ < 1 + ((REP_MASK >> 3) & 1); ++rep_) {
    if (IN(3)) phase_hy1(p, lds);
    SEAM(3);
    if (IN(4)) phase_hy2(p, lds);
    SEAM(4);
    if (IN(5)) phase_hy3(p, lds);
    SEAM(5);
    }
    REP(6, phase_gdn_prep(p, lds));
    SEAM(6);
    REP(7, phase_gdn_scan(p, lds));
    SEAM(7);
    REP(8, phase_gdn_out(p));
    SEAM(8);
    { pg8::EpiPlain E{(bf16_t*)(ws + OFF_OUT), DM};
        REP(9, run_gemm(lds, (const bf16_t*)(ws + OFF_H), (const bf16_t*)(ws + OFF_WOUT), MLAT, DM, DM, E)); }
    SEAM(9);
    REP(10, phase_postmix(p));
    SEAM(10);
    { pg8::EpiSwiglu E{(bf16_t*)(ws + OFF_ACT), DFF};
        REP(11, run_gemm(lds, (const bf16_t*)(ws + OFF_H), (const bf16_t*)(ws + OFF_WGU), MLAT, 2 * DFF, DM, E)); }
    SEAM(11);
    { pg8::EpiPlain E{(bf16_t*)(ws + OFF_FF), DM};
        REP(12, run_gemm(lds, (const bf16_t*)(ws + OFF_ACT), (const bf16_t*)(ws + OFF_WDOWN), MLAT, DM, DFF, E)); }
    SEAM(12);
    if (IN(13)) phase_final(p);
#undef IN
#undef REP
#undef SEAM
}

extern "C" void kernel_launch(void* const* d_in, const int* in_sizes, int n_in, void* d_out, int out_size, void* d_ws, size_t ws_size, hipStream_t stream) {
    static int grid = 0;
    if (grid == 0) {
        if (n_in != 32 || ws_size < WS_TOTAL) { fprintf(stderr, "kernel_launch: need 32 inputs and %zu bytes of workspace (got %d, %zu)\n", (size_t)WS_TOTAL, n_in, ws_size); grid = -1; return; }
        int dev = 0, cus = 0, per_cu = 0;
        hipGetDevice(&dev); hipDeviceGetAttribute(&cus, hipDeviceAttributeMultiprocessorCount, dev);
        if (hipFuncSetAttribute((const void*)fwd_kernel, hipFuncAttributeMaxDynamicSharedMemorySize, LDS_BYTES) != hipSuccess) { fprintf(stderr, "kernel_launch: hipFuncSetAttribute failed\n"); grid = -1; return; }
        if (hipOccupancyMaxActiveBlocksPerMultiprocessor(&per_cu, (const void*)fwd_kernel, NT, LDS_BYTES) != hipSuccess || per_cu < 1) { fprintf(stderr, "kernel_launch: occupancy query gave %d\n", per_cu); per_cu = 1; }
        (void)hipGetLastError();
        grid = cus * per_cu;
    }
    if (grid < 0) return;
    if (hipMemsetAsync((unsigned char*)d_ws + OFF_BAR, 0, XCD_BAR_WORDS * 4, stream) != hipSuccess) { fprintf(stderr, "kernel_launch: memset of the barrier words failed\n"); return; }
    Params p{};
    for (int i = 0; i < 32; ++i) p.in[i] = (const float*)d_in[i];
    p.out = (float*)d_out; p.ws = (unsigned char*)d_ws;
#if MULTI_LAUNCH
    for (int ph = 0; ph < NPHASE; ++ph) { p.ph_lo = ph; p.ph_hi = ph + 1;
        hipLaunchKernelGGL(fwd_kernel, dim3(grid), dim3(NT), LDS_BYTES, stream, p); }
#else
    p.ph_lo = 0; p.ph_hi = NPHASE;
    void* args[] = {&p};
    hipError_t e = hipLaunchCooperativeKernel((const void*)fwd_kernel, dim3(grid), dim3(NT), args, LDS_BYTES, stream);
    if (e != hipSuccess) fprintf(stderr, "cooperative launch failed: %s (grid %d)\n", hipGetErrorString(e), grid);
#endif
}
```

```cpp
#include <hip/hip_runtime.h>
#include <hip/hip_cooperative_groups.h>
#include <cstdio>
#include <cstdint>
namespace cg = cooperative_groups;

#ifndef MULTI_LAUNCH
#define MULTI_LAUNCH 0
#endif

__device__ __forceinline__ int otid() { int t = threadIdx.x; asm volatile("" : "+v"(t)); return t; }

#undef MULTI_LAUNCH
#define MULTI_LAUNCH 0
#define REP_MASK 0
namespace pg8 {
#define PG8_LAS __attribute__((address_space(3)))
typedef unsigned short bf16_t;
typedef short bf16x8 __attribute__((ext_vector_type(8)));
typedef float f32x4 __attribute__((ext_vector_type(4)));
typedef unsigned u32x4 __attribute__((ext_vector_type(4)));
constexpr int BM = 256, BK = 64, HALF = 128, HTB = HALF * BK * 2  , STAGE_BYTES = 8 * HTB, NXCD = 8, WGM = 8;

__host__ __device__ __forceinline__ int lds_byte(int r, int c) { const int st = (r >> 4) * 2 + (c >> 5), rr = r & 15, cc = c & 31, ob = rr * 64 + cc * 2; return st * 1024 + (ob ^ (((ob >> 9) & 1) << 5)); }
__host__ __device__ __forceinline__ void stage_rc(int b, int& R, int& C) { const int st = b / 1024, sb = b % 1024, swz = sb ^ (((sb >> 9) & 1) << 5); R = (st >> 1) * 16 + swz / 64; C = (st & 1) * 32 + (swz % 64) / 2; }
__host__ __device__ __forceinline__ int perm32(int rho) { const int n = rho >> 4, i = rho & 15; return 8 * (i >> 2) + 4 * n + (i & 3); }

struct Unit { int pm, pn; };
struct Gemm { const bf16_t* A; const bf16_t* Bt; int M, N, K; };

struct StaticOrder {
    int nM, nN, nwg, G, c;
    __host__ __device__ void init(int M, int N, int G_, int c_) { nM = M / BM; nN = N / BM; nwg = nM * nN; G = G_; c = c_; }
    __host__ __device__ bool next(int i, Unit& u) const {
        const long L = (long)i * G + c; if (L >= nwg) return false;
        int wgid = (int)L; { const int q = nwg / NXCD, r = nwg % NXCD, xcd = wgid % NXCD, off = wgid / NXCD; wgid = (xcd < r ? xcd * (q + 1) : r * (q + 1) + (xcd - r) * q) + off; }
        const int nig = WGM * nN, gid = wgid / nig, fm = gid * WGM, gsz = (nM - fm) < WGM ? (nM - fm) : WGM;
        u.pm = fm + ((wgid % nig) % gsz); u.pn = (wgid % nig) / gsz; return true;
    }
    __device__ __forceinline__ void a_ready(const Unit&) const {}
    __device__ __forceinline__ void done(const Unit&) const {}
};

__device__ __forceinline__ unsigned cvt_pk_bf16(float lo, float hi) { unsigned r; asm volatile("v_cvt_pk_bf16_f32 %0, %1, %2" : "=v"(r) : "v"(lo), "v"(hi)); return r; }
__device__ __forceinline__ float silu_f(float x) { return x * __builtin_amdgcn_rcpf(1.0f + __expf(-x)); }

struct EpiPlain {
    static constexpr bool PERM = true, AFTER_DRAIN = false;
    bf16_t* O; int ldc;
    __device__ __forceinline__ void operator()(const f32x4 (&acc)[2][2][4][2], const Unit& u, int wr, int wc, int fr, int fq) const {
        const int row0 = u.pm * BM + wr * 64 + fr, col0 = u.pn * BM + wc * 32 + 8 * fq;
#pragma unroll
        for (int ai = 0; ai < 2; ++ai)
#pragma unroll
            for (int m = 0; m < 4; ++m) { bf16_t* rowp = O + (size_t)(row0 + ai * HALF + m * 16) * ldc + col0;
#pragma unroll
                for (int bj = 0; bj < 2; ++bj) { const f32x4 v0 = acc[ai][bj][m][0], v1 = acc[ai][bj][m][1];
                    u32x4 w; w.x = cvt_pk_bf16(v0[0], v0[1]); w.y = cvt_pk_bf16(v0[2], v0[3]); w.z = cvt_pk_bf16(v1[0], v1[1]); w.w = cvt_pk_bf16(v1[2], v1[3]);
                    *(u32x4*)(rowp + bj * HALF) = w; } }
    }
};
struct EpiProj {
    static constexpr bool PERM = true, AFTER_DRAIN = false;
    bf16_t* pgdn; bf16_t* pz; bf16_t* phy; float* gates;
    __device__ __forceinline__ void operator()(const f32x4 (&acc)[2][2][4][2], const Unit& u, int wr, int wc, int fr, int fq) const {
        const int row0 = u.pm * BM + wr * 64 + fr, pn = u.pn;
        if (pn < 28) {
            bf16_t* base; int ld, colt;
            if (pn < 12) { base = pgdn; ld = 3072; colt = pn * 256; }
            else if (pn < 16) { base = pz; ld = 1024; colt = (pn - 12) * 256; }
            else { base = phy; ld = 3072; colt = (pn - 16) * 256; }
            const int col0 = colt + wc * 32 + 8 * fq;
#pragma unroll
            for (int ai = 0; ai < 2; ++ai)
#pragma unroll
                for (int m = 0; m < 4; ++m) { bf16_t* rowp = base + (size_t)(row0 + ai * HALF + m * 16) * ld + col0;
#pragma unroll
                    for (int bj = 0; bj < 2; ++bj) { const f32x4 v0 = acc[ai][bj][m][0], v1 = acc[ai][bj][m][1];
                        u32x4 w; w.x = cvt_pk_bf16(v0[0], v0[1]); w.y = cvt_pk_bf16(v0[2], v0[3]); w.z = cvt_pk_bf16(v1[0], v1[1]); w.w = cvt_pk_bf16(v1[2], v1[3]);
                        *(u32x4*)(rowp + bj * HALF) = w; } }
        } else if (wc == 0) {
#pragma unroll
            for (int ai = 0; ai < 2; ++ai)
#pragma unroll
                for (int m = 0; m < 4; ++m) { float* rowp = gates + (size_t)(row0 + ai * HALF + m * 16) * 32 + 8 * fq;
                    *(f32x4*)(rowp) = acc[ai][0][m][0]; *(f32x4*)(rowp + 4) = acc[ai][0][m][1]; }
        }
    }
};
struct EpiSwiglu {
    static constexpr bool PERM = true, AFTER_DRAIN = false;
    bf16_t* O; int ldc;
    __device__ __forceinline__ void operator()(const f32x4 (&acc)[2][2][4][2], const Unit& u, int wr, int wc, int fr, int fq) const {
        const int row0 = u.pm * BM + wr * 64 + fr, col0 = u.pn * HALF + wc * 32 + 8 * fq;
#pragma unroll
        for (int ai = 0; ai < 2; ++ai)
#pragma unroll
            for (int m = 0; m < 4; ++m) { bf16_t* rowp = O + (size_t)(row0 + ai * HALF + m * 16) * ldc + col0;
                const f32x4 g0 = acc[ai][0][m][0], g1 = acc[ai][0][m][1], u0 = acc[ai][1][m][0], u1 = acc[ai][1][m][1];
                u32x4 w;
                w.x = cvt_pk_bf16(silu_f(g0[0]) * u0[0], silu_f(g0[1]) * u0[1]); w.y = cvt_pk_bf16(silu_f(g0[2]) * u0[2], silu_f(g0[3]) * u0[3]);
                w.z = cvt_pk_bf16(silu_f(g1[0]) * u1[0], silu_f(g1[1]) * u1[1]); w.w = cvt_pk_bf16(silu_f(g1[2]) * u1[2], silu_f(g1[3]) * u1[3]);
                *(u32x4*)(rowp) = w; }
    }
};

template <class Epi, class Sched, bool ALIGN_EPI = false, bool SP2 = false>
__device__ __forceinline__ void gemm_phase(PG8_LAS unsigned char* lds, const Gemm g, const Sched& S, const Epi& E) {
    const int tid = otid(), wid = __builtin_amdgcn_readfirstlane(tid >> 6), lane = tid & 63, wr = wid >> 2, wc = wid & 3, fr = lane & 15, fq = lane >> 4;
    const int K = g.K, nt = K / BK;
    unsigned voffA[2], voffB[2];
#pragma unroll
    for (int i = 0; i < 2; ++i) { int R, C; stage_rc(tid * 16 + i * 8192, R, C); const int Rb = Epi::PERM ? ((R & ~31) + perm32(R & 31)) : R;
        voffA[i] = (unsigned)(R * K + C) * 2u; voffB[i] = (unsigned)(Rb * K + C) * 2u; }
    const size_t kstep = (size_t)(BK * 2);
    const size_t hstep = (size_t)HALF * K * 2;
    const size_t tstep = 2 * hstep;
    const unsigned ldsw = (unsigned)wid * 1024u;
    const int aoff = lds_byte(wr * 64 + fr, fq * 8), boff = lds_byte(wc * 32 + fr, fq * 8);
#define PG8_SA(b, h) (((b) * 2 + (h)) * HTB)
#define PG8_SB(b, h) ((4 + (b) * 2 + (h)) * HTB)
#define PG8_STAGE(bufoff, gbase, voff) do { _Pragma("unroll") for (int _i = 0; _i < 2; ++_i) \
        __builtin_amdgcn_global_load_lds((const unsigned*)((const char*)(gbase) + (voff)[_i]), (PG8_LAS unsigned*)(lds + (bufoff) + ldsw + _i * 8192), 16, 0, 0); } while (0)
#define PG8_LDA(dst, b, h) do { _Pragma("unroll") for (int m = 0; m < 4; ++m) _Pragma("unroll") for (int k = 0; k < 2; ++k) dst[m][k] = *(const PG8_LAS bf16x8*)(lds + PG8_SA(b, h) + aoff + m * 2048 + k * 1024); } while (0)
#define PG8_LDB(dst, b, h) do { _Pragma("unroll") for (int n = 0; n < 2; ++n) _Pragma("unroll") for (int k = 0; k < 2; ++k) dst[n][k] = *(const PG8_LAS bf16x8*)(lds + PG8_SB(b, h) + boff + n * 2048 + k * 1024); } while (0)
#define PG8_MMA(ai, bj, At, Bt) do { __builtin_amdgcn_s_setprio(1); _Pragma("unroll") for (int m = 0; m < 4; ++m) _Pragma("unroll") for (int n = 0; n < 2; ++n) _Pragma("unroll") for (int k = 0; k < 2; ++k) \
        acc[ai][bj][m][n] = __builtin_amdgcn_mfma_f32_16x16x32_bf16(Bt[n][k], At[m][k], acc[ai][bj][m][n], 0, 0, 0); __builtin_amdgcn_s_setprio(0); } while (0)
#define PG8_WAIT_V(n) asm volatile("s_waitcnt vmcnt(" #n ")" ::: "memory")
#define PG8_WAIT_L(n) asm volatile("s_waitcnt lgkmcnt(" #n ")" ::: "memory")
#define PG8_BAR __builtin_amdgcn_s_barrier()
#define PG8_SCHED __builtin_amdgcn_sched_barrier(0)
    Unit cur, nxt; int ui = 0;
    if (!S.next(0, cur)) return;
    f32x4 acc[2][2][4][2];
#pragma unroll
    for (int a = 0; a < 2; ++a)
#pragma unroll
        for (int b = 0; b < 2; ++b)
#pragma unroll
            for (int m = 0; m < 4; ++m)
#pragma unroll
                for (int n = 0; n < 2; ++n) acc[a][b][m][n] = (f32x4){0.f, 0.f, 0.f, 0.f};
    bf16x8 At[4][2], B0[2][2], B1[2][2];
    const char* cA = (const char*)g.A + (size_t)cur.pm * tstep; const char* cB = (const char*)g.Bt + (size_t)cur.pn * tstep;
    S.a_ready(cur);
    if constexpr (SP2) {
        PG8_STAGE(PG8_SB(0, 0), cB, voffB); PG8_STAGE(PG8_SB(0, 1), cB + hstep, voffB); PG8_STAGE(PG8_SA(0, 0), cA, voffA); PG8_STAGE(PG8_SA(0, 1), cA + hstep, voffA);
        if (wr == 1) PG8_BAR;
        PG8_WAIT_V(2); PG8_BAR;
        PG8_STAGE(PG8_SB(1, 0), cB + kstep, voffB); PG8_STAGE(PG8_SA(1, 0), cA + kstep, voffA); PG8_STAGE(PG8_SB(1, 1), cB + hstep + kstep, voffB);
        PG8_WAIT_V(6); PG8_BAR;
    } else {
        PG8_STAGE(PG8_SB(0, 0), cB, voffB); PG8_STAGE(PG8_SA(0, 0), cA, voffA); PG8_STAGE(PG8_SB(0, 1), cB + hstep, voffB); PG8_STAGE(PG8_SA(0, 1), cA + hstep, voffA);
        if (wr == 1) PG8_BAR;
        PG8_WAIT_V(4); PG8_BAR;
        PG8_STAGE(PG8_SB(1, 0), cB + kstep, voffB); PG8_STAGE(PG8_SA(1, 0), cA + kstep, voffA); PG8_STAGE(PG8_SB(1, 1), cB + hstep + kstep, voffB);
        PG8_WAIT_V(6); PG8_BAR;
    }
    for (;;) {
        const bool has_next = S.next(ui + 1, nxt);
        const char* nA = has_next ? (const char*)g.A + (size_t)nxt.pm * tstep : cA; const char* nB = has_next ? (const char*)g.Bt + (size_t)nxt.pn * tstep : cB;
        for (int t = 0; t < nt; t += 2) {
            const bool last = (t == nt - 2);
            const char* a1 = cA + (size_t)(t + 1) * kstep;
            const char* a2 = last ? nA : cA + (size_t)(t + 2) * kstep; const char* b2 = last ? nB : cB + (size_t)(t + 2) * kstep;
            const char* a3 = a2 + kstep; const char* b3 = b2 + kstep;
            if (last && has_next) S.a_ready(nxt);
            if constexpr (SP2) {
            PG8_LDB(B0, 0, 0); PG8_LDB(B1, 0, 1); PG8_SCHED; PG8_LDA(At, 0, 0); PG8_STAGE(PG8_SA(1, 1), a1 + hstep, voffA);
            PG8_WAIT_V(8); PG8_WAIT_L(0); PG8_BAR; PG8_MMA(0, 0, At, B0); PG8_MMA(0, 1, At, B1); PG8_BAR; PG8_SCHED;
            PG8_LDA(At, 0, 1); PG8_STAGE(PG8_SB(0, 0), b2, voffB); PG8_STAGE(PG8_SB(0, 1), b2 + hstep, voffB); PG8_STAGE(PG8_SA(0, 0), a2, voffA);
            PG8_WAIT_V(8); PG8_WAIT_L(0); PG8_BAR; PG8_MMA(1, 0, At, B0); PG8_MMA(1, 1, At, B1); PG8_BAR; PG8_SCHED;
            PG8_LDB(B0, 1, 0); PG8_LDB(B1, 1, 1); PG8_SCHED; PG8_LDA(At, 1, 0); PG8_STAGE(PG8_SA(0, 1), a2 + hstep, voffA);
            PG8_WAIT_V(8); PG8_WAIT_L(0); PG8_BAR; PG8_MMA(0, 0, At, B0); PG8_MMA(0, 1, At, B1); PG8_BAR; PG8_SCHED;
            PG8_LDA(At, 1, 1); PG8_STAGE(PG8_SB(1, 0), b3, voffB); PG8_STAGE(PG8_SB(1, 1), b3 + hstep, voffB); PG8_STAGE(PG8_SA(1, 0), a3, voffA);
            PG8_WAIT_V(8); PG8_WAIT_L(0); PG8_BAR; PG8_MMA(1, 0, At, B0); PG8_MMA(1, 1, At, B1); PG8_BAR; PG8_SCHED;
            } else {
            PG8_LDB(B0, 0, 0); PG8_SCHED; PG8_LDA(At, 0, 0); PG8_STAGE(PG8_SA(1, 1), a1 + hstep, voffA);
            PG8_WAIT_L(8); PG8_BAR; PG8_WAIT_L(0); PG8_MMA(0, 0, At, B0); PG8_BAR; PG8_SCHED;
            PG8_LDB(B1, 0, 1); PG8_STAGE(PG8_SB(0, 0), b2, voffB);
            PG8_BAR; PG8_WAIT_L(0); PG8_MMA(0, 1, At, B1); PG8_BAR;
            PG8_LDA(At, 0, 1); PG8_STAGE(PG8_SA(0, 0), a2, voffA);
            PG8_BAR; PG8_WAIT_L(0); PG8_MMA(1, 0, At, B0); PG8_BAR; PG8_SCHED;
            PG8_STAGE(PG8_SB(0, 1), b2 + hstep, voffB);
            PG8_WAIT_V(6); PG8_BAR; PG8_MMA(1, 1, At, B1); PG8_BAR;
            PG8_LDB(B0, 1, 0); PG8_SCHED; PG8_LDA(At, 1, 0); PG8_STAGE(PG8_SA(0, 1), a2 + hstep, voffA);
            PG8_WAIT_L(8); PG8_BAR; PG8_WAIT_L(0); PG8_MMA(0, 0, At, B0); PG8_BAR; PG8_SCHED;
            PG8_LDB(B1, 1, 1); PG8_STAGE(PG8_SB(1, 0), b3, voffB);
            PG8_BAR; PG8_WAIT_L(0); PG8_MMA(0, 1, At, B1); PG8_BAR;
            PG8_LDA(At, 1, 1); PG8_STAGE(PG8_SA(1, 0), a3, voffA);
            PG8_BAR; PG8_WAIT_L(0); PG8_MMA(1, 0, At, B0); PG8_BAR; PG8_SCHED;
            PG8_STAGE(PG8_SB(1, 1), b3 + hstep, voffB);
            PG8_WAIT_V(6); PG8_BAR; PG8_MMA(1, 1, At, B1); PG8_BAR;
            }
        }
        if constexpr (ALIGN_EPI) { if (wr == 0) PG8_BAR; }
        if constexpr (!Epi::AFTER_DRAIN) { E(acc, cur, wr, wc, fr, fq); S.done(cur); }
        if (!has_next) break;
#pragma unroll
        for (int a = 0; a < 2; ++a)
#pragma unroll
            for (int b = 0; b < 2; ++b)
#pragma unroll
                for (int m = 0; m < 4; ++m)
#pragma unroll
                    for (int n = 0; n < 2; ++n) acc[a][b][m][n] = (f32x4){0.f, 0.f, 0.f, 0.f};
        cur = nxt; cA = nA; cB = nB; ++ui;
        if constexpr (ALIGN_EPI) { if (wr == 1) PG8_BAR; }
    }
    PG8_WAIT_V(0);
    if constexpr (!ALIGN_EPI) { if (wr == 0) PG8_BAR; }
    PG8_BAR;
    if constexpr (Epi::AFTER_DRAIN) { E.fused(acc, cur, wr, wc, fr, fq, lds, wid, lane); S.done(cur); }
#undef PG8_SA
#undef PG8_SB
#undef PG8_STAGE
#undef PG8_LDA
#undef PG8_LDB
#undef PG8_MMA
#undef PG8_WAIT_V
#undef PG8_WAIT_L
#undef PG8_BAR
#undef PG8_SCHED
}
}

typedef unsigned short bf16_t;
typedef short bf16x8 __attribute__((ext_vector_type(8)));
typedef float f32x4 __attribute__((ext_vector_type(4)));
constexpr int NT = 512;
constexpr int DM = 2048, NB = 4, SL = 8192, CL = 256, MLAT = NB * SL, MCTX = NB * CL, MALL = MLAT + MCTX;
constexpr int NHD = 8, HD = 128, CHK = 64, DFF = 5632, N1 = 7424;
constexpr int NCHUNK = 132;
constexpr int NITEM = NB * NCHUNK * NHD;
constexpr float EPSF = 1e-6f;
constexpr int LDS_BYTES = 156 * 1024;

constexpr size_t al256(size_t x) { return (x + 255) & ~(size_t)255; }
constexpr size_t OFF_MOD = 0;
constexpr size_t OFF_GSC = OFF_MOD + al256((size_t)5 * 6 * DM * 4);
constexpr size_t OFF_GATES = OFF_GSC + al256((size_t)NITEM * 2 * 192 * 4);
constexpr size_t OFF_WIN = OFF_GATES + al256((size_t)MALL * 32 * 4);
constexpr size_t OFF_WOUT = OFF_WIN + al256((size_t)N1 * DM * 2);
constexpr size_t OFF_WGU = OFF_WOUT + al256((size_t)DM * DM * 2);
constexpr size_t OFF_WDOWN = OFF_WGU + al256((size_t)2 * DFF * DM * 2);
constexpr size_t OFF_H = OFF_WDOWN + al256((size_t)DM * DFF * 2);
constexpr size_t OFF_PGDN = OFF_H + al256((size_t)MALL * DM * 2);
constexpr size_t OFF_PZ = OFF_PGDN + al256((size_t)MALL * 3072 * 2);
constexpr size_t OFF_PHY = OFF_PZ + al256((size_t)MALL * 1024 * 2);
constexpr size_t OFF_UHT = OFF_PHY + al256((size_t)MALL * 3072 * 2);
constexpr size_t OFF_TAPS = OFF_UHT + al256((size_t)NB * 1024 * SL * 4);
constexpr size_t END_TAPS = OFF_TAPS + al256((size_t)1024 * 16384 * 4);
constexpr size_t OFF_KSPEC = END_TAPS;
constexpr size_t OFF_KT = OFF_PHY;
constexpr size_t OFF_Q = OFF_KT + (size_t)NITEM * 16384;
constexpr size_t OFF_UW = OFF_Q + (size_t)NITEM * 16384;
constexpr size_t OFF_ATT = OFF_UW + (size_t)NITEM * 2 * 32768;
constexpr size_t END_G2 = OFF_ATT + (size_t)NITEM * 2 * 8192;
constexpr size_t WS_END = END_G2 > END_TAPS ? END_G2 : END_TAPS;
constexpr size_t OFF_S1B = OFF_UHT;
constexpr size_t OFF_OF = OFF_PGDN;
constexpr size_t OFF_OB = OFF_PGDN + (size_t)MLAT * 1024 * 2;
constexpr size_t OFF_OUT = OFF_PGDN;
constexpr size_t OFF_ACT = OFF_PGDN;
constexpr size_t OFF_FF = OFF_H;
static_assert((size_t)MLAT * DFF * 2 <= OFF_UHT - OFF_PGDN, "act overlay");
constexpr size_t OFF_BAR = al256(WS_END);
constexpr size_t WS_TOTAL = OFF_BAR + 16384;
static_assert(WS_TOTAL <= ((size_t)1 << 30), "workspace over 1 GiB");

struct Params { const float* in[32]; float* out; unsigned char* ws; int ph_lo, ph_hi; };

__device__ __forceinline__ float bf_lo(unsigned w) { return __uint_as_float(w << 16); }
__device__ __forceinline__ float bf_hi(unsigned w) { return __uint_as_float(w & 0xffff0000u); }
__device__ __forceinline__ float bf2f(bf16_t v) { return __uint_as_float(((unsigned)v) << 16); }
__device__ __forceinline__ unsigned pk2(float lo, float hi) { return pg8::cvt_pk_bf16(lo, hi); }
__device__ __forceinline__ unsigned pk2_c(float lo, float hi) { unsigned a = __float_as_uint(lo), b = __float_as_uint(hi);
    a += 0x7fffu + ((a >> 16) & 1u); b += 0x7fffu + ((b >> 16) & 1u); return (a >> 16) | (b & 0xffff0000u); }
__device__ __forceinline__ bf16_t f2bf(float f) { return (bf16_t)(pk2(f, 0.f) & 0xffffu); }
__device__ __forceinline__ float silu(float x) { return x * __builtin_amdgcn_rcpf(1.0f + __expf(-x)); }
__device__ __forceinline__ void unpack8(const uint4 w, float (&f)[8]) {
    f[0] = bf_lo(w.x); f[1] = bf_hi(w.x); f[2] = bf_lo(w.y); f[3] = bf_hi(w.y); f[4] = bf_lo(w.z); f[5] = bf_hi(w.z); f[6] = bf_lo(w.w); f[7] = bf_hi(w.w);
}
__device__ __forceinline__ uint4 pack8(const float (&f)[8]) { uint4 w; w.x = pk2(f[0], f[1]); w.y = pk2(f[2], f[3]); w.z = pk2(f[4], f[5]); w.w = pk2(f[6], f[7]); return w; }
__device__ __forceinline__ float fsin(float x) { return __builtin_amdgcn_sinf(__builtin_amdgcn_fractf(x * 0.15915494309189535f)); }
__device__ __forceinline__ float wave_sum(float v) {
#pragma unroll
    for (int o = 32; o >= 1; o >>= 1) v += __shfl_xor(v, o);
    return v;
}

__device__ __forceinline__ void adaln_block(const Params& p, unsigned char* lds, int cb) {
    float* sc = (float*)lds;
    float* red = (float*)(lds + 5 * DM * 4);
    const int tid = otid();
    const float* c = p.in[1]; const float* cc = p.in[3]; const float* wm = p.in[4]; const float* bm = p.in[5];
    for (int i = tid; i < 5 * DM; i += NT) { const int r = i / DM, k = i % DM; const float v = r < 4 ? c[r * DM + k] : cc[k]; sc[i] = silu(v); }
    __syncthreads();
    const int l4 = tid % 12, kg = tid / 12;
    if (tid < 504) {
        float acc[5][4];
#pragma unroll
        for (int r = 0; r < 5; ++r)
#pragma unroll
            for (int j = 0; j < 4; ++j) acc[r][j] = 0.f;
#pragma unroll 7
        for (int k = kg; k < DM; k += 42) {
            const float4 w = *(const float4*)(wm + (size_t)k * (6 * DM) + cb * 48 + l4 * 4);
#pragma unroll
            for (int r = 0; r < 5; ++r) { const float s = sc[r * DM + k]; acc[r][0] += s * w.x; acc[r][1] += s * w.y; acc[r][2] += s * w.z; acc[r][3] += s * w.w; }
        }
#pragma unroll
        for (int r = 0; r < 5; ++r)
#pragma unroll
            for (int j = 0; j < 4; ++j) red[(kg * 5 + r) * 48 + l4 * 4 + j] = acc[r][j];
    }
    __syncthreads();
    if (tid < 240) {
        const int r = tid / 48, col = tid % 48; float s = 0.f;
        for (int g = 0; g < 42; ++g) s += red[(g * 5 + r) * 48 + col];
        float* MOD = (float*)(p.ws + OFF_MOD);
        MOD[r * (6 * DM) + cb * 48 + col] = s + bm[cb * 48 + col];
    }
    __syncthreads();
}

__device__ __forceinline__ void taps_block(const Params& p, unsigned char* lds, int tile) {
    float* zs = (float*)lds;
    float* h1 = zs + 32 * 33;
    float* h2 = h1 + 32 * 65;
    float* h3 = h2 + 32 * 65;
    float* w4s = (float*)(lds + 32768);
    const int tid = otid(), t0 = tile * 32;
    const float* w1 = p.in[17]; const float* b1 = p.in[18]; const float* f1 = p.in[19];
    const float* w2 = p.in[20]; const float* b2 = p.in[21]; const float* f2 = p.in[22];
    const float* w3 = p.in[23]; const float* b3 = p.in[24]; const float* f3 = p.in[25];
    const float* w4 = p.in[26]; const float* hb = p.in[27];
    float* ws1 = w4s; float* ws2 = w4s + 2112; float* ws3 = ws2 + 4096;
    for (int i = tid; i < 2112 / 4; i += NT) *(float4*)(ws1 + 4 * i) = *(const float4*)(w1 + 4 * i);
    for (int i = tid; i < 1024; i += NT) { *(float4*)(ws2 + 4 * i) = *(const float4*)(w2 + 4 * i); *(float4*)(ws3 + 4 * i) = *(const float4*)(w3 + 4 * i); }
    for (int i = tid; i < 32 * 33; i += NT) {
        const int r = i / 33, f = i % 33; const float t = (float)(t0 + r);
        float v;
        if (f == 0) v = t / 8191.0f;
        else { const int bi = (f - 1) & 15; const float fr = 1e-4f + (float)bi * ((15.0f - 1e-4f) / 15.0f); const float rev = t * fr * (1.0f / 8192.0f);
            v = (f <= 16) ? __builtin_amdgcn_cosf(__builtin_amdgcn_fractf(rev)) : -__builtin_amdgcn_sinf(__builtin_amdgcn_fractf(rev)); }
        zs[i] = v;
    }
    __syncthreads();
    const int row = tid & 31, ug = tid >> 5;
    {   float a[4] = {0.f, 0.f, 0.f, 0.f};
#pragma unroll 3
        for (int k = 0; k < 33; ++k) { const float z = zs[row * 33 + k]; const float4 w = *(const float4*)(ws1 + k * 64 + ug * 4); a[0] += z * w.x; a[1] += z * w.y; a[2] += z * w.z; a[3] += z * w.w; }
#pragma unroll
        for (int j = 0; j < 4; ++j) h1[row * 65 + ug * 4 + j] = fsin(f1[ug * 4 + j] * (a[j] + b1[ug * 4 + j]));
    }
    __syncthreads();
    {   float a[4] = {0.f, 0.f, 0.f, 0.f};
#pragma unroll 4
        for (int k = 0; k < 64; ++k) { const float z = h1[row * 65 + k]; const float4 w = *(const float4*)(ws2 + k * 64 + ug * 4); a[0] += z * w.x; a[1] += z * w.y; a[2] += z * w.z; a[3] += z * w.w; }
#pragma unroll
        for (int j = 0; j < 4; ++j) h2[row * 65 + ug * 4 + j] = fsin(f2[ug * 4 + j] * (a[j] + b2[ug * 4 + j]));
    }
    __syncthreads();
    {   float a[4] = {0.f, 0.f, 0.f, 0.f};
#pragma unroll 4
        for (int k = 0; k < 64; ++k) { const float z = h2[row * 65 + k]; const float4 w = *(const float4*)(ws3 + k * 64 + ug * 4); a[0] += z * w.x; a[1] += z * w.y; a[2] += z * w.z; a[3] += z * w.w; }
#pragma unroll
        for (int j = 0; j < 4; ++j) h3[row * 65 + ug * 4 + j] = fsin(f3[ug * 4 + j] * (a[j] + b3[ug * 4 + j]));
    }
    __syncthreads();
    bf16_t* Ah = (bf16_t*)(lds + 98304); bf16_t* Al = Ah + 32 * 72;
    {   float hv[4]; unsigned short hh[4], hl[4];
#pragma unroll
        for (int j = 0; j < 4; ++j) { hv[j] = h3[row * 65 + ug * 4 + j]; const unsigned u = pk2_c(hv[j], 0.f) & 0xffffu; hh[j] = (unsigned short)u; hl[j] = (unsigned short)(pk2_c(hv[j] - __uint_as_float(u << 16), 0.f) & 0xffffu); }
        uint2 wh, wl; wh.x = hh[0] | ((unsigned)hh[1] << 16); wh.y = hh[2] | ((unsigned)hh[3] << 16); wl.x = hl[0] | ((unsigned)hl[1] << 16); wl.y = hl[2] | ((unsigned)hl[3] << 16);
        *(uint2*)(Ah + row * 72 + ug * 4) = wh; *(uint2*)(Al + row * 72 + ug * 4) = wl; }
    float* TAPS = (float*)(p.ws + OFF_TAPS);
    const float mind = -3.0701134573253946f, maxd = -15.350567286626973f;
    const int lane = tid & 63, wid = __builtin_amdgcn_readfirstlane(tid >> 6), fr = lane & 15, fq = lane >> 4;
    for (int cc = 0; cc < 8; ++cc) {
        for (int i = tid; i < 64 * 64; i += NT) { const int k = i >> 6, c4 = (i & 63) * 4; *(float4*)(w4s + k * 256 + c4) = *(const float4*)(w4 + (size_t)k * 2048 + cc * 256 + c4); }
        __syncthreads();
#pragma unroll 1
        for (int nn = 0; nn < 2; ++nn) {
            const int nt = wid * 2 + nn;
            f32x4 acc[2]; acc[0] = (f32x4){0.f, 0.f, 0.f, 0.f}; acc[1] = (f32x4){0.f, 0.f, 0.f, 0.f};
#pragma unroll
            for (int ks = 0; ks < 2; ++ks) {
                bf16x8 bh, bl;
#pragma unroll
                for (int e = 0; e < 8; ++e) { const float x = w4s[(32 * ks + 8 * fq + e) * 256 + 16 * nt + fr]; const unsigned u = pk2_c(x, 0.f) & 0xffffu;
                    bh[e] = (short)u; bl[e] = (short)(pk2_c(x - __uint_as_float(u << 16), 0.f) & 0xffffu); }
#pragma unroll
                for (int mt = 0; mt < 2; ++mt) {
                    const bf16x8 ah = *(const bf16x8*)(Ah + (16 * mt + fr) * 72 + 32 * ks + 8 * fq), al = *(const bf16x8*)(Al + (16 * mt + fr) * 72 + 32 * ks + 8 * fq);
                    acc[mt] = __builtin_amdgcn_mfma_f32_16x16x32_bf16(ah, bh, acc[mt], 0, 0, 0);
                    acc[mt] = __builtin_amdgcn_mfma_f32_16x16x32_bf16(ah, bl, acc[mt], 0, 0, 0);
                    acc[mt] = __builtin_amdgcn_mfma_f32_16x16x32_bf16(al, bh, acc[mt], 0, 0, 0);
                }
            }
            const int c2 = cc * 256 + 16 * nt + fr, c = c2 & 1023;
            const float delta = fabsf(mind + (float)c * ((maxd - mind) / 1023.0f));
#pragma unroll
            for (int mt = 0; mt < 2; ++mt)
#pragma unroll
                for (int r = 0; r < 4; ++r) {
                    const int t = t0 + 16 * mt + 4 * fq + r; const float t01 = (float)t / 8191.0f;
                    float v = acc[mt][r] * __expf(-t01 * delta);
                    if (c2 < 1024) { if (t == 0) v += hb[c]; TAPS[(size_t)c * 16384 + t] = v; }
                    else { if (t == 0) TAPS[(size_t)c * 16384 + 8192] = 0.f; else TAPS[(size_t)c * 16384 + 16384 - t] = v; }
                }
        }
        __syncthreads();
    }
}

struct TDesc { const float* src; bf16_t* dst; int srcN, scol, K, kt, nt; };
__device__ __forceinline__ void transpose_decode(const Params& p, int idx, int tid, TDesc& d) {
    int mode, nK;
    if (idx < 928) { mode = 0; nK = 8; } else if (idx < 1184) { mode = 1; nK = 8; idx -= 928; } else if (idx < 2592) { mode = 2; nK = 8; idx -= 1184; } else { mode = 3; nK = 22; idx -= 2592; }
    d.kt = idx % nK; d.nt = idx / nK; d.K = (mode == 3) ? DFF : DM;
    d.dst = (bf16_t*)(p.ws + (mode == 0 ? OFF_WIN : mode == 1 ? OFF_WOUT : mode == 2 ? OFF_WGU : OFF_WDOWN));
    const int nc = (tid & 15) * 4, n = d.nt * 64 + nc;
    if (mode == 0) { d.src = p.in[10]; d.srcN = 7200; d.scol = (n < 3072) ? n : (n < 7168) ? n + 32 : (n < 7200) ? n - 4096 : -1; }
    else if (mode == 1) { d.src = p.in[28]; d.srcN = DM; d.scol = n; }
    else if (mode == 2) { const int pn = n >> 8, w = n & 255; d.src = (w < 128) ? p.in[29] : p.in[30]; d.srcN = DFF; d.scol = pn * 128 + (w & 127); }
    else { d.src = p.in[31]; d.srcN = DM; d.scol = n; }
}
__device__ __forceinline__ void transpose_load(const TDesc& d, int tid, float4 (&v)[8]) {
    const int kr = tid >> 4;
#pragma unroll
    for (int it = 0; it < 8; ++it) { v[it] = make_float4(0.f, 0.f, 0.f, 0.f); if (d.scol >= 0) v[it] = *(const float4*)(d.src + (size_t)(d.kt * 256 + kr + it * 32) * d.srcN + d.scol); }
}
__device__ __forceinline__ void transpose_store(const TDesc& d, int tid, const float4 (&v)[8], float* tile  ) {
    const int kr = tid >> 4, nc = (tid & 15) * 4;
#pragma unroll
    for (int it = 0; it < 8; ++it) { float* tp = tile + (kr + it * 32) * 65 + nc; tp[0] = v[it].x; tp[1] = v[it].y; tp[2] = v[it].z; tp[3] = v[it].w; }
    __syncthreads();
    {   const int nn = tid >> 3, k8 = (tid & 7) * 8;
#pragma unroll
        for (int w = 0; w < 4; ++w) { float f[8];
#pragma unroll
            for (int j = 0; j < 8; ++j) f[j] = tile[(k8 + 64 * w + j) * 65 + nn];
            *(uint4*)(d.dst + (size_t)(d.nt * 64 + nn) * d.K + d.kt * 256 + k8 + 64 * w) = pack8(f); }
    }
    __syncthreads();
}

__device__ __forceinline__ void phase_prologue(const Params& p, unsigned char* lds) {
    const int G = gridDim.x, bx = blockIdx.x;
#ifndef P0_MASK
#define P0_MASK 7
#endif
    if (P0_MASK & 1) for (int cb = bx; cb < 256; cb += G) adaln_block(p, lds, cb);
    if (P0_MASK & 2) for (int t = bx; t < 256; t += G) taps_block(p, lds, t);
    if (P0_MASK & 4) {
        const int tid = otid(); float4 v[8], vn[8]; TDesc d, dn; int i = bx;
        if (i < 3296) { transpose_decode(p, i, tid, d); transpose_load(d, tid, v); }
        for (; i < 3296; i += G) {
            if (i + G < 3296) { transpose_decode(p, i + G, tid, dn); transpose_load(dn, tid, vn); }
            transpose_store(d, tid, v, (float*)lds);
            d = dn;
#pragma unroll
            for (int it = 0; it < 8; ++it) v[it] = vn[it];
        }
    }
}

__device__ __forceinline__ void phase_prenorm(const Params& p) {
    const int tid_ = otid(), lane = tid_ & 63, wv = __builtin_amdgcn_readfirstlane(tid_ >> 6);
    const float* MOD = (const float*)(p.ws + OFF_MOD); const float* g = p.in[6];
    bf16_t* H = (bf16_t*)(p.ws + OFF_H);
    const int stride = gridDim.x * 8;
    float4 v[8], vn[8];
#define PRE_SRC(row_) ((row_) < MLAT ? p.in[0] + (size_t)(row_) * DM : p.in[2] + (size_t)((row_) - MLAT) * DM)
    int row = blockIdx.x * 8 + wv;
    if (row < MALL) { const float* src = PRE_SRC(row);
#pragma unroll
        for (int i = 0; i < 8; ++i) v[i] = *(const float4*)(src + 4 * (lane + 64 * i)); }
    for (; row < MALL; row += stride) {
        const int nxt = row + stride;
        if (nxt < MALL) { const float* src = PRE_SRC(nxt);
#pragma unroll
            for (int i = 0; i < 8; ++i) vn[i] = *(const float4*)(src + 4 * (lane + 64 * i)); }
        const int r = row < MLAT ? (row >> 13) : 4;
        const float* sh = MOD + r * (6 * DM); const float* sc = sh + DM;
        float ss = 0.f;
#pragma unroll
        for (int i = 0; i < 8; ++i) ss += v[i].x * v[i].x + v[i].y * v[i].y + v[i].z * v[i].z + v[i].w * v[i].w;
        ss = wave_sum(ss);
        const float rstd = rsqrtf(ss * (1.0f / DM) + EPSF);
#pragma unroll
        for (int i = 0; i < 8; ++i) { const int col = 4 * (lane + 64 * i);
            const float4 gg = *(const float4*)(g + col), s1 = *(const float4*)(sc + col), s0 = *(const float4*)(sh + col);
            uint2 w; w.x = pk2(v[i].x * rstd * gg.x * (1.f + s1.x) + s0.x, v[i].y * rstd * gg.y * (1.f + s1.y) + s0.y);
            w.y = pk2(v[i].z * rstd * gg.z * (1.f + s1.z) + s0.z, v[i].w * rstd * gg.w * (1.f + s1.w) + s0.w);
            *(uint2*)(H + (size_t)row * DM + col) = w; }
#pragma unroll
        for (int i = 0; i < 8; ++i) v[i] = vn[i];
    }
#undef PRE_SRC
}

__device__ __forceinline__ void phase_hy1(const Params& p, unsigned char* lds) {
    float* tile = (float*)lds;
    const int tid = otid();
    const bf16_t* PHY = (const bf16_t*)(p.ws + OFF_PHY); bf16_t* MIX = (bf16_t*)(p.ws + OFF_H); bf16_t* UHT = (bf16_t*)(p.ws + OFF_UHT);
    const float* cw = p.in[15]; const float* cb = p.in[16];
    const bool g16 = (gridDim.x & 15) == 0;
    const int c8 = (tid & 7) * 8, tr = tid >> 3;
    float wr[3][3][8], br[3][8]; int ct_loaded = -1; uint4 raw[3][3], rawn[3][3];
    for (int k = 0;; ++k) {
        int ct, tt;
        if (g16) { ct = blockIdx.x & 15; tt = (int)(blockIdx.x >> 4) + k * (int)(gridDim.x >> 4); if (tt >= 512) break; }
        else { const int tl = blockIdx.x + k * gridDim.x; if (tl >= 512 * 16) break; ct = tl & 15; tt = tl >> 4; }
        const int c0 = ct * 64, row0 = tt * 64;
        if (ct != ct_loaded) { ct_loaded = ct;
#pragma unroll
            for (int gI = 0; gI < 3; ++gI) { const int col = gI * 1024 + c0 + c8;
#pragma unroll
                for (int j = 0; j < 8; ++j) br[gI][j] = cb[col + j];
#pragma unroll
                for (int i = 0; i < 3; ++i)
#pragma unroll
                    for (int j = 0; j < 8; ++j) wr[gI][i][j] = cw[i * 3072 + col + j]; } }
        const int row = row0 + tr, tpos = row & (SL - 1);
        if (k == 0) {
#pragma unroll
            for (int gI = 0; gI < 3; ++gI)
#pragma unroll
                for (int i = 0; i < 3; ++i) { int tp = tpos + i - 1; tp = tp < 0 ? 0 : (tp >= SL ? SL - 1 : tp);
                    raw[gI][i] = *(const uint4*)(PHY + (size_t)(row - tpos + tp) * 3072 + gI * 1024 + c0 + c8); }
        }
        {
            int ctn, ttn; bool have;
            if (g16) { ctn = ct; ttn = tt + (int)(gridDim.x >> 4); have = ttn < 512; } else { const int tl = blockIdx.x + (k + 1) * gridDim.x; have = tl < 512 * 16; ctn = tl & 15; ttn = tl >> 4; }
            if (have) { const int rown = ttn * 64 + tr, tposn = rown & (SL - 1);
#pragma unroll
                for (int gI = 0; gI < 3; ++gI)
#pragma unroll
                    for (int i = 0; i < 3; ++i) { int tp = tposn + i - 1; tp = tp < 0 ? 0 : (tp >= SL ? SL - 1 : tp);
                        rawn[gI][i] = *(const uint4*)(PHY + (size_t)(rown - tposn + tp) * 3072 + gI * 1024 + ctn * 64 + c8); } }
        }
        float res[3][8];
#pragma unroll
        for (int gI = 0; gI < 3; ++gI) {
            float a[8];
#pragma unroll
            for (int j = 0; j < 8; ++j) a[j] = br[gI][j];
#pragma unroll
            for (int i = 0; i < 3; ++i) {
                const int tp = tpos + i - 1; const float msk = (tp >= 0 && tp < SL) ? 1.0f : 0.0f;
                float f[8]; unpack8(raw[gI][i], f);
#pragma unroll
                for (int j = 0; j < 8; ++j) a[j] += (wr[gI][i][j] * msk) * f[j];
            }
#pragma unroll
            for (int j = 0; j < 8; ++j) res[gI][j] = a[j];
        }
#pragma unroll
        for (int gI = 0; gI < 3; ++gI)
#pragma unroll
            for (int i = 0; i < 3; ++i) raw[gI][i] = rawn[gI][i];
        *(uint4*)(MIX + (size_t)row * DM + 1024 + c0 + c8) = pack8(res[0]);
#pragma unroll
        for (int j = 0; j < 8; ++j) tile[(c8 + j) * 65 + tr] = res[1][j] * res[2][j];
        __syncthreads();
        {   const int c = tid >> 3, t8 = (tid & 7) * 8; const int b = row0 >> 13, tb = (row0 & (SL - 1)) + t8;
            bf16_t* dp = UHT + ((size_t)(b * 1024 + c0 + c)) * SL + tb; float f[8];
#pragma unroll
            for (int j = 0; j < 8; ++j) f[j] = tile[c * 65 + t8 + j];
            *(uint4*)dp = pack8(f); }
        __syncthreads();
    }
}

__device__ __forceinline__ void phase_hy3(const Params& p, unsigned char* lds) {
    float* tile = (float*)lds;
    const int tid = otid();
    bf16_t* MIX = (bf16_t*)(p.ws + OFF_H); const bf16_t* UHT = (const bf16_t*)(p.ws + OFF_UHT);
    const int c = tid >> 3, t8 = (tid & 7) * 8, tr = tid >> 3, c8 = (tid & 7) * 8;
    uint4 uy, um, ny, nm;
#define HY3_LOAD(tl_, y_, m_) do { const int ct_ = (tl_) & 15, tt_ = (tl_) >> 4, c0_ = ct_ * 64, row0_ = tt_ * 64; const int b_ = row0_ >> 13, tb_ = (row0_ & (SL - 1)) + t8; \
        y_ = *(const uint4*)(UHT + ((size_t)(b_ * 1024 + c0_ + c)) * SL + tb_); m_ = *(const uint4*)(MIX + (size_t)(row0_ + tr) * DM + 1024 + c0_ + c8); } while (0)
    int tl = blockIdx.x;
    if (tl < 512 * 16) HY3_LOAD(tl, uy, um);
    for (; tl < 512 * 16; tl += gridDim.x) {
        const int ct = tl & 15, tt = tl >> 4, c0 = ct * 64, row0 = tt * 64;
        if (tl + (int)gridDim.x < 512 * 16) HY3_LOAD(tl + (int)gridDim.x, ny, nm);
        {   float f[8]; unpack8(uy, f); float* tp = tile + c * 65 + t8;
#pragma unroll
            for (int j = 0; j < 8; ++j) tp[j] = f[j]; }
        __syncthreads();
        {   bf16_t* mp = MIX + (size_t)(row0 + tr) * DM + 1024 + c0 + c8;
            float f[8]; unpack8(um, f);
#pragma unroll
            for (int j = 0; j < 8; ++j) f[j] *= tile[(c8 + j) * 65 + tr];
            *(uint4*)mp = pack8(f); }
        __syncthreads();
        uy = ny; um = nm;
    }
#undef HY3_LOAD
}


__device__ __forceinline__ float2 cmul(float2 a, float2 b) { return make_float2(a.x * b.x - a.y * b.y, a.x * b.y + a.y * b.x); }
__device__ __forceinline__ int pidx(int i) { return i + ((i >> 6) << 2); }
template <bool INV> __device__ __forceinline__ float2 mulw16(float2 d, int m) {
    const float C1 = 0.9238795325112867f, S1 = 0.3826834323650898f, C2 = 0.7071067811865476f;
    float c, s;
    switch (m & 7) {
        case 0: return d;
        case 1: c = C1; s = S1; break;
        case 2: c = C2; s = C2; break;
        case 3: c = S1; s = C1; break;
        case 4: return INV ? make_float2(-d.y, d.x) : make_float2(d.y, -d.x);
        case 5: c = -S1; s = C1; break;
        case 6: c = -C2; s = C2; break;
        default: c = -C1; s = S1; break;
    }
    if (!INV) s = -s;
    return make_float2(d.x * c - d.y * s, d.x * s + d.y * c);
}
template <int R> __device__ __forceinline__ constexpr int brev(int q) { int r = 0; for (int b = 1, o = R >> 1; b < R; b <<= 1, o >>= 1) if (q & b) r |= o; return r; }
template <int R, int LOG, int S0 = 0> __device__ __forceinline__ void dft_fwd(float2 (&v)[R]) {
#pragma unroll
    for (int s = S0; s < LOG; ++s) {
        const int h = (R / 2) >> s;
#pragma unroll
        for (int j = 0; j < R; ++j) {
            if (j & h) continue;
            const int m = (j & (h - 1)) * (R / (2 * h)) * (16 / R);
            const float2 a = v[j], b = v[j + h];
            v[j] = make_float2(a.x + b.x, a.y + b.y);
            v[j + h] = mulw16<false>(make_float2(a.x - b.x, a.y - b.y), m);
        }
    }
}
template <int R, int LOG, int S0 = 0> __device__ __forceinline__ void dft_inv(float2 (&v)[R]) {
#pragma unroll
    for (int s = LOG - 1; s >= S0; --s) {
        const int h = (R / 2) >> s;
#pragma unroll
        for (int j = 0; j < R; ++j) {
            if (j & h) continue;
            const int m = (j & (h - 1)) * (R / (2 * h)) * (16 / R);
            const float2 a = v[j], b = mulw16<true>(v[j + h], m);
            v[j] = make_float2(a.x + b.x, a.y + b.y);
            v[j + h] = make_float2(a.x - b.x, a.y - b.y);
        }
    }
}
__device__ __forceinline__ void tw_powers(float2 w1, float2 (&w)[16]) {
    w[1] = w1; w[2] = cmul(w1, w1); w[3] = cmul(w[2], w1); w[4] = cmul(w[2], w[2]); w[5] = cmul(w[4], w1); w[6] = cmul(w[4], w[2]); w[7] = cmul(w[4], w[3]);
    w[8] = cmul(w[4], w[4]);
#pragma unroll
    for (int k = 1; k < 8; ++k) w[8 + k] = cmul(w[8], w[k]);
}
template <int n, bool INV, bool HALF = false, bool TW = false> __device__ __forceinline__ void fft_pass16(float2* X, int tid, const float2 (&wpre)[16]) {
    constexpr int st = n / 16, PST = (st >= 64) ? st + 4 * (st / 64) : st;
#pragma unroll 1
    for (int g = tid; g < 1024; g += NT) {
        int lo = g & (st - 1); asm volatile("" : "+v"(lo));
        const int blk = g / st, base = blk * n + lo;
        float2* Xp = X + pidx(base);
        float2 w[16];
        if (TW) {
#pragma unroll
            for (int k = 1; k < 16; ++k) w[k] = make_float2(wpre[k].x, INV ? -wpre[k].y : wpre[k].y);
        } else {   const float rev = (float)lo * (1.0f / n); const float c = __builtin_amdgcn_cosf(rev), s = __builtin_amdgcn_sinf(rev);
            tw_powers(make_float2(c, INV ? s : -s), w); }
        float2 v[16];
        if (!INV) {
            if (HALF) {
#pragma unroll
                for (int j = 0; j < 8; ++j) { v[j] = Xp[j * PST]; v[j + 8] = mulw16<false>(v[j], j); }
                dft_fwd<16, 4, 1>(v);
            } else {
#pragma unroll
                for (int j = 0; j < 16; ++j) v[j] = Xp[j * PST];
                dft_fwd<16, 4>(v);
            }
#pragma unroll
            for (int q = 1; q < 16; ++q) v[q] = cmul(v[q], w[brev<16>(q)]);
#pragma unroll
            for (int q = 0; q < 16; ++q) Xp[brev<16>(q) * PST] = v[q];
        } else {
#pragma unroll
            for (int q = 0; q < 16; ++q) { const int k = brev<16>(q); float2 t = Xp[k * PST]; if (k) t = cmul(t, w[k]); v[q] = t; }
            if (HALF) {
                dft_inv<16, 4, 1>(v);
#pragma unroll
                for (int j = 0; j < 8; ++j) { const float2 b = mulw16<true>(v[j + 8], j); Xp[j * PST] = make_float2(v[j].x + b.x, v[j].y + b.y); }
            } else {
                dft_inv<16, 4>(v);
#pragma unroll
                for (int j = 0; j < 16; ++j) Xp[j * PST] = v[j];
            }
        }
    }
}
__device__ __forceinline__ void phase_hy2(const Params& p, unsigned char* lds) {
    float2* X = (float2*)lds;
    const int tid = otid();
    const float* TAPS = (const float*)(p.ws + OFF_TAPS); bf16_t* UHT = (bf16_t*)(p.ws + OFF_UHT);
    float2 w64[16];
    {   const float r64 = (float)(tid & 3) * (1.0f / 64.0f);
        tw_powers(make_float2(__builtin_amdgcn_cosf(r64), -__builtin_amdgcn_sinf(r64)), w64); w64[0] = make_float2(1.f, 0.f); }
    for (int c = blockIdx.x; c < 1024; c += gridDim.x) {
        float4* KS = (float4*)(p.ws + OFF_KSPEC) + (size_t)blockIdx.x * 8192;
#pragma unroll
        for (int i = 0; i < 8; ++i) { const int t = 4 * (tid + NT * i); const float4 v = *(const float4*)(TAPS + (size_t)c * 16384 + t);
            float4* xp = (float4*)(X + pidx(t)); xp[0] = make_float4(v.x, 0.f, v.y, 0.f); xp[1] = make_float4(v.z, 0.f, v.w, 0.f); }
        __syncthreads();
        fft_pass16<16384, false, false, false>(X, tid, w64); __syncthreads();
        fft_pass16<1024, false, false, false>(X, tid, w64); __syncthreads();
        fft_pass16<64, false, false, true>(X, tid, w64); __syncthreads();
#pragma unroll 2
        for (int i = 0; i < 8; ++i) { const float4* xp = (const float4*)(X + pidx(4 * (tid + NT * i))); const float4 a = xp[0], b = xp[1];
            float2 v[4] = {make_float2(a.x, a.y), make_float2(a.z, a.w), make_float2(b.x, b.y), make_float2(b.z, b.w)};
            dft_fwd<4, 2>(v);
            const float sc = 1.0f / 16384.0f;
            KS[2 * (tid + NT * i)] = make_float4(v[0].x * sc, v[0].y * sc, v[1].x * sc, v[1].y * sc); KS[2 * (tid + NT * i) + 1] = make_float4(v[2].x * sc, v[2].y * sc, v[3].x * sc, v[3].y * sc); }
        __syncthreads();
        for (int pr = 0; pr < 2; ++pr) {
            bf16_t* u1 = UHT + ((size_t)((2 * pr) * 1024 + c)) * SL; bf16_t* u2 = UHT + ((size_t)((2 * pr + 1) * 1024 + c)) * SL;
#pragma unroll
            for (int i = 0; i < 4; ++i) { const int t = 4 * (tid + NT * i); const uint2 ua = *(const uint2*)(u1 + t), ub = *(const uint2*)(u2 + t);
                const float4 a = make_float4(bf_lo(ua.x), bf_hi(ua.x), bf_lo(ua.y), bf_hi(ua.y)), b = make_float4(bf_lo(ub.x), bf_hi(ub.x), bf_lo(ub.y), bf_hi(ub.y));
                float4* xp = (float4*)(X + pidx(t)); xp[0] = make_float4(a.x, b.x, a.y, b.y); xp[1] = make_float4(a.z, b.z, a.w, b.w); }
            __syncthreads();
            fft_pass16<16384, false, true, false>(X, tid, w64); __syncthreads();
            fft_pass16<1024, false, false, false>(X, tid, w64); __syncthreads();
            fft_pass16<64, false, false, true>(X, tid, w64); __syncthreads();
#pragma unroll 2
            for (int i = 0; i < 8; ++i) { float4* xp = (float4*)(X + pidx(4 * (tid + NT * i))); const float4 a = xp[0], b = xp[1];
                float2 v[4] = {make_float2(a.x, a.y), make_float2(a.z, a.w), make_float2(b.x, b.y), make_float2(b.z, b.w)};
                dft_fwd<4, 2>(v);
                const float4 k0 = KS[2 * (tid + NT * i)], k1 = KS[2 * (tid + NT * i) + 1];
                v[0] = cmul(v[0], make_float2(k0.x, k0.y)); v[1] = cmul(v[1], make_float2(k0.z, k0.w)); v[2] = cmul(v[2], make_float2(k1.x, k1.y)); v[3] = cmul(v[3], make_float2(k1.z, k1.w));
                dft_inv<4, 2>(v);
                xp[0] = make_float4(v[0].x, v[0].y, v[1].x, v[1].y); xp[1] = make_float4(v[2].x, v[2].y, v[3].x, v[3].y); }
            __syncthreads();
            fft_pass16<64, true, false, true>(X, tid, w64); __syncthreads();
            fft_pass16<1024, true, false, false>(X, tid, w64); __syncthreads();
            fft_pass16<16384, true, true, false>(X, tid, w64); __syncthreads();
#pragma unroll
            for (int i = 0; i < 4; ++i) { const int t = 4 * (tid + NT * i); const float4* xp = (const float4*)(X + pidx(t)); const float4 a = xp[0], b = xp[1];
                uint2 w1, w2; w1.x = pk2(a.x, a.z); w1.y = pk2(b.x, b.z); w2.x = pk2(a.y, a.w); w2.y = pk2(b.y, b.w);
                *(uint2*)(u1 + t) = w1; *(uint2*)(u2 + t) = w2; }
            __syncthreads();
        }
    }
}


__device__ __forceinline__ void item_decode(int item, int& b, int& n, int& h, int& row0, int& seq0, int& seqlen) {
    h = item & 7; const int cidx = item >> 3; b = cidx / NCHUNK; n = cidx % NCHUNK;
    if (n < 4) { seq0 = MLAT + b * CL; seqlen = CL; row0 = seq0 + n * CHK; } else { seq0 = b * SL; seqlen = SL; row0 = seq0 + (n - 4) * CHK; }
}
constexpr int G2X_A10 = 0, G2X_T11 = 5120, G2X_T00T = 10240, G2X_XT = 20480, G2X_BYTES = 30720;
template <int D> __device__ __forceinline__ void g2_tinv_diag(const float* As, int lane, const float* rsu, const float* rsw, bf16_t* TM, unsigned char* xl) {
    const int blk = lane >> 5, cc = lane & 31;
    int abase = D * 64 * 68 + blk * (32 * 68 + 32); asm volatile("" : "+v"(abase));
    const float* Ad = As + abase;
    {   const float* ap = As + D * 64 * 68 + cc * 68 + 32 + 16 * blk; bf16_t* a10 = (bf16_t*)(xl + G2X_A10) + D * 32 * 40;
#pragma unroll
        for (int q = 0; q < 4; ++q) { const float4 v = *(const float4*)(ap + 4 * q);
            a10[(16 * blk + 4 * q + 0) * 40 + cc] = f2bf(v.x); a10[(16 * blk + 4 * q + 1) * 40 + cc] = f2bf(v.y); a10[(16 * blk + 4 * q + 2) * 40 + cc] = f2bf(v.z); a10[(16 * blk + 4 * q + 3) * 40 + cc] = f2bf(v.w); } }
    float x[32];
#pragma unroll
    for (int i = 0; i < 32; ++i) x[i] = (i == cc) ? 1.0f : 0.0f;
#pragma clang loop unroll(full)
    for (int j = 0; j < 31; ++j) {
        const float xj = x[j];
        int zj = 0; asm volatile("" : "+v"(zj) : "v"(x[j > 0 ? j - 1 : 0])); zj &= ~3;
#pragma clang loop unroll(full)
        for (int i4 = ((j + 1) & ~3); i4 < 32; i4 += 4) {
            const float4 a = *(const float4*)(Ad + zj + j * 68 + i4);
            if (i4 > j) x[i4] -= a.x * xj;
            if (i4 + 1 > j) x[i4 + 1] -= a.y * xj;
            if (i4 + 2 > j) x[i4 + 2] -= a.z * xj;
            x[i4 + 3] -= a.w * xj;
        }
    }
    const int sj = 32 * blk + cc, jo = D ? 63 - sj : sj;
    const float su = rsu[D * 64 + jo], sw = rsw[D * 64 + jo];
    bf16_t* tu = TM + (D * 2 + 0) * 64 * 72 + jo; bf16_t* tw = TM + (D * 2 + 1) * 64 * 72 + jo;
#pragma unroll
    for (int ii = 0; ii < 32; ++ii) { const int si = 32 * blk + ii, io = D ? 63 - si : si; tu[io * 72] = f2bf(x[ii] * su); tw[io * 72] = f2bf(x[ii] * sw); }
    if (blk == 1) {
        bf16_t* t11 = (bf16_t*)(xl + G2X_T11) + D * 32 * 40 + cc;
#pragma unroll
        for (int ii = 0; ii < 32; ++ii) { const int io = D ? 63 - ii : ii; tu[io * 72] = 0; tw[io * 72] = 0; t11[ii * 40] = f2bf(x[ii]); }
    } else {
        bf16_t* t0u = (bf16_t*)(xl + G2X_T00T) + (D * 2 + 0) * 32 * 40 + cc * 40; bf16_t* t0w = (bf16_t*)(xl + G2X_T00T) + (D * 2 + 1) * 32 * 40 + cc * 40;
#pragma unroll
        for (int q = 0; q < 4; ++q) { uint4 wu, ww;
            wu.x = pk2(x[8 * q] * su, x[8 * q + 1] * su); wu.y = pk2(x[8 * q + 2] * su, x[8 * q + 3] * su); wu.z = pk2(x[8 * q + 4] * su, x[8 * q + 5] * su); wu.w = pk2(x[8 * q + 6] * su, x[8 * q + 7] * su);
            ww.x = pk2(x[8 * q] * sw, x[8 * q + 1] * sw); ww.y = pk2(x[8 * q + 2] * sw, x[8 * q + 3] * sw); ww.z = pk2(x[8 * q + 4] * sw, x[8 * q + 5] * sw); ww.w = pk2(x[8 * q + 6] * sw, x[8 * q + 7] * sw);
            *(uint4*)(t0u + 8 * q) = wu; *(uint4*)(t0w + 8 * q) = ww; }
    }
}
constexpr int G2_KB = 0, G2_QB = 17408, G2_TM = 0  , G2_KT = 36864, G2_VT = 55296, G2_AS = 73728, G2_GT = 108544, G2_XL = 110592;
static_assert(G2_GT + 8 * 64 * 4 <= G2_XL && G2_XL + G2X_BYTES <= LDS_BYTES, "G2 LDS");
__device__ __forceinline__ void phase_gdn_prep(const Params& p, unsigned char* lds) {
    bf16_t* kb = (bf16_t*)(lds + G2_KB); bf16_t* qb = (bf16_t*)(lds + G2_QB); bf16_t* kT = (bf16_t*)(lds + G2_KT); bf16_t* vT = (bf16_t*)(lds + G2_VT);
    float* As = (float*)(lds + G2_AS); bf16_t* TM = (bf16_t*)(lds + G2_TM); float* gt = (float*)(lds + G2_GT); unsigned char* xl = lds + G2_XL;
    float* beta_s = gt; float* gc_s = gt + 128; float* rsu = gt + 256; float* rsw = gt + 384;
    const bf16_t* PG = (const bf16_t*)(p.ws + OFF_PGDN); const float* GATES = (const float*)(p.ws + OFF_GATES);
    const float* cw = p.in[11]; const float* a_log = p.in[12]; const float* dt_bias = p.in[13];
    bf16_t* KT = (bf16_t*)(p.ws + OFF_KT); bf16_t* QO = (bf16_t*)(p.ws + OFF_Q); bf16_t* UW = (bf16_t*)(p.ws + OFF_UW); bf16_t* ATT = (bf16_t*)(p.ws + OFF_ATT);
    float* GSC = (float*)(p.ws + OFF_GSC);
    for (int item = blockIdx.x; item < NITEM; item += gridDim.x) {
        int tid = otid();
        const int lane = tid & 63, wid = __builtin_amdgcn_readfirstlane(tid >> 6), fr = lane & 15, fq = lane >> 4;
        int b, n, h, row0, seq0, seqlen; item_decode(item, b, n, h, row0, seq0, seqlen);
        const bool ctx = n < 4;
        float graw_b = 0.f, graw_a = 0.f;
        if (tid < 128) { const int d = tid >> 6, i = d ? 63 - lane : lane; const float* gp = GATES + (size_t)(row0 + i) * 32; graw_b = gp[d * 8 + h]; graw_a = gp[16 + d * 8 + h]; }
        {   const int r = tid >> 3, c16 = (tid & 7) * 16;
            uint4 raw[3][5][2];
#pragma unroll
            for (int mt = 0; mt < 3; ++mt)
#pragma unroll
                for (int i = 0; i < 5; ++i) { int rr = row0 + r + i - 2; rr = rr < seq0 ? seq0 : (rr >= seq0 + seqlen ? seq0 + seqlen - 1 : rr);
                    const bf16_t* sp = PG + (size_t)rr * 3072 + mt * 1024 + h * 128 + c16; raw[mt][i][0] = *(const uint4*)sp; raw[mt][i][1] = *(const uint4*)(sp + 8); }
#pragma unroll
            for (int mt = 0; mt < 3; ++mt) {
                if (mt == 2 && ctx) break;
                const int col = mt * 1024 + h * 128 + c16;
                float a[16];
#pragma unroll
                for (int j = 0; j < 16; ++j) a[j] = 0.f;
#pragma unroll
                for (int i = 0; i < 5; ++i) {
                    const int rr = row0 + r + i - 2;
                    const float msk = (rr >= seq0 && rr < seq0 + seqlen) ? 1.0f : 0.0f;
                    float f0[8], f1[8]; unpack8(raw[mt][i][0], f0); unpack8(raw[mt][i][1], f1);
                    const float* wp = cw + i * 3072 + col;
#pragma unroll
                    for (int j = 0; j < 8; ++j) { a[j] += (wp[j] * msk) * f0[j]; a[8 + j] += (wp[8 + j] * msk) * f1[j]; }
                }
                float ss = 0.f;
#pragma unroll
                for (int j = 0; j < 16; ++j) { a[j] = silu(a[j]); ss += a[j] * a[j]; }
                if (mt != 1) {
                    ss += __shfl_xor(ss, 1); ss += __shfl_xor(ss, 2); ss += __shfl_xor(ss, 4);
                    const float sc = rsqrtf(ss + EPSF) * (mt == 2 ? 0.08838834764831845f : 1.0f);
#pragma unroll
                    for (int j = 0; j < 16; ++j) a[j] *= sc;
                }
                uint4 w0, w1; w0.x = pk2(a[0], a[1]); w0.y = pk2(a[2], a[3]); w0.z = pk2(a[4], a[5]); w0.w = pk2(a[6], a[7]);
                w1.x = pk2(a[8], a[9]); w1.y = pk2(a[10], a[11]); w1.z = pk2(a[12], a[13]); w1.w = pk2(a[14], a[15]);
                if (mt == 0) {
                    *(uint4*)(kb + r * 136 + c16) = w0; *(uint4*)(kb + r * 136 + c16 + 8) = w1;
#pragma unroll
                    for (int j = 0; j < 16; ++j) kT[(c16 + j) * 72 + r] = f2bf(a[j]);
                } else if (mt == 1) {
#pragma unroll
                    for (int j = 0; j < 16; ++j) vT[(c16 + j) * 72 + r] = f2bf(a[j]);
                } else {
                    *(uint4*)(qb + r * 136 + c16) = w0; *(uint4*)(qb + r * 136 + c16 + 8) = w1;
                    bf16_t* qp = QO + (size_t)item * 8192 + r * 128 + c16; *(uint4*)qp = w0; *(uint4*)(qp + 8) = w1;
                }
            }
        }
        if (tid < 128) {
            const int d = tid >> 6, i = d ? 63 - lane : lane;
            const float beta = 1.0f / (1.0f + __expf(-graw_b));
            const float x = graw_a + dt_bias[d * 8 + h];
            const float sp = x > 20.f ? x : __logf(1.0f + __expf(x));
            float g = -__expf(a_log[d * 8 + h]) * sp;
#pragma unroll
            for (int o = 1; o < 64; o <<= 1) { const float t = __shfl_up(g, o); if (lane >= o) g += t; }
            const float glast = __shfl(g, 63);
            const float eg = __expf(g), ee = __expf(glast - g);
            beta_s[d * 64 + i] = beta; gc_s[d * 64 + i] = g; rsu[d * 64 + i] = beta; rsw[d * 64 + i] = beta * eg;
            float* gs = GSC + ((size_t)item * 2 + d) * 192; gs[i] = eg; gs[64 + i] = ee; if (lane == 63) gs[128] = __expf(glast);
        }
        __syncthreads();
#pragma unroll
        for (int i = 0; i < 2; ++i) { const int q16 = tid + NT * i; *(uint4*)(KT + (size_t)item * 8192 + (size_t)q16 * 8) = *(const uint4*)(kT + (q16 >> 3) * 72 + (q16 & 7) * 8); }
        {   const int mt = wid >> 1, ntp = wid & 1;
            f32x4 ckk[2], cqk[2];
#pragma unroll
            for (int e = 0; e < 2; ++e) { ckk[e] = (f32x4){0.f, 0.f, 0.f, 0.f}; cqk[e] = (f32x4){0.f, 0.f, 0.f, 0.f}; }
#pragma unroll
            for (int ks = 0; ks < 4; ++ks) {
                const bf16x8 ak = *(const bf16x8*)(kb + (16 * mt + fr) * 136 + 32 * ks + 8 * fq);
                bf16x8 aq = ak; if (!ctx) aq = *(const bf16x8*)(qb + (16 * mt + fr) * 136 + 32 * ks + 8 * fq);
#pragma unroll
                for (int e = 0; e < 2; ++e) { const bf16x8 bk = *(const bf16x8*)(kb + (16 * (2 * ntp + e) + fr) * 136 + 32 * ks + 8 * fq);
                    ckk[e] = __builtin_amdgcn_mfma_f32_16x16x32_bf16(ak, bk, ckk[e], 0, 0, 0);
                    cqk[e] = __builtin_amdgcn_mfma_f32_16x16x32_bf16(aq, bk, cqk[e], 0, 0, 0); }
            }
#pragma unroll
            for (int e = 0; e < 2; ++e)
#pragma unroll
                for (int r = 0; r < 4; ++r) {
                    const int i = 16 * mt + 4 * fq + r, j = 16 * (2 * ntp + e) + fr;
#pragma unroll
                    for (int d = 0; d < 2; ++d) {
                        const bool before = d ? (j > i) : (j < i); const bool incl = before || (i == j);
                        const float df = incl ? gc_s[d * 64 + i] - gc_s[d * 64 + j] : 0.f; const float ex = __expf(df);
                        const float av = before ? beta_s[d * 64 + i] * ckk[e][r] * ex : 0.f;
                        const int ii = d ? 63 - i : i, jj = d ? 63 - j : j;
                        As[(d * 64 + jj) * 68 + ii] = av;
                        if (!ctx) ATT[((size_t)item * 2 + d) * 4096 + i * 64 + j] = f2bf(incl ? cqk[e][r] * ex : 0.f);
                    }
                }
        }
        __syncthreads();
        if (wid == 0) g2_tinv_diag<0>(As, lane, rsu, rsw, TM, xl);
        else if (wid == 1) g2_tinv_diag<1>(As, lane, rsu, rsw, TM, xl);
        __syncthreads();
        {   const int dd = wid >> 2, vv = (wid >> 1) & 1, mh = wid & 1;
            const bf16_t* a10 = (const bf16_t*)(xl + G2X_A10) + dd * 32 * 40; const bf16_t* t11 = (const bf16_t*)(xl + G2X_T11) + dd * 32 * 40;
            const bf16_t* t0t = (const bf16_t*)(xl + G2X_T00T) + (dd * 2 + vv) * 32 * 40; bf16_t* xt = (bf16_t*)(xl + G2X_XT) + (dd * 2 + vv) * 32 * 40;
            const bf16x8 aA = *(const bf16x8*)(a10 + (16 * mh + fr) * 40 + 8 * fq);
#pragma unroll
            for (int nt = 0; nt < 2; ++nt) { const bf16x8 bT = *(const bf16x8*)(t0t + (16 * nt + fr) * 40 + 8 * fq);
                f32x4 acc = (f32x4){0.f, 0.f, 0.f, 0.f}; acc = __builtin_amdgcn_mfma_f32_16x16x32_bf16(aA, bT, acc, 0, 0, 0);
                uint2 w; w.x = pk2_c(acc[0], acc[1]); w.y = pk2_c(acc[2], acc[3]);
                *(uint2*)(xt + (16 * nt + fr) * 40 + 16 * mh + 4 * fq) = w; }
            __syncthreads();
            const bf16x8 aT = *(const bf16x8*)(t11 + (16 * mh + fr) * 40 + 8 * fq);
            bf16_t* tm = TM + (dd * 2 + vv) * 64 * 72;
#pragma unroll
            for (int nt = 0; nt < 2; ++nt) { const bf16x8 bX = *(const bf16x8*)(xt + (16 * nt + fr) * 40 + 8 * fq);
                f32x4 acc = (f32x4){0.f, 0.f, 0.f, 0.f}; acc = __builtin_amdgcn_mfma_f32_16x16x32_bf16(aT, bX, acc, 0, 0, 0);
                const int sj = 16 * nt + fr, jo = dd ? 63 - sj : sj;
#pragma unroll
                for (int r = 0; r < 4; ++r) { const int si = 32 + 16 * mh + 4 * fq + r, io = dd ? 63 - si : si; tm[io * 72 + jo] = (bf16_t)(pk2_c(-acc[r], 0.f) & 0xffffu); } }
        }
        __syncthreads();
        {   const int mi = wid >> 1, half = wid & 1, uw = mi & 1;
            const bf16_t* Tm = TM + mi * 64 * 72; const bf16_t* Bm = uw ? kT : vT;
            bf16_t* dst = UW + ((size_t)item * 4 + mi) * 8192;
#pragma unroll
            for (int mm = 0; mm < 2; ++mm) {
                const int mt = 2 * half + mm;
                const bf16x8 a0 = *(const bf16x8*)(Tm + (16 * mt + fr) * 72 + 8 * fq), a1 = *(const bf16x8*)(Tm + (16 * mt + fr) * 72 + 32 + 8 * fq);
#pragma unroll
                for (int nt = 0; nt < 8; ++nt) {
                    const bf16x8 b0 = *(const bf16x8*)(Bm + (16 * nt + fr) * 72 + 8 * fq), b1 = *(const bf16x8*)(Bm + (16 * nt + fr) * 72 + 32 + 8 * fq);
                    f32x4 acc = (f32x4){0.f, 0.f, 0.f, 0.f};
                    acc = __builtin_amdgcn_mfma_f32_16x16x32_bf16(b0, a0, acc, 0, 0, 0);
                    acc = __builtin_amdgcn_mfma_f32_16x16x32_bf16(b1, a1, acc, 0, 0, 0);
                    uint2 w; w.x = pk2_c(acc[0], acc[1]); w.y = pk2_c(acc[2], acc[3]);
                    *(uint2*)(dst + (16 * mt + fr) * 128 + 16 * nt + 4 * fq) = w;
                }
            }
        }
        __syncthreads();
    }
}

constexpr int SC_BUF = 68224, SC_W = 0, SC_KT = 17408, SC_Q = 35840, SC_AT = 53248, SC_U = 62464  , SC_S = 67584  ,
              SC_ST = 2 * SC_BUF, SC_VT = SC_ST + 8704, SC_VE = SC_VT + 4608;
static_assert(SC_S + 132 * 4 <= SC_BUF && SC_VE + 4608 <= LDS_BYTES - 16, "scan LDS");
struct ScanLd { uint4 w[4], k[4], q[4], a[2], u; float sc; };
struct ScanCtx { const bf16_t* KT; const bf16_t* QO; const bf16_t* UW; const bf16_t* ATT; const float* GSC; int lt, fr, fq, wid, sl, d, h, b; };
__device__ __forceinline__ void scan_item(const ScanCtx& c, int s, int& item, bool& ctx, int& row0) {
    const int n = c.d ? (s < 4 ? 3 - s : 135 - s) : s; item = ((c.b * NCHUNK + n) << 3) + c.h; ctx = n < 4;
    row0 = ctx ? MLAT + c.b * CL + n * CHK : c.b * SL + (n - 4) * CHK;
}
__device__ __forceinline__ void scan_load(const ScanCtx& c, ScanLd& L, int s) {
    int it, r0; bool cx; scan_item(c, s, it, cx, r0); (void)cx; (void)r0;
    const bf16_t* wp = c.UW + (((size_t)it * 2 + c.d) * 2 + 1) * 8192; const bf16_t* up = c.UW + (((size_t)it * 2 + c.d) * 2) * 8192;
    const bf16_t* kp = c.KT + (size_t)it * 8192; const bf16_t* qp = c.QO + (size_t)it * 8192; const bf16_t* ap = c.ATT + ((size_t)it * 2 + c.d) * 4096;
    const float* gs = c.GSC + ((size_t)it * 2 + c.d) * 192;
    const unsigned o16 = (unsigned)c.lt * 16u;
#pragma unroll
    for (int i = 0; i < 4; ++i) { const unsigned q = o16 + 4096u * i; L.w[i] = *(const uint4*)((const char*)wp + q); L.k[i] = *(const uint4*)((const char*)kp + q); L.q[i] = *(const uint4*)((const char*)qp + q); }
#pragma unroll
    for (int i = 0; i < 2; ++i) L.a[i] = *(const uint4*)((const char*)ap + o16 + 4096u * i);
    L.u = *(const uint4*)((const char*)up + (unsigned)((c.lt >> 2) * 256 + 64 * c.sl + (c.lt & 3) * 16));
    L.sc = gs[c.lt < 129 ? c.lt : 128];
}
__device__ __forceinline__ void scan_store(const ScanCtx& c, const ScanLd& L, unsigned char* bp) {
#pragma unroll
    for (int i = 0; i < 4; ++i) { const int q = c.lt + 256 * i;
        *(uint4*)(bp + SC_W + (q >> 4) * 272 + (q & 15) * 16) = L.w[i];
        *(uint4*)(bp + SC_KT + (q >> 3) * 144 + (q & 7) * 16) = L.k[i];
        *(uint4*)(bp + SC_Q + (q >> 4) * 272 + (q & 15) * 16) = L.q[i]; }
#pragma unroll
    for (int i = 0; i < 2; ++i) { const int q = c.lt + 256 * i; *(uint4*)(bp + SC_AT + (q >> 3) * 144 + (q & 7) * 16) = L.a[i]; }
    *(uint4*)(bp + SC_U + (c.lt >> 2) * 80 + (c.lt & 3) * 16) = L.u;
    if (c.lt < 129) *(float*)(bp + SC_S + c.lt * 4) = L.sc;
}
__device__ __forceinline__ void scan_alpha(const ScanCtx& c, unsigned char* lds, const unsigned char* bc, bool ctx, f32x4 (&O1)[2]) {
    const int fr = c.fr, fq = c.fq, mt = c.wid;
    f32x4 P[2]; P[0] = (f32x4){0.f, 0.f, 0.f, 0.f}; P[1] = (f32x4){0.f, 0.f, 0.f, 0.f}; O1[0] = (f32x4){0.f, 0.f, 0.f, 0.f}; O1[1] = (f32x4){0.f, 0.f, 0.f, 0.f};
#pragma unroll
    for (int ks = 0; ks < 4; ++ks) {
        const bf16x8 aW = *(const bf16x8*)(bc + SC_W + (16 * mt + fr) * 272 + (32 * ks + 8 * fq) * 2);
        bf16x8 aQ = aW; if (!ctx) aQ = *(const bf16x8*)(bc + SC_Q + (16 * mt + fr) * 272 + (32 * ks + 8 * fq) * 2);
#pragma unroll
        for (int nt = 0; nt < 2; ++nt) {
            const bf16x8 bS = *(const bf16x8*)(lds + SC_ST + (16 * nt + fr) * 272 + (32 * ks + 8 * fq) * 2);
            P[nt] = __builtin_amdgcn_mfma_f32_16x16x32_bf16(aW, bS, P[nt], 0, 0, 0);
            if (!ctx) O1[nt] = __builtin_amdgcn_mfma_f32_16x16x32_bf16(aQ, bS, O1[nt], 0, 0, 0);
        }
    }
    float eec[4];
#pragma unroll
    for (int r = 0; r < 4; ++r) eec[r] = *(const float*)(bc + SC_S + (64 + 16 * mt + 4 * fq + r) * 4);
#pragma unroll
    for (int nt = 0; nt < 2; ++nt) {
        float vn[4];
#pragma unroll
        for (int r = 0; r < 4; ++r) vn[r] = bf2f(*(const bf16_t*)(bc + SC_U + (16 * mt + 4 * fq + r) * 80 + (16 * nt + fr) * 2)) - P[nt][r];
        uint2 w; w.x = pk2(vn[0], vn[1]); w.y = pk2(vn[2], vn[3]);
        *(uint2*)(lds + SC_VT + (16 * nt + fr) * 144 + (16 * mt + 4 * fq) * 2) = w;
        w.x = pk2(vn[0] * eec[0], vn[1] * eec[1]); w.y = pk2(vn[2] * eec[2], vn[3] * eec[3]);
        *(uint2*)(lds + SC_VE + (16 * nt + fr) * 144 + (16 * mt + 4 * fq) * 2) = w;
    }
}
__device__ __forceinline__ void scan_beta(const ScanCtx& c, unsigned char* lds, const unsigned char* bc, bool ctx, int row0, const f32x4 (&O1)[2], f32x4 (&Sacc)[2][2], bf16_t* OD) {
    const int fr = c.fr, fq = c.fq, mt = c.wid;
    const float decc = *(const float*)(bc + SC_S + 128 * 4);
#pragma unroll
    for (int j = 0; j < 2; ++j) {
        const int dt = 2 * c.wid + j;
        const bf16x8 aK0 = *(const bf16x8*)(bc + SC_KT + (16 * dt + fr) * 144 + (8 * fq) * 2), aK1 = *(const bf16x8*)(bc + SC_KT + (16 * dt + fr) * 144 + (32 + 8 * fq) * 2);
#pragma unroll
        for (int e = 0; e < 2; ++e) {
            f32x4 a = Sacc[j][e] * decc;
            const bf16x8 b0 = *(const bf16x8*)(lds + SC_VE + (16 * e + fr) * 144 + (8 * fq) * 2), b1 = *(const bf16x8*)(lds + SC_VE + (16 * e + fr) * 144 + (32 + 8 * fq) * 2);
            a = __builtin_amdgcn_mfma_f32_16x16x32_bf16(aK0, b0, a, 0, 0, 0);
            a = __builtin_amdgcn_mfma_f32_16x16x32_bf16(aK1, b1, a, 0, 0, 0);
            Sacc[j][e] = a;
        }
    }
    if (!ctx) {
        const bf16x8 aA0 = *(const bf16x8*)(bc + SC_AT + (16 * mt + fr) * 144 + (8 * fq) * 2), aA1 = *(const bf16x8*)(bc + SC_AT + (16 * mt + fr) * 144 + (32 + 8 * fq) * 2);
        float egc[4];
#pragma unroll
        for (int r = 0; r < 4; ++r) egc[r] = *(const float*)(bc + SC_S + (16 * mt + 4 * fq + r) * 4);
#pragma unroll
        for (int nt = 0; nt < 2; ++nt) {
            const bf16x8 b0 = *(const bf16x8*)(lds + SC_VT + (16 * nt + fr) * 144 + (8 * fq) * 2), b1 = *(const bf16x8*)(lds + SC_VT + (16 * nt + fr) * 144 + (32 + 8 * fq) * 2);
            f32x4 O2 = (f32x4){0.f, 0.f, 0.f, 0.f};
            O2 = __builtin_amdgcn_mfma_f32_16x16x32_bf16(aA0, b0, O2, 0, 0, 0);
            O2 = __builtin_amdgcn_mfma_f32_16x16x32_bf16(aA1, b1, O2, 0, 0, 0);
#pragma unroll
            for (int r = 0; r < 4; ++r) OD[(size_t)(row0 + 16 * mt + 4 * fq + r) * 1024 + c.h * 128 + 32 * c.sl + 16 * nt + fr] = f2bf(egc[r] * O1[nt][r] + O2[r]);
        }
    }
#pragma unroll
    for (int j = 0; j < 2; ++j)
#pragma unroll
        for (int e = 0; e < 2; ++e) { uint2 w; w.x = pk2_c(Sacc[j][e][0], Sacc[j][e][1]); w.y = pk2_c(Sacc[j][e][2], Sacc[j][e][3]);
            *(uint2*)(lds + SC_ST + (16 * e + fr) * 272 + (16 * (2 * c.wid + j) + 4 * fq) * 2) = w; }
}
__device__ __forceinline__ void phase_gdn_scan(const Params& p, unsigned char* lds) {
    ScanCtx c;
    const int tid = otid(), lane = tid & 63; c.wid = __builtin_amdgcn_readfirstlane(tid >> 6); c.fr = lane & 15; c.fq = lane >> 4;
    const bool loader = c.wid >= 4; c.lt = tid - 256;
    c.KT = (const bf16_t*)(p.ws + OFF_KT); c.QO = (const bf16_t*)(p.ws + OFF_Q); c.UW = (const bf16_t*)(p.ws + OFF_UW);
    c.ATT = (const bf16_t*)(p.ws + OFF_ATT); c.GSC = (const float*)(p.ws + OFF_GSC);
    for (int work = blockIdx.x; work < 256; work += gridDim.x) {
        const int xcd_ = work & 7, idx_ = work >> 3, grp_ = (idx_ >> 2) * 8 + xcd_;
        c.sl = idx_ & 3; c.d = grp_ & 1; c.h = (grp_ >> 1) & 7; c.b = grp_ >> 4;
        bf16_t* OD = (bf16_t*)(p.ws + (c.d ? OFF_OB : OFF_OF));
        for (int i = tid; i < 8704 / 4; i += NT) ((unsigned*)(lds + SC_ST))[i] = 0u;
        if (loader) {
            ScanLd L0, L1;
#define SCAN_ZERO(L_) do { _Pragma("unroll") for (int i = 0; i < 4; ++i) { L_.w[i] = make_uint4(0u, 0u, 0u, 0u); L_.k[i] = make_uint4(0u, 0u, 0u, 0u); L_.q[i] = make_uint4(0u, 0u, 0u, 0u); } \
                L_.a[0] = make_uint4(0u, 0u, 0u, 0u); L_.a[1] = make_uint4(0u, 0u, 0u, 0u); L_.u = make_uint4(0u, 0u, 0u, 0u); L_.sc = 0.f; } while (0)
            SCAN_ZERO(L0); SCAN_ZERO(L1);
#undef SCAN_ZERO
            scan_load(c, L0, 0); scan_store(c, L0, lds); scan_load(c, L1, 1);
            __syncthreads();
#define SCAN_LSTEP(s_, LD_, ST_) do { const int ss_ = (s_); if (ss_ + 2 < NCHUNK) scan_load(c, LD_, ss_ + 2); __syncthreads(); \
                if (ss_ + 1 < NCHUNK) scan_store(c, ST_, lds + ((ss_ + 1) & 1) * SC_BUF); __syncthreads(); } while (0)
#pragma unroll 1
            for (int s = 0; s < NCHUNK; s += 2) {
                SCAN_LSTEP(s, L0, L1); SCAN_LSTEP(s + 1, L1, L0); }
#undef SCAN_LSTEP
        } else {
            __builtin_amdgcn_s_setprio(3);
            f32x4 Sacc[2][2];
#pragma unroll
            for (int j = 0; j < 2; ++j) { Sacc[j][0] = (f32x4){0.f, 0.f, 0.f, 0.f}; Sacc[j][1] = (f32x4){0.f, 0.f, 0.f, 0.f}; }
            __syncthreads();
#pragma unroll 1
            for (int s = 0; s < NCHUNK; ++s) {
                int item, row0; bool ctx; scan_item(c, s, item, ctx, row0); (void)item;
                const unsigned char* bc = lds + (s & 1) * SC_BUF; f32x4 O1[2];
                scan_alpha(c, lds, bc, ctx, O1);
                __syncthreads();
                scan_beta(c, lds, bc, ctx, row0, O1, Sacc, OD);
                __syncthreads();
            }
            __builtin_amdgcn_s_setprio(0);
        }
    }
}

__device__ __forceinline__ void phase_gdn_out(const Params& p) {
    const bf16_t* OFp = (const bf16_t*)(p.ws + OFF_OF); const bf16_t* OBp = (const bf16_t*)(p.ws + OFF_OB); const bf16_t* PZ = (const bf16_t*)(p.ws + OFF_PZ);
    bf16_t* MIX = (bf16_t*)(p.ws + OFF_H); const float* gn = p.in[14];
    const size_t total = (size_t)MLAT * 128, stride = (size_t)gridDim.x * NT;
    size_t e = (size_t)blockIdx.x * NT + otid();
    uint4 ua, ub, uz, na, nb, nz;
    if (e < total) { const size_t row = e >> 7; const int c8 = (int)(e & 127) * 8; ua = *(const uint4*)(OFp + row * 1024 + c8); ub = *(const uint4*)(OBp + row * 1024 + c8); uz = *(const uint4*)(PZ + row * 1024 + c8); }
    for (; e < total; e += stride) {
        const size_t en = e + stride;
        if (en < total) { const size_t row = en >> 7; const int c8 = (int)(en & 127) * 8; na = *(const uint4*)(OFp + row * 1024 + c8); nb = *(const uint4*)(OBp + row * 1024 + c8); nz = *(const uint4*)(PZ + row * 1024 + c8); }
        const size_t row = e >> 7; const int c8 = (int)(e & 127) * 8;
        float a[8], bq[8], z[8];
        unpack8(ua, a); unpack8(ub, bq); unpack8(uz, z);
        float ss = 0.f;
#pragma unroll
        for (int j = 0; j < 8; ++j) { a[j] += bq[j]; ss += a[j] * a[j]; }
        ss += __shfl_xor(ss, 1); ss += __shfl_xor(ss, 2); ss += __shfl_xor(ss, 4); ss += __shfl_xor(ss, 8);
        const float rstd = rsqrtf(ss * (1.0f / 128.0f) + EPSF);
#pragma unroll
        for (int j = 0; j < 8; ++j) a[j] = a[j] * rstd * gn[(c8 & 127) + j] * silu(z[j]);
        *(uint4*)(MIX + row * DM + c8) = pack8(a);
        ua = na; ub = nb; uz = nz;
    }
}

__device__ __forceinline__ void phase_postmix(const Params& p) {
    const int tid_ = otid(), lane = tid_ & 63, wv = __builtin_amdgcn_readfirstlane(tid_ >> 6);
    const float* MOD = (const float*)(p.ws + OFF_MOD); const float* w1 = p.in[7]; const float* w2 = p.in[8];
    const bf16_t* OUT = (const bf16_t*)(p.ws + OFF_OUT); bf16_t* H = (bf16_t*)(p.ws + OFF_H); bf16_t* S1B = (bf16_t*)(p.ws + OFF_S1B);
    const int stride = gridDim.x * 8;
    uint4 ov[4], ovn[4]; float4 xv[8], xvn[8];
    int row = blockIdx.x * 8 + wv;
    if (row < MLAT) {
#pragma unroll
        for (int i = 0; i < 4; ++i) { ov[i] = *(const uint4*)(OUT + (size_t)row * DM + 8 * (lane + 64 * i));
            xv[2 * i] = *(const float4*)(p.in[0] + (size_t)row * DM + 8 * (lane + 64 * i)); xv[2 * i + 1] = *(const float4*)(p.in[0] + (size_t)row * DM + 8 * (lane + 64 * i) + 4); } }
    for (; row < MLAT; row += stride) {
        const int nxt = row + stride;
        if (nxt < MLAT) {
#pragma unroll
            for (int i = 0; i < 4; ++i) { ovn[i] = *(const uint4*)(OUT + (size_t)nxt * DM + 8 * (lane + 64 * i));
                xvn[2 * i] = *(const float4*)(p.in[0] + (size_t)nxt * DM + 8 * (lane + 64 * i)); xvn[2 * i + 1] = *(const float4*)(p.in[0] + (size_t)nxt * DM + 8 * (lane + 64 * i) + 4); } }
        const int b = row >> 13; const float* mb = MOD + b * (6 * DM);
        const float* ga = mb + 2 * DM; const float* shf = mb + 3 * DM; const float* scf = mb + 4 * DM;
        float o[4][8]; float ss = 0.f;
#pragma unroll
        for (int i = 0; i < 4; ++i) { unpack8(ov[i], o[i]);
#pragma unroll
            for (int j = 0; j < 8; ++j) ss += o[i][j] * o[i][j]; }
        ss = wave_sum(ss); const float rstd = rsqrtf(ss * (1.0f / DM) + EPSF);
        float ss2 = 0.f;
#pragma unroll
        for (int i = 0; i < 4; ++i) { const int col = 8 * (lane + 64 * i);
#pragma unroll
            for (int hh = 0; hh < 2; ++hh) { const float4 xq = xv[2 * i + hh], wv4 = *(const float4*)(w1 + col + 4 * hh), gv = *(const float4*)(ga + col + 4 * hh);
                float4 s; s.x = xq.x + gv.x * o[i][4 * hh] * rstd * wv4.x; s.y = xq.y + gv.y * o[i][4 * hh + 1] * rstd * wv4.y; s.z = xq.z + gv.z * o[i][4 * hh + 2] * rstd * wv4.z; s.w = xq.w + gv.w * o[i][4 * hh + 3] * rstd * wv4.w;
                o[i][4 * hh] = s.x; o[i][4 * hh + 1] = s.y; o[i][4 * hh + 2] = s.z; o[i][4 * hh + 3] = s.w;
                ss2 += s.x * s.x + s.y * s.y + s.z * s.z + s.w * s.w; } }
        ss2 = wave_sum(ss2); const float rstd2 = rsqrtf(ss2 * (1.0f / DM) + EPSF);
#pragma unroll
        for (int i = 0; i < 4; ++i) { const int col = 8 * (lane + 64 * i); float f[8];
#pragma unroll
            for (int j = 0; j < 8; ++j) f[j] = o[i][j] * rstd2 * w2[col + j] * (1.f + scf[col + j]) + shf[col + j];
            *(uint4*)(H + (size_t)row * DM + col) = pack8(f); *(uint4*)(S1B + (size_t)row * DM + col) = pack8(o[i]); }
#pragma unroll
        for (int i = 0; i < 4; ++i) { ov[i] = ovn[i]; xv[2 * i] = xvn[2 * i]; xv[2 * i + 1] = xvn[2 * i + 1]; }
    }
}

__device__ __forceinline__ void phase_final(const Params& p) {
    const int tid_ = otid(), lane = tid_ & 63, wv = __builtin_amdgcn_readfirstlane(tid_ >> 6);
    const float* MOD = (const float*)(p.ws + OFF_MOD); const float* w = p.in[9]; const bf16_t* FF = (const bf16_t*)(p.ws + OFF_FF); const bf16_t* S1B = (const bf16_t*)(p.ws + OFF_S1B);
    const int stride = gridDim.x * 8;
    uint4 fv[4], fvn[4], sv[4], svn[4];
    int row = blockIdx.x * 8 + wv;
    if (row < MLAT) {
#pragma unroll
        for (int i = 0; i < 4; ++i) { fv[i] = *(const uint4*)(FF + (size_t)row * DM + 8 * (lane + 64 * i)); sv[i] = *(const uint4*)(S1B + (size_t)row * DM + 8 * (lane + 64 * i)); } }
    for (; row < MLAT; row += stride) {
        const int nxt = row + stride;
        if (nxt < MLAT) {
#pragma unroll
            for (int i = 0; i < 4; ++i) { fvn[i] = *(const uint4*)(FF + (size_t)nxt * DM + 8 * (lane + 64 * i)); svn[i] = *(const uint4*)(S1B + (size_t)nxt * DM + 8 * (lane + 64 * i)); } }
        const int b = row >> 13; const float* gf = MOD + b * (6 * DM) + 5 * DM;
        float o[4][8]; float ss = 0.f;
#pragma unroll
        for (int i = 0; i < 4; ++i) { unpack8(fv[i], o[i]);
#pragma unroll
            for (int j = 0; j < 8; ++j) ss += o[i][j] * o[i][j]; }
        ss = wave_sum(ss); const float rstd = rsqrtf(ss * (1.0f / DM) + EPSF);
#pragma unroll
        for (int i = 0; i < 4; ++i) { const int col = 8 * (lane + 64 * i); float s1[8]; unpack8(sv[i], s1);
#pragma unroll
            for (int hh = 0; hh < 2; ++hh) { const float4 wv4 = *(const float4*)(w + col + 4 * hh), gv = *(const float4*)(gf + col + 4 * hh); float4 s;
                s.x = s1[4 * hh] + gv.x * o[i][4 * hh] * rstd * wv4.x; s.y = s1[4 * hh + 1] + gv.y * o[i][4 * hh + 1] * rstd * wv4.y;
                s.z = s1[4 * hh + 2] + gv.z * o[i][4 * hh + 2] * rstd * wv4.z; s.w = s1[4 * hh + 3] + gv.w * o[i][4 * hh + 3] * rstd * wv4.w;
                *(float4*)(p.out + (size_t)row * DM + col + 4 * hh) = s; } }
#pragma unroll
        for (int i = 0; i < 4; ++i) { fv[i] = fvn[i]; sv[i] = svn[i]; }
    }
}

#define XB_TMO      128
#define XB_XCNT(j)  (256  + 64 * (j))
#define XB_XSUB(j)  (1280 + 64 * (j))
#define XB_XGEN(j)  (2304 + 64 * (j))
#define XB_TOP      3328
#define XB_TOPGEN   3392
#define XCD_BAR_WORDS 3456
#define XB_SPIN_CAP (1u << 18)
#define LAS __attribute__((address_space(3)))

__device__ __forceinline__ unsigned xb_ld(unsigned* p)              { return __hip_atomic_load(p, __ATOMIC_RELAXED, __HIP_MEMORY_SCOPE_AGENT); }
__device__ __forceinline__ unsigned xb_add(unsigned* p, unsigned v) { return __hip_atomic_fetch_add(p, v, __ATOMIC_RELAXED, __HIP_MEMORY_SCOPE_AGENT); }
__device__ __forceinline__ unsigned xb_xcc_id() { return (unsigned)__builtin_amdgcn_s_getreg((3 << 11) | 20) & 0xFu; }
#define XB_SPIN(cond, bar) do { unsigned _sp = 0; while (cond) { __builtin_amdgcn_s_sleep(1); \
    if ((++_sp & 255u) == 0u) { if (xb_ld(&(bar)[XB_TMO])) break; if (_sp > XB_SPIN_CAP) { atomicAdd(&(bar)[XB_TMO], 1u); break; } } } } while (0)

struct XcdBarrier {
    unsigned* bar; unsigned x;
    volatile LAS unsigned* st;
};

__device__ __forceinline__ XcdBarrier xcd_barrier_post(unsigned* bar, volatile LAS unsigned* st) {
    XcdBarrier b; b.bar = bar; b.x = xb_xcc_id(); b.st = st;
    if (threadIdx.x == 0) (void)xb_add(&bar[XB_XCNT(b.x)], 1u);
    return b;
}
__device__ __forceinline__ void xcd_barrier_complete(unsigned* bar, unsigned x, unsigned& nloc, unsigned& nx) {
    const unsigned G = gridDim.x * gridDim.y * gridDim.z;
    unsigned sum, cnt, mine, sp = 0u;
    for (;;) {
        sum = 0u; cnt = 0u; mine = 0u;
#pragma unroll
        for (unsigned j = 0; j < 16; ++j) { const unsigned c = xb_ld(&bar[XB_XCNT(j)]); sum += c; cnt += (c > 0u) ? 1u : 0u; mine = (j == x) ? c : mine; }
        if (sum == G) break;
        __builtin_amdgcn_s_sleep(1);
        if ((++sp & 255u) == 0u) { if (xb_ld(&bar[XB_TMO])) break; if (sp > XB_SPIN_CAP) { atomicAdd(&bar[XB_TMO], 1u); break; } }
    }
    nloc = mine > 0u ? mine : 1u; nx = cnt > 0u ? cnt : 1u;
}

__device__ __forceinline__ void xcd_barrier(const XcdBarrier& b) {
    asm volatile("s_waitcnt vmcnt(0)" ::: "memory");
    __syncthreads();
    if (threadIdx.x == 0) {
        unsigned* bar = b.bar;
        __builtin_amdgcn_s_waitcnt(0);
        unsigned nloc = b.st[0], nx = b.st[1];
        if (nloc == 0u) { xcd_barrier_complete(bar, b.x, nloc, nx); b.st[0] = nloc; b.st[1] = nx; }
        const unsigned old = xb_add(&bar[XB_XSUB(b.x)], 1u);
        const unsigned gen = old / nloc;
        if (old + 1u == (gen + 1u) * nloc) {
            __builtin_amdgcn_fence(__ATOMIC_RELEASE, "agent");
            asm volatile("s_waitcnt vmcnt(0)" ::: "memory");
            const unsigned og = xb_add(&bar[XB_TOP], 1u);
            const unsigned tg = og / nx;
            if (og + 1u == (tg + 1u) * nx) xb_add(&bar[XB_TOPGEN], 1u);
            else XB_SPIN(xb_ld(&bar[XB_TOPGEN]) == tg, bar);
            __builtin_amdgcn_fence(__ATOMIC_ACQUIRE, "agent");
            xb_add(&bar[XB_XGEN(b.x)], 1u);
            asm volatile("s_waitcnt vmcnt(0)" ::: "memory");
        } else {
            XB_SPIN(xb_ld(&bar[XB_XGEN(b.x)]) == gen, bar);
            __builtin_amdgcn_fence(__ATOMIC_ACQUIRE, "agent");
            asm volatile("s_waitcnt vmcnt(0)" ::: "memory");
        }
    }
    __syncthreads();
}


constexpr int NPHASE = 14;
template <class Epi> __device__ __forceinline__ void run_gemm(unsigned char* lds, const bf16_t* A, const bf16_t* Bt, int M, int N, int K, const Epi& E) {
    pg8::Gemm g{A, Bt, M, N, K}; pg8::StaticOrder S; S.init(M, N, (int)gridDim.x, (int)blockIdx.x);
    pg8::gemm_phase<Epi, pg8::StaticOrder, true, true>((PG8_LAS unsigned char*)lds, g, S, E);
}
__global__ void __launch_bounds__(NT, 2) fwd_kernel(Params p) {
    extern __shared__ __attribute__((aligned(16))) unsigned char lds[];
    cg::grid_group grid = cg::this_grid();
    const int lo = p.ph_lo, hi = p.ph_hi;
    unsigned char* ws = p.ws;
    if (lo < 0) grid.sync();
    if (threadIdx.x == 0) *(uint4*)(lds + LDS_BYTES - 16) = make_uint4(0u, 0u, 0u, 0u);
    __syncthreads();
    XcdBarrier xbar = xcd_barrier_post((unsigned*)(ws + OFF_BAR), (volatile LAS unsigned*)((LAS unsigned char*)lds + (LDS_BYTES - 16)));
#ifndef PH_MASK
#define PH_MASK 0xffff
#endif
#ifndef REP_MASK
#define REP_MASK 0
#endif
#define IN(k) ((((PH_MASK) >> (k)) & 1) && lo <= (k) && (k) < hi)
#define REP(k, stmt) do { if (IN(k)) { const int nrep_ = 1 + ((REP_MASK >> (k)) & 1); _Pragma("unroll 1") for (int rep_ = 0; rep_ < nrep_; ++rep_) { if (rep_) xcd_barrier(xbar); stmt; } } } while (0)
#define SEAM(k) do { if (IN(k) && IN((k) + 1)) xcd_barrier(xbar); } while (0)
    REP(0, phase_prologue(p, lds));
    SEAM(0);
    REP(1, phase_prenorm(p));
    SEAM(1);
    { pg8::EpiProj E{(bf16_t*)(ws + OFF_PGDN), (bf16_t*)(ws + OFF_PZ), (bf16_t*)(ws + OFF_PHY), (float*)(ws + OFF_GATES)};
        REP(2, run_gemm(lds, (const bf16_t*)(ws + OFF_H), (const bf16_t*)(ws + OFF_WIN), MALL, N1, DM, E)); }
    SEAM(2);
#pragma unroll 1
    for (int rep_ = 0; rep_ < 1 + ((REP_MASK >> 3) & 1); ++rep_) {
    if (IN(3)) phase_hy1(p, lds);
    SEAM(3);
    if (IN(4)) phase_hy2(p, lds);
    SEAM(4);
    if (IN(5)) phase_hy3(p, lds);
    SEAM(5);
    }
    REP(6, phase_gdn_prep(p, lds));
    SEAM(6);
    REP(7, phase_gdn_scan(p, lds));
    SEAM(7);
    REP(8, phase_gdn_out(p));
    SEAM(8);
    { pg8::EpiPlain E{(bf16_t*)(ws + OFF_OUT), DM};
        REP(9, run_gemm(lds, (const bf16_t*)(ws + OFF_H), (const bf16_t*)(ws + OFF_WOUT), MLAT, DM, DM, E)); }
    SEAM(9);
    REP(10, phase_postmix(p));
    SEAM(10);
    { pg8::EpiSwiglu E{(bf16_t*)(ws + OFF_ACT), DFF};
        REP(11, run_gemm(lds, (const bf16_t*)(ws + OFF_H), (const bf16_t*)(ws + OFF_WGU), MLAT, 2 * DFF, DM, E)); }
    SEAM(11);
    { pg8::EpiPlain E{(bf16_t*)(ws + OFF_FF), DM};
        REP(12, run_gemm(lds, (const bf16_t*)(ws + OFF_ACT), (const bf16_t*)(ws + OFF_WDOWN), MLAT, DM, DFF, E)); }
    SEAM(12);
    if (IN(13)) phase_final(p);
#undef IN
#undef REP
#undef SEAM
}

extern "C" void kernel_launch(void* const* d_in, const int* in_sizes, int n_in, void* d_out, int out_size, void* d_ws, size_t ws_size, hipStream_t stream) {
    static int grid = 0;
    if (grid == 0) {
        if (n_in != 32 || ws_size < WS_TOTAL) { fprintf(stderr, "kernel_launch: need 32 inputs and %zu bytes of workspace (got %d, %zu)\n", (size_t)WS_TOTAL, n_in, ws_size); grid = -1; return; }
        int dev = 0, cus = 0, per_cu = 0;
        hipGetDevice(&dev); hipDeviceGetAttribute(&cus, hipDeviceAttributeMultiprocessorCount, dev);
        if (hipFuncSetAttribute((const void*)fwd_kernel, hipFuncAttributeMaxDynamicSharedMemorySize, LDS_BYTES) != hipSuccess) { fprintf(stderr, "kernel_launch: hipFuncSetAttribute failed\n"); grid = -1; return; }
        if (hipOccupancyMaxActiveBlocksPerMultiprocessor(&per_cu, (const void*)fwd_kernel, NT, LDS_BYTES) != hipSuccess || per_cu < 1) { fprintf(stderr, "kernel_launch: occupancy query gave %d\n", per_cu); per_cu = 1; }
        (void)hipGetLastError();
        grid = cus * per_cu;
    }
    if (grid < 0) return;
    if (hipMemsetAsync((unsigned char*)d_ws + OFF_BAR, 0, XCD_BAR_WORDS * 4, stream) != hipSuccess) { fprintf(stderr, "kernel_launch: memset of the barrier words failed\n"); return; }
    Params p{};
    for (int i = 0; i < 32; ++i) p.in[i] = (const float*)d_in[i];
    p.out = (float*)d_out; p.ws = (unsigned char*)d_ws;
#if MULTI_LAUNCH
    for (int ph = 0; ph < NPHASE; ++ph) { p.ph_lo = ph; p.ph_hi = ph + 1;
        hipLaunchKernelGGL(fwd_kernel, dim3(grid), dim3(NT), LDS_BYTES, stream, p); }
#else
    p.ph_lo = 0; p.ph_hi = NPHASE;
    void* args[] = {&p};
    hipError_t e = hipLaunchCooperativeKernel((const void*)fwd_kernel, dim3(grid), dim3(NT), args, LDS_BYTES, stream);
    if (e != hipSuccess) fprintf(stderr, "cooperative launch failed: %s (grid %d)\n", hipGetErrorString(e), grid);
#endif
}
```

```cpp
#include <hip/hip_runtime.h>
#include <hip/hip_cooperative_groups.h>
#include <cstdio>
#include <cstdint>
namespace cg = cooperative_groups;

#ifndef MULTI_LAUNCH
#define MULTI_LAUNCH 0
#endif

__device__ __forceinline__ int otid() { int t = threadIdx.x; asm volatile("" : "+v"(t)); return t; }

#undef MULTI_LAUNCH
#define MULTI_LAUNCH 0
#define REP_MASK 0
namespace pg8 {
#define PG8_LAS __attribute__((address_space(3)))
typedef unsigned short bf16_t;
typedef short bf16x8 __attribute__((ext_vector_type(8)));
typedef float f32x4 __attribute__((ext_vector_type(4)));
typedef unsigned u32x4 __attribute__((ext_vector_type(4)));
constexpr int BM = 256, BK = 64, HALF = 128, HTB = HALF * BK * 2  , STAGE_BYTES = 8 * HTB, NXCD = 8, WGM = 8;

__host__ __device__ __forceinline__ int lds_byte(int r, int c) { const int st = (r >> 4) * 2 + (c >> 5), rr = r & 15, cc = c & 31, ob = rr * 64 + cc * 2; return st * 1024 + (ob ^ (((ob >> 9) & 1) << 5)); }
__host__ __device__ __forceinline__ void stage_rc(int b, int& R, int& C) { const int st = b / 1024, sb = b % 1024, swz = sb ^ (((sb >> 9) & 1) << 5); R = (st >> 1) * 16 + swz / 64; C = (st & 1) * 32 + (swz % 64) / 2; }
__host__ __device__ __forceinline__ int perm32(int rho) { const int n = rho >> 4, i = rho & 15; return 8 * (i >> 2) + 4 * n + (i & 3); }

struct Unit { int pm, pn; };
struct Gemm { const bf16_t* A; const bf16_t* Bt; int M, N, K; };

struct StaticOrder {
    int nM, nN, nwg, G, c;
    __host__ __device__ void init(int M, int N, int G_, int c_) { nM = M / BM; nN = N / BM; nwg = nM * nN; G = G_; c = c_; }
    __host__ __device__ bool next(int i, Unit& u) const {
        const long L = (long)i * G + c; if (L >= nwg) return false;
        int wgid = (int)L; { const int q = nwg / NXCD, r = nwg % NXCD, xcd = wgid % NXCD, off = wgid / NXCD; wgid = (xcd < r ? xcd * (q + 1) : r * (q + 1) + (xcd - r) * q) + off; }
        const int nig = WGM * nN, gid = wgid / nig, fm = gid * WGM, gsz = (nM - fm) < WGM ? (nM - fm) : WGM;
        u.pm = fm + ((wgid % nig) % gsz); u.pn = (wgid % nig) / gsz; return true;
    }
    __device__ __forceinline__ void a_ready(const Unit&) const {}
    __device__ __forceinline__ void done(const Unit&) const {}
};

__device__ __forceinline__ unsigned cvt_pk_bf16(float lo, float hi) { unsigned r; asm volatile("v_cvt_pk_bf16_f32 %0, %1, %2" : "=v"(r) : "v"(lo), "v"(hi)); return r; }
__device__ __forceinline__ float silu_f(float x) { return x * __builtin_amdgcn_rcpf(1.0f + __expf(-x)); }

struct EpiPlain {
    static constexpr bool PERM = true, AFTER_DRAIN = false;
    bf16_t* O; int ldc;
    __device__ __forceinline__ void operator()(const f32x4 (&acc)[2][2][4][2], const Unit& u, int wr, int wc, int fr, int fq) const {
        const int row0 = u.pm * BM + wr * 64 + fr, col0 = u.pn * BM + wc * 32 + 8 * fq;
#pragma unroll
        for (int ai = 0; ai < 2; ++ai)
#pragma unroll
            for (int m = 0; m < 4; ++m) { bf16_t* rowp = O + (size_t)(row0 + ai * HALF + m * 16) * ldc + col0;
#pragma unroll
                for (int bj = 0; bj < 2; ++bj) { const f32x4 v0 = acc[ai][bj][m][0], v1 = acc[ai][bj][m][1];
                    u32x4 w; w.x = cvt_pk_bf16(v0[0], v0[1]); w.y = cvt_pk_bf16(v0[2], v0[3]); w.z = cvt_pk_bf16(v1[0], v1[1]); w.w = cvt_pk_bf16(v1[2], v1[3]);
                    *(u32x4*)(rowp + bj * HALF) = w; } }
    }
};
struct EpiProj {
    static constexpr bool PERM = true, AFTER_DRAIN = false;
    bf16_t* pgdn; bf16_t* pz; bf16_t* phy; float* gates;
    __device__ __forceinline__ void operator()(const f32x4 (&acc)[2][2][4][2], const Unit& u, int wr, int wc, int fr, int fq) const {
        const int row0 = u.pm * BM + wr * 64 + fr, pn = u.pn;
        if (pn < 28) {
            bf16_t* base; int ld, colt;
            if (pn < 12) { base = pgdn; ld = 3072; colt = pn * 256; }
            else if (pn < 16) { base = pz; ld = 1024; colt = (pn - 12) * 256; }
            else { base = phy; ld = 3072; colt = (pn - 16) * 256; }
            const int col0 = colt + wc * 32 + 8 * fq;
#pragma unroll
            for (int ai = 0; ai < 2; ++ai)
#pragma unroll
                for (int m = 0; m < 4; ++m) { bf16_t* rowp = base + (size_t)(row0 + ai * HALF + m * 16) * ld + col0;
#pragma unroll
                    for (int bj = 0; bj < 2; ++bj) { const f32x4 v0 = acc[ai][bj][m][0], v1 = acc[ai][bj][m][1];
                        u32x4 w; w.x = cvt_pk_bf16(v0[0], v0[1]); w.y = cvt_pk_bf16(v0[2], v0[3]); w.z = cvt_pk_bf16(v1[0], v1[1]); w.w = cvt_pk_bf16(v1[2], v1[3]);
                        *(u32x4*)(rowp + bj * HALF) = w; } }
        } else if (wc == 0) {
#pragma unroll
            for (int ai = 0; ai < 2; ++ai)
#pragma unroll
                for (int m = 0; m < 4; ++m) { float* rowp = gates + (size_t)(row0 + ai * HALF + m * 16) * 32 + 8 * fq;
                    *(f32x4*)(rowp) = acc[ai][0][m][0]; *(f32x4*)(rowp + 4) = acc[ai][0][m][1]; }
        }
    }
};
struct EpiSwiglu {
    static constexpr bool PERM = true, AFTER_DRAIN = false;
    bf16_t* O; int ldc;
    __device__ __forceinline__ void operator()(const f32x4 (&acc)[2][2][4][2], const Unit& u, int wr, int wc, int fr, int fq) const {
        const int row0 = u.pm * BM + wr * 64 + fr, col0 = u.pn * HALF + wc * 32 + 8 * fq;
#pragma unroll
        for (int ai = 0; ai < 2; ++ai)
#pragma unroll
            for (int m = 0; m < 4; ++m) { bf16_t* rowp = O + (size_t)(row0 + ai * HALF + m * 16) * ldc + col0;
                const f32x4 g0 = acc[ai][0][m][0], g1 = acc[ai][0][m][1], u0 = acc[ai][1][m][0], u1 = acc[ai][1][m][1];
                u32x4 w;
                w.x = cvt_pk_bf16(silu_f(g0[0]) * u0[0], silu_f(g0[1]) * u0[1]); w.y = cvt_pk_bf16(silu_f(g0[2]) * u0[2], silu_f(g0[3]) * u0[3]);
                w.z = cvt_pk_bf16(silu_f(g1[0]) * u1[0], silu_f(g1[1]) * u1[1]); w.w = cvt_pk_bf16(silu_f(g1[2]) * u1[2], silu_f(g1[3]) * u1[3]);
                *(u32x4*)(rowp) = w; }
    }
};

template <class Epi, class Sched, bool ALIGN_EPI = false, bool SP2 = false>
__device__ __forceinline__ void gemm_phase(PG8_LAS unsigned char* lds, const Gemm g, const Sched& S, const Epi& E) {
    const int tid = otid(), wid = __builtin_amdgcn_readfirstlane(tid >> 6), lane = tid & 63, wr = wid >> 2, wc = wid & 3, fr = lane & 15, fq = lane >> 4;
    const int K = g.K, nt = K / BK;
    unsigned voffA[2], voffB[2];
#pragma unroll
    for (int i = 0; i < 2; ++i) { int R, C; stage_rc(tid * 16 + i * 8192, R, C); const int Rb = Epi::PERM ? ((R & ~31) + perm32(R & 31)) : R;
        voffA[i] = (unsigned)(R * K + C) * 2u; voffB[i] = (unsigned)(Rb * K + C) * 2u; }
    const size_t kstep = (size_t)(BK * 2);
    const size_t hstep = (size_t)HALF * K * 2;
    const size_t tstep = 2 * hstep;
    const unsigned ldsw = (unsigned)wid * 1024u;
    const int aoff = lds_byte(wr * 64 + fr, fq * 8), boff = lds_byte(wc * 32 + fr, fq * 8);
#define PG8_SA(b, h) (((b) * 2 + (h)) * HTB)
#define PG8_SB(b, h) ((4 + (b) * 2 + (h)) * HTB)
#define PG8_STAGE(bufoff, gbase, voff) do { _Pragma("unroll") for (int _i = 0; _i < 2; ++_i) \
        __builtin_amdgcn_global_load_lds((const unsigned*)((const char*)(gbase) + (voff)[_i]), (PG8_LAS unsigned*)(lds + (bufoff) + ldsw + _i * 8192), 16, 0, 0); } while (0)
#define PG8_LDA(dst, b, h) do { _Pragma("unroll") for (int m = 0; m < 4; ++m) _Pragma("unroll") for (int k = 0; k < 2; ++k) dst[m][k] = *(const PG8_LAS bf16x8*)(lds + PG8_SA(b, h) + aoff + m * 2048 + k * 1024); } while (0)
#define PG8_LDB(dst, b, h) do { _Pragma("unroll") for (int n = 0; n < 2; ++n) _Pragma("unroll") for (int k = 0; k < 2; ++k) dst[n][k] = *(const PG8_LAS bf16x8*)(lds + PG8_SB(b, h) + boff + n * 2048 + k * 1024); } while (0)
#define PG8_MMA(ai, bj, At, Bt) do { __builtin_amdgcn_s_setprio(1); _Pragma("unroll") for (int m = 0; m < 4; ++m) _Pragma("unroll") for (int n = 0; n < 2; ++n) _Pragma("unroll") for (int k = 0; k < 2; ++k) \
        acc[ai][bj][m][n] = __builtin_amdgcn_mfma_f32_16x16x32_bf16(Bt[n][k], At[m][k], acc[ai][bj][m][n], 0, 0, 0); __builtin_amdgcn_s_setprio(0); } while (0)
#define PG8_WAIT_V(n) asm volatile("s_waitcnt vmcnt(" #n ")" ::: "memory")
#define PG8_WAIT_L(n) asm volatile("s_waitcnt lgkmcnt(" #n ")" ::: "memory")
#define PG8_BAR __builtin_amdgcn_s_barrier()
#define PG8_SCHED __builtin_amdgcn_sched_barrier(0)
    Unit cur, nxt; int ui = 0;
    if (!S.next(0, cur)) return;
    f32x4 acc[2][2][4][2];
#pragma unroll
    for (int a = 0; a < 2; ++a)
#pragma unroll
        for (int b = 0; b < 2; ++b)
#pragma unroll
            for (int m = 0; m < 4; ++m)
#pragma unroll
                for (int n = 0; n < 2; ++n) acc[a][b][m][n] = (f32x4){0.f, 0.f, 0.f, 0.f};
    bf16x8 At[4][2], B0[2][2], B1[2][2];
    const char* cA = (const char*)g.A + (size_t)cur.pm * tstep; const char* cB = (const char*)g.Bt + (size_t)cur.pn * tstep;
    S.a_ready(cur);
    if constexpr (SP2) {
        PG8_STAGE(PG8_SB(0, 0), cB, voffB); PG8_STAGE(PG8_SB(0, 1), cB + hstep, voffB); PG8_STAGE(PG8_SA(0, 0), cA, voffA); PG8_STAGE(PG8_SA(0, 1), cA + hstep, voffA);
        if (wr == 1) PG8_BAR;
        PG8_WAIT_V(2); PG8_BAR;
        PG8_STAGE(PG8_SB(1, 0), cB + kstep, voffB); PG8_STAGE(PG8_SA(1, 0), cA + kstep, voffA); PG8_STAGE(PG8_SB(1, 1), cB + hstep + kstep, voffB);
        PG8_WAIT_V(6); PG8_BAR;
    } else {
        PG8_STAGE(PG8_SB(0, 0), cB, voffB); PG8_STAGE(PG8_SA(0, 0), cA, voffA); PG8_STAGE(PG8_SB(0, 1), cB + hstep, voffB); PG8_STAGE(PG8_SA(0, 1), cA + hstep, voffA);
        if (wr == 1) PG8_BAR;
        PG8_WAIT_V(4); PG8_BAR;
        PG8_STAGE(PG8_SB(1, 0), cB + kstep, voffB); PG8_STAGE(PG8_SA(1, 0), cA + kstep, voffA); PG8_STAGE(PG8_SB(1, 1), cB + hstep + kstep, voffB);
        PG8_WAIT_V(6); PG8_BAR;
    }
    for (;;) {
        const bool has_next = S.next(ui + 1, nxt);
        const char* nA = has_next ? (const char*)g.A + (size_t)nxt.pm * tstep : cA; const char* nB = has_next ? (const char*)g.Bt + (size_t)nxt.pn * tstep : cB;
        for (int t = 0; t < nt; t += 2) {
            const bool last = (t == nt - 2);
            const char* a1 = cA + (size_t)(t + 1) * kstep;
            const char* a2 = last ? nA : cA + (size_t)(t + 2) * kstep; const char* b2 = last ? nB : cB + (size_t)(t + 2) * kstep;
            const char* a3 = a2 + kstep; const char* b3 = b2 + kstep;
            if (last && has_next) S.a_ready(nxt);
            if constexpr (SP2) {
            PG8_LDB(B0, 0, 0); PG8_LDB(B1, 0, 1); PG8_SCHED; PG8_LDA(At, 0, 0); PG8_STAGE(PG8_SA(1, 1), a1 + hstep, voffA);
            PG8_WAIT_V(8); PG8_WAIT_L(0); PG8_BAR; PG8_MMA(0, 0, At, B0); PG8_MMA(0, 1, At, B1); PG8_BAR; PG8_SCHED;
            PG8_LDA(At, 0, 1); PG8_STAGE(PG8_SB(0, 0), b2, voffB); PG8_STAGE(PG8_SB(0, 1), b2 + hstep, voffB); PG8_STAGE(PG8_SA(0, 0), a2, voffA);
            PG8_WAIT_V(8); PG8_WAIT_L(0); PG8_BAR; PG8_MMA(1, 0, At, B0); PG8_MMA(1, 1, At, B1); PG8_BAR; PG8_SCHED;
            PG8_LDB(B0, 1, 0); PG8_LDB(B1, 1, 1); PG8_SCHED; PG8_LDA(At, 1, 0); PG8_STAGE(PG8_SA(0, 1), a2 + hstep, voffA);
            PG8_WAIT_V(8); PG8_WAIT_L(0); PG8_BAR; PG8_MMA(0, 0, At, B0); PG8_MMA(0, 1, At, B1); PG8_BAR; PG8_SCHED;
            PG8_LDA(At, 1, 1); PG8_STAGE(PG8_SB(1, 0), b3, voffB); PG8_STAGE(PG8_SB(1, 1), b3 + hstep, voffB); PG8_STAGE(PG8_SA(1, 0), a3, voffA);
            PG8_WAIT_V(8); PG8_WAIT_L(0); PG8_BAR; PG8_MMA(1, 0, At, B0); PG8_MMA(1, 1, At, B1); PG8_BAR; PG8_SCHED;
            } else {
            PG8_LDB(B0, 0, 0); PG8_SCHED; PG8_LDA(At, 0, 0); PG8_STAGE(PG8_SA(1, 1), a1 + hstep, voffA);
            PG8_WAIT_L(8); PG8_BAR; PG8_WAIT_L(0); PG8_MMA(0, 0, At, B0); PG8_BAR; PG8_SCHED;
            PG8_LDB(B1, 0, 1); PG8_STAGE(PG8_SB(0, 0), b2, voffB);
            PG8_BAR; PG8_WAIT_L(0); PG8_MMA(0, 1, At, B1); PG8_BAR;
            PG8_LDA(At, 0, 1); PG8_STAGE(PG8_SA(0, 0), a2, voffA);
            PG8_BAR; PG8_WAIT_L(0); PG8_MMA(1, 0, At, B0); PG8_BAR; PG8_SCHED;
            PG8_STAGE(PG8_SB(0, 1), b2 + hstep, voffB);
            PG8_WAIT_V(6); PG8_BAR; PG8_MMA(1, 1, At, B1); PG8_BAR;
            PG8_LDB(B0, 1, 0); PG8_SCHED; PG8_LDA(At, 1, 0); PG8_STAGE(PG8_SA(0, 1), a2 + hstep, voffA);
            PG8_WAIT_L(8); PG8_BAR; PG8_WAIT_L(0); PG8_MMA(0, 0, At, B0); PG8_BAR; PG8_SCHED;
            PG8_LDB(B1, 1, 1); PG8_STAGE(PG8_SB(1, 0), b3, voffB);
            PG8_BAR; PG8_WAIT_L(0); PG8_MMA(0, 1, At, B1); PG8_BAR;
            PG8_LDA(At, 1, 1); PG8_STAGE(PG8_SA(1, 0), a3, voffA);
            PG8_BAR; PG8_WAIT_L(0); PG8_MMA(1, 0, At, B0); PG8_BAR; PG8_SCHED;
            PG8_STAGE(PG8_SB(1, 1), b3 + hstep, voffB);
            PG8_WAIT_V(6); PG8_BAR; PG8_MMA(1, 1, At, B1); PG8_BAR;
            }
        }
        if constexpr (ALIGN_EPI) { if (wr == 0) PG8_BAR; }
        if constexpr (!Epi::AFTER_DRAIN) { E(acc, cur, wr, wc, fr, fq); S.done(cur); }
        if (!has_next) break;
#pragma unroll
        for (int a = 0; a < 2; ++a)
#pragma unroll
            for (int b = 0; b < 2; ++b)
#pragma unroll
                for (int m = 0; m < 4; ++m)
#pragma unroll
                    for (int n = 0; n < 2; ++n) acc[a][b][m][n] = (f32x4){0.f, 0.f, 0.f, 0.f};
        cur = nxt; cA = nA; cB = nB; ++ui;
        if constexpr (ALIGN_EPI) { if (wr == 1) PG8_BAR; }
    }
    PG8_WAIT_V(0);
    if constexpr (!ALIGN_EPI) { if (wr == 0) PG8_BAR; }
    PG8_BAR;
    if constexpr (Epi::AFTER_DRAIN) { E.fused(acc, cur, wr, wc, fr, fq, lds, wid, lane); S.done(cur); }
#undef PG8_SA
#undef PG8_SB
#undef PG8_STAGE
#undef PG8_LDA
#undef PG8_LDB
#undef PG8_MMA
#undef PG8_WAIT_V
#undef PG8_WAIT_L
#undef PG8_BAR
#undef PG8_SCHED
}
}

typedef unsigned short bf16_t;
typedef short bf16x8 __attribute__((ext_vector_type(8)));
typedef float f32x4 __attribute__((ext_vector_type(4)));
constexpr int NT = 512;
constexpr int DM = 2048, NB = 4, SL = 8192, CL = 256, MLAT = NB * SL, MCTX = NB * CL, MALL = MLAT + MCTX;
constexpr int NHD = 8, HD = 128, CHK = 64, DFF = 5632, N1 = 7424;
constexpr int NCHUNK = 132;
constexpr int NITEM = NB * NCHUNK * NHD;
constexpr float EPSF = 1e-6f;
constexpr int LDS_BYTES = 156 * 1024;

constexpr size_t al256(size_t x) { return (x + 255) & ~(size_t)255; }
constexpr size_t OFF_MOD = 0;
constexpr size_t OFF_GSC = OFF_MOD + al256((size_t)5 * 6 * DM * 4);
constexpr size_t OFF_GATES = OFF_GSC + al256((size_t)NITEM * 2 * 192 * 4);
constexpr size_t OFF_WIN = OFF_GATES + al256((size_t)MALL * 32 * 4);
constexpr size_t OFF_WOUT = OFF_WIN + al256((size_t)N1 * DM * 2);
constexpr size_t OFF_WGU = OFF_WOUT + al256((size_t)DM * DM * 2);
constexpr size_t OFF_WDOWN = OFF_WGU + al256((size_t)2 * DFF * DM * 2);
constexpr size_t OFF_H = OFF_WDOWN + al256((size_t)DM * DFF * 2);
constexpr size_t OFF_PGDN = OFF_H + al256((size_t)MALL * DM * 2);
constexpr size_t OFF_PZ = OFF_PGDN + al256((size_t)MALL * 3072 * 2);
constexpr size_t OFF_PHY = OFF_PZ + al256((size_t)MALL * 1024 * 2);
constexpr size_t OFF_UHT = OFF_PHY + al256((size_t)MALL * 3072 * 2);
constexpr size_t OFF_TAPS = OFF_UHT + al256((size_t)NB * 1024 * SL * 4);
constexpr size_t END_TAPS = OFF_TAPS + al256((size_t)1024 * 16384 * 4);
constexpr size_t OFF_KSPEC = END_TAPS;
constexpr size_t OFF_KT = OFF_PHY;
constexpr size_t OFF_Q = OFF_KT + (size_t)NITEM * 16384;
constexpr size_t OFF_UW = OFF_Q + (size_t)NITEM * 16384;
constexpr size_t OFF_ATT = OFF_UW + (size_t)NITEM * 2 * 32768;
constexpr size_t END_G2 = OFF_ATT + (size_t)NITEM * 2 * 8192;
constexpr size_t WS_END = END_G2 > END_TAPS ? END_G2 : END_TAPS;
constexpr size_t OFF_S1B = OFF_UHT;
constexpr size_t OFF_OF = OFF_PGDN;
constexpr size_t OFF_OB = OFF_PGDN + (size_t)MLAT * 1024 * 2;
constexpr size_t OFF_OUT = OFF_PGDN;
constexpr size_t OFF_ACT = OFF_PGDN;
constexpr size_t OFF_FF = OFF_H;
static_assert((size_t)MLAT * DFF * 2 <= OFF_UHT - OFF_PGDN, "act overlay");
constexpr size_t OFF_BAR = al256(WS_END);
constexpr size_t WS_TOTAL = OFF_BAR + 16384;
static_assert(WS_TOTAL <= ((size_t)1 << 30), "workspace over 1 GiB");

struct Params { const float* in[32]; float* out; unsigned char* ws; int ph_lo, ph_hi; };

__device__ __forceinline__ float bf_lo(unsigned w) { return __uint_as_float(w << 16); }
__device__ __forceinline__ float bf_hi(unsigned w) { return __uint_as_float(w & 0xffff0000u); }
__device__ __forceinline__ float bf2f(bf16_t v) { return __uint_as_float(((unsigned)v) << 16); }
__device__ __forceinline__ unsigned pk2(float lo, float hi) { return pg8::cvt_pk_bf16(lo, hi); }
__device__ __forceinline__ unsigned pk2_c(float lo, float hi) { unsigned a = __float_as_uint(lo), b = __float_as_uint(hi);
    a += 0x7fffu + ((a >> 16) & 1u); b += 0x7fffu + ((b >> 16) & 1u); return (a >> 16) | (b & 0xffff0000u); }
__device__ __forceinline__ bf16_t f2bf(float f) { return (bf16_t)(pk2(f, 0.f) & 0xffffu); }
__device__ __forceinline__ float silu(float x) { return x * __builtin_amdgcn_rcpf(1.0f + __expf(-x)); }
__device__ __forceinline__ void unpack8(const uint4 w, float (&f)[8]) {
    f[0] = bf_lo(w.x); f[1] = bf_hi(w.x); f[2] = bf_lo(w.y); f[3] = bf_hi(w.y); f[4] = bf_lo(w.z); f[5] = bf_hi(w.z); f[6] = bf_lo(w.w); f[7] = bf_hi(w.w);
}
__device__ __forceinline__ uint4 pack8(const float (&f)[8]) { uint4 w; w.x = pk2(f[0], f[1]); w.y = pk2(f[2], f[3]); w.z = pk2(f[4], f[5]); w.w = pk2(f[6], f[7]); return w; }
__device__ __forceinline__ float fsin(float x) { return __builtin_amdgcn_sinf(__builtin_amdgcn_fractf(x * 0.15915494309189535f)); }
__device__ __forceinline__ float wave_sum(float v) {
#pragma unroll
    for (int o = 32; o >= 1; o >>= 1) v += __shfl_xor(v, o);
    return v;
}

__device__ __forceinline__ void adaln_block(const Params& p, unsigned char* lds, int cb) {
    float* sc = (float*)lds;
    float* red = (float*)(lds + 5 * DM * 4);
    const int tid = otid();
    const float* c = p.in[1]; const float* cc = p.in[3]; const float* wm = p.in[4]; const float* bm = p.in[5];
    for (int i = tid; i < 5 * DM; i += NT) { const int r = i / DM, k = i % DM; const float v = r < 4 ? c[r * DM + k] : cc[k]; sc[i] = silu(v); }
    __syncthreads();
    const int l4 = tid % 12, kg = tid / 12;
    if (tid < 504) {
        float acc[5][4];
#pragma unroll
        for (int r = 0; r < 5; ++r)
#pragma unroll
            for (int j = 0; j < 4; ++j) acc[r][j] = 0.f;
#pragma unroll 7
        for (int k = kg; k < DM; k += 42) {
            const float4 w = *(const float4*)(wm + (size_t)k * (6 * DM) + cb * 48 + l4 * 4);
#pragma unroll
            for (int r = 0; r < 5; ++r) { const float s = sc[r * DM + k]; acc[r][0] += s * w.x; acc[r][1] += s * w.y; acc[r][2] += s * w.z; acc[r][3] += s * w.w; }
        }
#pragma unroll
        for (int r = 0; r < 5; ++r)
#pragma unroll
            for (int j = 0; j < 4; ++j) red[(kg * 5 + r) * 48 + l4 * 4 + j] = acc[r][j];
    }
    __syncthreads();
    if (tid < 240) {
        const int r = tid / 48, col = tid % 48; float s = 0.f;
        for (int g = 0; g < 42; ++g) s += red[(g * 5 + r) * 48 + col];
        float* MOD = (float*)(p.ws + OFF_MOD);
        MOD[r * (6 * DM) + cb * 48 + col] = s + bm[cb * 48 + col];
    }
    __syncthreads();
}

__device__ __forceinline__ void taps_block(const Params& p, unsigned char* lds, int tile) {
    float* zs = (float*)lds;
    float* h1 = zs + 32 * 33;
    float* h2 = h1 + 32 * 65;
    float* h3 = h2 + 32 * 65;
    float* w4s = (float*)(lds + 32768);
    const int tid = otid(), t0 = tile * 32;
    const float* w1 = p.in[17]; const float* b1 = p.in[18]; const float* f1 = p.in[19];
    const float* w2 = p.in[20]; const float* b2 = p.in[21]; const float* f2 = p.in[22];
    const float* w3 = p.in[23]; const float* b3 = p.in[24]; const float* f3 = p.in[25];
    const float* w4 = p.in[26]; const float* hb = p.in[27];
    float* ws1 = w4s; float* ws2 = w4s + 2112; float* ws3 = ws2 + 4096;
    for (int i = tid; i < 2112 / 4; i += NT) *(float4*)(ws1 + 4 * i) = *(const float4*)(w1 + 4 * i);
    for (int i = tid; i < 1024; i += NT) { *(float4*)(ws2 + 4 * i) = *(const float4*)(w2 + 4 * i); *(float4*)(ws3 + 4 * i) = *(const float4*)(w3 + 4 * i); }
    for (int i = tid; i < 32 * 33; i += NT) {
        const int r = i / 33, f = i % 33; const float t = (float)(t0 + r);
        float v;
        if (f == 0) v = t / 8191.0f;
        else { const int bi = (f - 1) & 15; const float fr = 1e-4f + (float)bi * ((15.0f - 1e-4f) / 15.0f); const float rev = t * fr * (1.0f / 8192.0f);
            v = (f <= 16) ? __builtin_amdgcn_cosf(__builtin_amdgcn_fractf(rev)) : -__builtin_amdgcn_sinf(__builtin_amdgcn_fractf(rev)); }
        zs[i] = v;
    }
    __syncthreads();
    const int row = tid & 31, ug = tid >> 5;
    {   float a[4] = {0.f, 0.f, 0.f, 0.f};
#pragma unroll 3
        for (int k = 0; k < 33; ++k) { const float z = zs[row * 33 + k]; const float4 w = *(const float4*)(ws1 + k * 64 + ug * 4); a[0] += z * w.x; a[1] += z * w.y; a[2] += z * w.z; a[3] += z * w.w; }
#pragma unroll
        for (int j = 0; j < 4; ++j) h1[row * 65 + ug * 4 + j] = fsin(f1[ug * 4 + j] * (a[j] + b1[ug * 4 + j]));
    }
    __syncthreads();
    {   float a[4] = {0.f, 0.f, 0.f, 0.f};
#pragma unroll 4
        for (int k = 0; k < 64; ++k) { const float z = h1[row * 65 + k]; const float4 w = *(const float4*)(ws2 + k * 64 + ug * 4); a[0] += z * w.x; a[1] += z * w.y; a[2] += z * w.z; a[3] += z * w.w; }
#pragma unroll
        for (int j = 0; j < 4; ++j) h2[row * 65 + ug * 4 + j] = fsin(f2[ug * 4 + j] * (a[j] + b2[ug * 4 + j]));
    }
    __syncthreads();
    {   float a[4] = {0.f, 0.f, 0.f, 0.f};
#pragma unroll 4
        for (int k = 0; k < 64; ++k) { const float z = h2[row * 65 + k]; const float4 w = *(const float4*)(ws3 + k * 64 + ug * 4); a[0] += z * w.x; a[1] += z * w.y; a[2] += z * w.z; a[3] += z * w.w; }
#pragma unroll
        for (int j = 0; j < 4; ++j) h3[row * 65 + ug * 4 + j] = fsin(f3[ug * 4 + j] * (a[j] + b3[ug * 4 + j]));
    }
    __syncthreads();
    bf16_t* Ah = (bf16_t*)(lds + 98304); bf16_t* Al = Ah + 32 * 72;
    {   float hv[4]; unsigned short hh[4], hl[4];
#pragma unroll
        for (int j = 0; j < 4; ++j) { hv[j] = h3[row * 65 + ug * 4 + j]; const unsigned u = pk2_c(hv[j], 0.f) & 0xffffu; hh[j] = (unsigned short)u; hl[j] = (unsigned short)(pk2_c(hv[j] - __uint_as_float(u << 16), 0.f) & 0xffffu); }
        uint2 wh, wl; wh.x = hh[0] | ((unsigned)hh[1] << 16); wh.y = hh[2] | ((unsigned)hh[3] << 16); wl.x = hl[0] | ((unsigned)hl[1] << 16); wl.y = hl[2] | ((unsigned)hl[3] << 16);
        *(uint2*)(Ah + row * 72 + ug * 4) = wh; *(uint2*)(Al + row * 72 + ug * 4) = wl; }
    float* TAPS = (float*)(p.ws + OFF_TAPS);
    const float mind = -3.0701134573253946f, maxd = -15.350567286626973f;
    const int lane = tid & 63, wid = __builtin_amdgcn_readfirstlane(tid >> 6), fr = lane & 15, fq = lane >> 4;
    for (int cc = 0; cc < 8; ++cc) {
        for (int i = tid; i < 64 * 64; i += NT) { const int k = i >> 6, c4 = (i & 63) * 4; *(float4*)(w4s + k * 256 + c4) = *(const float4*)(w4 + (size_t)k * 2048 + cc * 256 + c4); }
        __syncthreads();
#pragma unroll 1
        for (int nn = 0; nn < 2; ++nn) {
            const int nt = wid * 2 + nn;
            f32x4 acc[2]; acc[0] = (f32x4){0.f, 0.f, 0.f, 0.f}; acc[1] = (f32x4){0.f, 0.f, 0.f, 0.f};
#pragma unroll
            for (int ks = 0; ks < 2; ++ks) {
                bf16x8 bh, bl;
#pragma unroll
                for (int e = 0; e < 8; ++e) { const float x = w4s[(32 * ks + 8 * fq + e) * 256 + 16 * nt + fr]; const unsigned u = pk2_c(x, 0.f) & 0xffffu;
                    bh[e] = (short)u; bl[e] = (short)(pk2_c(x - __uint_as_float(u << 16), 0.f) & 0xffffu); }
#pragma unroll
                for (int mt = 0; mt < 2; ++mt) {
                    const bf16x8 ah = *(const bf16x8*)(Ah + (16 * mt + fr) * 72 + 32 * ks + 8 * fq), al = *(const bf16x8*)(Al + (16 * mt + fr) * 72 + 32 * ks + 8 * fq);
                    acc[mt] = __builtin_amdgcn_mfma_f32_16x16x32_bf16(ah, bh, acc[mt], 0, 0, 0);
                    acc[mt] = __builtin_amdgcn_mfma_f32_16x16x32_bf16(ah, bl, acc[mt], 0, 0, 0);
                    acc[mt] = __builtin_amdgcn_mfma_f32_16x16x32_bf16(al, bh, acc[mt], 0, 0, 0);
                }
            }
            const int c2 = cc * 256 + 16 * nt + fr, c = c2 & 1023;
            const float delta = fabsf(mind + (float)c * ((maxd - mind) / 1023.0f));
#pragma unroll
            for (int mt = 0; mt < 2; ++mt)
#pragma unroll
                for (int r = 0; r < 4; ++r) {
                    const int t = t0 + 16 * mt + 4 * fq + r; const float t01 = (float)t / 8191.0f;
                    float v = acc[mt][r] * __expf(-t01 * delta);
                    if (c2 < 1024) { if (t == 0) v += hb[c]; TAPS[(size_t)c * 16384 + t] = v; }
                    else { if (t == 0) TAPS[(size_t)c * 16384 + 8192] = 0.f; else TAPS[(size_t)c * 16384 + 16384 - t] = v; }
                }
        }
        __syncthreads();
    }
}

struct TDesc { const float* src; bf16_t* dst; int srcN, scol, K, kt, nt; };
__device__ __forceinline__ void transpose_decode(const Params& p, int idx, int tid, TDesc& d) {
    int mode, nK;
    if (idx < 928) { mode = 0; nK = 8; } else if (idx < 1184) { mode = 1; nK = 8; idx -= 928; } else if (idx < 2592) { mode = 2; nK = 8; idx -= 1184; } else { mode = 3; nK = 22; idx -= 2592; }
    d.kt = idx % nK; d.nt = idx / nK; d.K = (mode == 3) ? DFF : DM;
    d.dst = (bf16_t*)(p.ws + (mode == 0 ? OFF_WIN : mode == 1 ? OFF_WOUT : mode == 2 ? OFF_WGU : OFF_WDOWN));
    const int nc = (tid & 15) * 4, n = d.nt * 64 + nc;
    if (mode == 0) { d.src = p.in[10]; d.srcN = 7200; d.scol = (n < 3072) ? n : (n < 7168) ? n + 32 : (n < 7200) ? n - 4096 : -1; }
    else if (mode == 1) { d.src = p.in[28]; d.srcN = DM; d.scol = n; }
    else if (mode == 2) { const int pn = n >> 8, w = n & 255; d.src = (w < 128) ? p.in[29] : p.in[30]; d.srcN = DFF; d.scol = pn * 128 + (w & 127); }
    else { d.src = p.in[31]; d.srcN = DM; d.scol = n; }
}
__device__ __forceinline__ void transpose_load(const TDesc& d, int tid, float4 (&v)[8]) {
    const int kr = tid >> 4;
#pragma unroll
    for (int it = 0; it < 8; ++it) { v[it] = make_float4(0.f, 0.f, 0.f, 0.f); if (d.scol >= 0) v[it] = *(const float4*)(d.src + (size_t)(d.kt * 256 + kr + it * 32) * d.srcN + d.scol); }
}
__device__ __forceinline__ void transpose_store(const TDesc& d, int tid, const float4 (&v)[8], float* tile  ) {
    const int kr = tid >> 4, nc = (tid & 15) * 4;
#pragma unroll
    for (int it = 0; it < 8; ++it) { float* tp = tile + (kr + it * 32) * 65 + nc; tp[0] = v[it].x; tp[1] = v[it].y; tp[2] = v[it].z; tp[3] = v[it].w; }
    __syncthreads();
    {   const int nn = tid >> 3, k8 = (tid & 7) * 8;
#pragma unroll
        for (int w = 0; w < 4; ++w) { float f[8];
#pragma unroll
            for (int j = 0; j < 8; ++j) f[j] = tile[(k8 + 64 * w + j) * 65 + nn];
            *(uint4*)(d.dst + (size_t)(d.nt * 64 + nn) * d.K + d.kt * 256 + k8 + 64 * w) = pack8(f); }
    }
    __syncthreads();
}

__device__ __forceinline__ void phase_prologue(const Params& p, unsigned char* lds) {
    const int G = gridDim.x, bx = blockIdx.x;
#ifndef P0_MASK
#define P0_MASK 7
#endif
    if (P0_MASK & 1) for (int cb = bx; cb < 256; cb += G) adaln_block(p, lds, cb);
    if (P0_MASK & 2) for (int t = bx; t < 256; t += G) taps_block(p, lds, t);
    if (P0_MASK & 4) {
        const int tid = otid(); float4 v[8], vn[8]; TDesc d, dn; int i = bx;
        if (i < 3296) { transpose_decode(p, i, tid, d); transpose_load(d, tid, v); }
        for (; i < 3296; i += G) {
            if (i + G < 3296) { transpose_decode(p, i + G, tid, dn); transpose_load(dn, tid, vn); }
            transpose_store(d, tid, v, (float*)lds);
            d = dn;
#pragma unroll
            for (int it = 0; it < 8; ++it) v[it] = vn[it];
        }
    }
}

__device__ __forceinline__ void phase_prenorm(const Params& p) {
    const int tid_ = otid(), lane = tid_ & 63, wv = __builtin_amdgcn_readfirstlane(tid_ >> 6);
    const float* MOD = (const float*)(p.ws + OFF_MOD); const float* g = p.in[6];
    bf16_t* H = (bf16_t*)(p.ws + OFF_H);
    const int stride = gridDim.x * 8;
    float4 v[8], vn[8], pa[8], ps[8]; int r_loaded = -1;
#define PRE_SRC(row_) ((row_) < MLAT ? p.in[0] + (size_t)(row_) * DM : p.in[2] + (size_t)((row_) - MLAT) * DM)
    int row = blockIdx.x * 8 + wv;
    if (row < MALL) { const float* src = PRE_SRC(row);
#pragma unroll
        for (int i = 0; i < 8; ++i) v[i] = *(const float4*)(src + 4 * (lane + 64 * i)); }
    for (; row < MALL; row += stride) {
        const int nxt = row + stride;
        if (nxt < MALL) { const float* src = PRE_SRC(nxt);
#pragma unroll
            for (int i = 0; i < 8; ++i) vn[i] = *(const float4*)(src + 4 * (lane + 64 * i)); }
        const int r = row < MLAT ? (row >> 13) : 4;
        if (r != r_loaded) { r_loaded = r;
            const float* sh = MOD + r * (6 * DM); const float* sc = sh + DM;
#pragma unroll
            for (int i = 0; i < 8; ++i) { const int col = 4 * (lane + 64 * i); const float4 gg = *(const float4*)(g + col), s1 = *(const float4*)(sc + col);
                pa[i] = make_float4(gg.x * (1.f + s1.x), gg.y * (1.f + s1.y), gg.z * (1.f + s1.z), gg.w * (1.f + s1.w)); ps[i] = *(const float4*)(sh + col); } }
        float ss = 0.f;
#pragma unroll
        for (int i = 0; i < 8; ++i) ss += v[i].x * v[i].x + v[i].y * v[i].y + v[i].z * v[i].z + v[i].w * v[i].w;
        ss = wave_sum(ss);
        const float rstd = rsqrtf(ss * (1.0f / DM) + EPSF);
#pragma unroll
        for (int i = 0; i < 8; ++i) { const int col = 4 * (lane + 64 * i);
            uint2 w; w.x = pk2(v[i].x * rstd * pa[i].x + ps[i].x, v[i].y * rstd * pa[i].y + ps[i].y);
            w.y = pk2(v[i].z * rstd * pa[i].z + ps[i].z, v[i].w * rstd * pa[i].w + ps[i].w);
            *(uint2*)(H + (size_t)row * DM + col) = w; }
#pragma unroll
        for (int i = 0; i < 8; ++i) v[i] = vn[i];
    }
#undef PRE_SRC
}

__device__ __forceinline__ void phase_hy1(const Params& p, unsigned char* lds) {
    float* tile = (float*)lds;
    const int tid = otid();
    const bf16_t* PHY = (const bf16_t*)(p.ws + OFF_PHY); bf16_t* MIX = (bf16_t*)(p.ws + OFF_H); bf16_t* UHT = (bf16_t*)(p.ws + OFF_UHT);
    const float* cw = p.in[15]; const float* cb = p.in[16];
    const bool g16 = (gridDim.x & 15) == 0;
    const int c8 = (tid & 7) * 8, tr = tid >> 3;
    float wr[3][3][8], br[3][8]; int ct_loaded = -1; uint4 raw[3][3], rawn[3][3];
    for (int k = 0;; ++k) {
        int ct, tt;
        if (g16) { ct = blockIdx.x & 15; tt = (int)(blockIdx.x >> 4) + k * (int)(gridDim.x >> 4); if (tt >= 512) break; }
        else { const int tl = blockIdx.x + k * gridDim.x; if (tl >= 512 * 16) break; ct = tl & 15; tt = tl >> 4; }
        const int c0 = ct * 64, row0 = tt * 64;
        if (ct != ct_loaded) { ct_loaded = ct;
#pragma unroll
            for (int gI = 0; gI < 3; ++gI) { const int col = gI * 1024 + c0 + c8;
#pragma unroll
                for (int j = 0; j < 8; ++j) br[gI][j] = cb[col + j];
#pragma unroll
                for (int i = 0; i < 3; ++i)
#pragma unroll
                    for (int j = 0; j < 8; ++j) wr[gI][i][j] = cw[i * 3072 + col + j]; } }
        const int row = row0 + tr, tpos = row & (SL - 1);
        if (k == 0) {
#pragma unroll
            for (int gI = 0; gI < 3; ++gI)
#pragma unroll
                for (int i = 0; i < 3; ++i) { int tp = tpos + i - 1; tp = tp < 0 ? 0 : (tp >= SL ? SL - 1 : tp);
                    raw[gI][i] = *(const uint4*)(PHY + (size_t)(row - tpos + tp) * 3072 + gI * 1024 + c0 + c8); }
        }
        {
            int ctn, ttn; bool have;
            if (g16) { ctn = ct; ttn = tt + (int)(gridDim.x >> 4); have = ttn < 512; } else { const int tl = blockIdx.x + (k + 1) * gridDim.x; have = tl < 512 * 16; ctn = tl & 15; ttn = tl >> 4; }
            if (have) { const int rown = ttn * 64 + tr, tposn = rown & (SL - 1);
#pragma unroll
                for (int gI = 0; gI < 3; ++gI)
#pragma unroll
                    for (int i = 0; i < 3; ++i) { int tp = tposn + i - 1; tp = tp < 0 ? 0 : (tp >= SL ? SL - 1 : tp);
                        rawn[gI][i] = *(const uint4*)(PHY + (size_t)(rown - tposn + tp) * 3072 + gI * 1024 + ctn * 64 + c8); } }
        }
        float res[3][8];
#pragma unroll
        for (int gI = 0; gI < 3; ++gI) {
            float a[8];
#pragma unroll
            for (int j = 0; j < 8; ++j) a[j] = br[gI][j];
#pragma unroll
            for (int i = 0; i < 3; ++i) {
                const int tp = tpos + i - 1; const float msk = (tp >= 0 && tp < SL) ? 1.0f : 0.0f;
                float f[8]; unpack8(raw[gI][i], f);
#pragma unroll
                for (int j = 0; j < 8; ++j) a[j] += (wr[gI][i][j] * msk) * f[j];
            }
#pragma unroll
            for (int j = 0; j < 8; ++j) res[gI][j] = a[j];
        }
#pragma unroll
        for (int gI = 0; gI < 3; ++gI)
#pragma unroll
            for (int i = 0; i < 3; ++i) raw[gI][i] = rawn[gI][i];
        *(uint4*)(MIX + (size_t)row * DM + 1024 + c0 + c8) = pack8(res[0]);
#pragma unroll
        for (int j = 0; j < 8; ++j) tile[(c8 + j) * 65 + tr] = res[1][j] * res[2][j];
        __syncthreads();
        {   const int c = tid >> 3, t8 = (tid & 7) * 8; const int b = row0 >> 13, tb = (row0 & (SL - 1)) + t8;
            bf16_t* dp = UHT + ((size_t)(b * 1024 + c0 + c)) * SL + tb; float f[8];
#pragma unroll
            for (int j = 0; j < 8; ++j) f[j] = tile[c * 65 + t8 + j];
            *(uint4*)dp = pack8(f); }
        __syncthreads();
    }
}

__device__ __forceinline__ void phase_hy3(const Params& p, unsigned char* lds) {
    float* tile = (float*)lds;
    const int tid = otid();
    bf16_t* MIX = (bf16_t*)(p.ws + OFF_H); const bf16_t* UHT = (const bf16_t*)(p.ws + OFF_UHT);
    const int c = tid >> 3, t8 = (tid & 7) * 8, tr = tid >> 3, c8 = (tid & 7) * 8;
    uint4 uy, um, ny, nm;
#define HY3_LOAD(tl_, y_, m_) do { const int ct_ = (tl_) & 15, tt_ = (tl_) >> 4, c0_ = ct_ * 64, row0_ = tt_ * 64; const int b_ = row0_ >> 13, tb_ = (row0_ & (SL - 1)) + t8; \
        y_ = *(const uint4*)(UHT + ((size_t)(b_ * 1024 + c0_ + c)) * SL + tb_); m_ = *(const uint4*)(MIX + (size_t)(row0_ + tr) * DM + 1024 + c0_ + c8); } while (0)
    int tl = blockIdx.x;
    if (tl < 512 * 16) HY3_LOAD(tl, uy, um);
    for (; tl < 512 * 16; tl += gridDim.x) {
        const int ct = tl & 15, tt = tl >> 4, c0 = ct * 64, row0 = tt * 64;
        if (tl + (int)gridDim.x < 512 * 16) HY3_LOAD(tl + (int)gridDim.x, ny, nm);
        {   float f[8]; unpack8(uy, f); float* tp = tile + c * 65 + t8;
#pragma unroll
            for (int j = 0; j < 8; ++j) tp[j] = f[j]; }
        __syncthreads();
        {   bf16_t* mp = MIX + (size_t)(row0 + tr) * DM + 1024 + c0 + c8;
            float f[8]; unpack8(um, f);
#pragma unroll
            for (int j = 0; j < 8; ++j) f[j] *= tile[(c8 + j) * 65 + tr];
            *(uint4*)mp = pack8(f); }
        __syncthreads();
        uy = ny; um = nm;
    }
#undef HY3_LOAD
}


__device__ __forceinline__ float2 cmul(float2 a, float2 b) { return make_float2(a.x * b.x - a.y * b.y, a.x * b.y + a.y * b.x); }
__device__ __forceinline__ int pidx(int i) { return i + ((i >> 6) << 2); }
template <bool INV> __device__ __forceinline__ float2 mulw16(float2 d, int m) {
    const float C1 = 0.9238795325112867f, S1 = 0.3826834323650898f, C2 = 0.7071067811865476f;
    float c, s;
    switch (m & 7) {
        case 0: return d;
        case 1: c = C1; s = S1; break;
        case 2: c = C2; s = C2; break;
        case 3: c = S1; s = C1; break;
        case 4: return INV ? make_float2(-d.y, d.x) : make_float2(d.y, -d.x);
        case 5: c = -S1; s = C1; break;
        case 6: c = -C2; s = C2; break;
        default: c = -C1; s = S1; break;
    }
    if (!INV) s = -s;
    return make_float2(d.x * c - d.y * s, d.x * s + d.y * c);
}
template <int R> __device__ __forceinline__ constexpr int brev(int q) { int r = 0; for (int b = 1, o = R >> 1; b < R; b <<= 1, o >>= 1) if (q & b) r |= o; return r; }
template <int R, int LOG, int S0 = 0> __device__ __forceinline__ void dft_fwd(float2 (&v)[R]) {
#pragma unroll
    for (int s = S0; s < LOG; ++s) {
        const int h = (R / 2) >> s;
#pragma unroll
        for (int j = 0; j < R; ++j) {
            if (j & h) continue;
            const int m = (j & (h - 1)) * (R / (2 * h)) * (16 / R);
            const float2 a = v[j], b = v[j + h];
            v[j] = make_float2(a.x + b.x, a.y + b.y);
            v[j + h] = mulw16<false>(make_float2(a.x - b.x, a.y - b.y), m);
        }
    }
}
template <int R, int LOG, int S0 = 0> __device__ __forceinline__ void dft_inv(float2 (&v)[R]) {
#pragma unroll
    for (int s = LOG - 1; s >= S0; --s) {
        const int h = (R / 2) >> s;
#pragma unroll
        for (int j = 0; j < R; ++j) {
            if (j & h) continue;
            const int m = (j & (h - 1)) * (R / (2 * h)) * (16 / R);
            const float2 a = v[j], b = mulw16<true>(v[j + h], m);
            v[j] = make_float2(a.x + b.x, a.y + b.y);
            v[j + h] = make_float2(a.x - b.x, a.y - b.y);
        }
    }
}
__device__ __forceinline__ void tw_powers(float2 w1, float2 (&w)[16]) {
    w[1] = w1; w[2] = cmul(w1, w1); w[3] = cmul(w[2], w1); w[4] = cmul(w[2], w[2]); w[5] = cmul(w[4], w1); w[6] = cmul(w[4], w[2]); w[7] = cmul(w[4], w[3]);
    w[8] = cmul(w[4], w[4]);
#pragma unroll
    for (int k = 1; k < 8; ++k) w[8 + k] = cmul(w[8], w[k]);
}
template <int n, bool INV, bool HALF = false, bool TW = false> __device__ __forceinline__ void fft_pass16(float2* X, int tid, const float2 (&wpre)[16]) {
    constexpr int st = n / 16, PST = (st >= 64) ? st + 4 * (st / 64) : st;
#pragma unroll 1
    for (int g = tid; g < 1024; g += NT) {
        int lo = g & (st - 1); asm volatile("" : "+v"(lo));
        const int blk = g / st, base = blk * n + lo;
        float2* Xp = X + pidx(base);
        float2 w[16];
        if (TW) {
#pragma unroll
            for (int k = 1; k < 16; ++k) w[k] = make_float2(wpre[k].x, INV ? -wpre[k].y : wpre[k].y);
        } else {   const float rev = (float)lo * (1.0f / n); const float c = __builtin_amdgcn_cosf(rev), s = __builtin_amdgcn_sinf(rev);
            tw_powers(make_float2(c, INV ? s : -s), w); }
        float2 v[16];
        if (!INV) {
            if (HALF) {
#pragma unroll
                for (int j = 0; j < 8; ++j) { v[j] = Xp[j * PST]; v[j + 8] = mulw16<false>(v[j], j); }
                dft_fwd<16, 4, 1>(v);
            } else {
#pragma unroll
                for (int j = 0; j < 16; ++j) v[j] = Xp[j * PST];
                dft_fwd<16, 4>(v);
            }
#pragma unroll
            for (int q = 1; q < 16; ++q) v[q] = cmul(v[q], w[brev<16>(q)]);
#pragma unroll
            for (int q = 0; q < 16; ++q) Xp[brev<16>(q) * PST] = v[q];
        } else {
#pragma unroll
            for (int q = 0; q < 16; ++q) { const int k = brev<16>(q); float2 t = Xp[k * PST]; if (k) t = cmul(t, w[k]); v[q] = t; }
            if (HALF) {
                dft_inv<16, 4, 1>(v);
#pragma unroll
                for (int j = 0; j < 8; ++j) { const float2 b = mulw16<true>(v[j + 8], j); Xp[j * PST] = make_float2(v[j].x + b.x, v[j].y + b.y); }
            } else {
                dft_inv<16, 4>(v);
#pragma unroll
                for (int j = 0; j < 16; ++j) Xp[j * PST] = v[j];
            }
        }
    }
}
__device__ __forceinline__ void phase_hy2(const Params& p, unsigned char* lds) {
    float2* X = (float2*)lds;
    const int tid = otid();
    const float* TAPS = (const float*)(p.ws + OFF_TAPS); bf16_t* UHT = (bf16_t*)(p.ws + OFF_UHT);
    float2 w64[16];
    {   const float r64 = (float)(tid & 3) * (1.0f / 64.0f);
        tw_powers(make_float2(__builtin_amdgcn_cosf(r64), -__builtin_amdgcn_sinf(r64)), w64); w64[0] = make_float2(1.f, 0.f); }
    for (int c = blockIdx.x; c < 1024; c += gridDim.x) {
        float4* KS = (float4*)(p.ws + OFF_KSPEC) + (size_t)blockIdx.x * 8192;
#pragma unroll
        for (int i = 0; i < 8; ++i) { const int t = 4 * (tid + NT * i); const float4 v = *(const float4*)(TAPS + (size_t)c * 16384 + t);
            float4* xp = (float4*)(X + pidx(t)); xp[0] = make_float4(v.x, 0.f, v.y, 0.f); xp[1] = make_float4(v.z, 0.f, v.w, 0.f); }
        __syncthreads();
        fft_pass16<16384, false, false, false>(X, tid, w64); __syncthreads();
        fft_pass16<1024, false, false, false>(X, tid, w64); __syncthreads();
        fft_pass16<64, false, false, true>(X, tid, w64); __syncthreads();
#pragma unroll 2
        for (int i = 0; i < 8; ++i) { const float4* xp = (const float4*)(X + pidx(4 * (tid + NT * i))); const float4 a = xp[0], b = xp[1];
            float2 v[4] = {make_float2(a.x, a.y), make_float2(a.z, a.w), make_float2(b.x, b.y), make_float2(b.z, b.w)};
            dft_fwd<4, 2>(v);
            const float sc = 1.0f / 16384.0f;
            KS[2 * (tid + NT * i)] = make_float4(v[0].x * sc, v[0].y * sc, v[1].x * sc, v[1].y * sc); KS[2 * (tid + NT * i) + 1] = make_float4(v[2].x * sc, v[2].y * sc, v[3].x * sc, v[3].y * sc); }
        __syncthreads();
        for (int pr = 0; pr < 2; ++pr) {
            bf16_t* u1 = UHT + ((size_t)((2 * pr) * 1024 + c)) * SL; bf16_t* u2 = UHT + ((size_t)((2 * pr + 1) * 1024 + c)) * SL;
#pragma unroll
            for (int i = 0; i < 4; ++i) { const int t = 4 * (tid + NT * i); const uint2 ua = *(const uint2*)(u1 + t), ub = *(const uint2*)(u2 + t);
                const float4 a = make_float4(bf_lo(ua.x), bf_hi(ua.x), bf_lo(ua.y), bf_hi(ua.y)), b = make_float4(bf_lo(ub.x), bf_hi(ub.x), bf_lo(ub.y), bf_hi(ub.y));
                float4* xp = (float4*)(X + pidx(t)); xp[0] = make_float4(a.x, b.x, a.y, b.y); xp[1] = make_float4(a.z, b.z, a.w, b.w); }
            __syncthreads();
            fft_pass16<16384, false, true, false>(X, tid, w64); __syncthreads();
            fft_pass16<1024, false, false, false>(X, tid, w64); __syncthreads();
            fft_pass16<64, false, false, true>(X, tid, w64); __syncthreads();
#pragma unroll 2
            for (int i = 0; i < 8; ++i) { float4* xp = (float4*)(X + pidx(4 * (tid + NT * i))); const float4 a = xp[0], b = xp[1];
                float2 v[4] = {make_float2(a.x, a.y), make_float2(a.z, a.w), make_float2(b.x, b.y), make_float2(b.z, b.w)};
                dft_fwd<4, 2>(v);
                const float4 k0 = KS[2 * (tid + NT * i)], k1 = KS[2 * (tid + NT * i) + 1];
                v[0] = cmul(v[0], make_float2(k0.x, k0.y)); v[1] = cmul(v[1], make_float2(k0.z, k0.w)); v[2] = cmul(v[2], make_float2(k1.x, k1.y)); v[3] = cmul(v[3], make_float2(k1.z, k1.w));
                dft_inv<4, 2>(v);
                xp[0] = make_float4(v[0].x, v[0].y, v[1].x, v[1].y); xp[1] = make_float4(v[2].x, v[2].y, v[3].x, v[3].y); }
            __syncthreads();
            fft_pass16<64, true, false, true>(X, tid, w64); __syncthreads();
            fft_pass16<1024, true, false, false>(X, tid, w64); __syncthreads();
            fft_pass16<16384, true, true, false>(X, tid, w64); __syncthreads();
#pragma unroll
            for (int i = 0; i < 4; ++i) { const int t = 4 * (tid + NT * i); const float4* xp = (const float4*)(X + pidx(t)); const float4 a = xp[0], b = xp[1];
                uint2 w1, w2; w1.x = pk2(a.x, a.z); w1.y = pk2(b.x, b.z); w2.x = pk2(a.y, a.w); w2.y = pk2(b.y, b.w);
                *(uint2*)(u1 + t) = w1; *(uint2*)(u2 + t) = w2; }
            __syncthreads();
        }
    }
}


__device__ __forceinline__ void item_decode(int item, int& b, int& n, int& h, int& row0, int& seq0, int& seqlen) {
    h = item & 7; const int cidx = item >> 3; b = cidx / NCHUNK; n = cidx % NCHUNK;
    if (n < 4) { seq0 = MLAT + b * CL; seqlen = CL; row0 = seq0 + n * CHK; } else { seq0 = b * SL; seqlen = SL; row0 = seq0 + (n - 4) * CHK; }
}
constexpr int G2X_A10 = 0, G2X_T11 = 5120, G2X_T00T = 10240, G2X_XT = 20480, G2X_BYTES = 30720;
template <int D> __device__ __forceinline__ void g2_tinv_diag(const float* As, int lane, const float* rsu, const float* rsw, bf16_t* TM, unsigned char* xl) {
    const int blk = lane >> 5, cc = lane & 31;
    int abase = D * 64 * 68 + blk * (32 * 68 + 32); asm volatile("" : "+v"(abase));
    const float* Ad = As + abase;
    {   const float* ap = As + D * 64 * 68 + cc * 68 + 32 + 16 * blk; bf16_t* a10 = (bf16_t*)(xl + G2X_A10) + D * 32 * 40;
#pragma unroll
        for (int q = 0; q < 4; ++q) { const float4 v = *(const float4*)(ap + 4 * q);
            a10[(16 * blk + 4 * q + 0) * 40 + cc] = f2bf(v.x); a10[(16 * blk + 4 * q + 1) * 40 + cc] = f2bf(v.y); a10[(16 * blk + 4 * q + 2) * 40 + cc] = f2bf(v.z); a10[(16 * blk + 4 * q + 3) * 40 + cc] = f2bf(v.w); } }
    float x[32];
#pragma unroll
    for (int i = 0; i < 32; ++i) x[i] = (i == cc) ? 1.0f : 0.0f;
#pragma clang loop unroll(full)
    for (int j = 0; j < 31; ++j) {
        const float xj = x[j];
        int zj = 0; asm volatile("" : "+v"(zj) : "v"(x[j > 0 ? j - 1 : 0])); zj &= ~3;
#pragma clang loop unroll(full)
        for (int i4 = ((j + 1) & ~3); i4 < 32; i4 += 4) {
            const float4 a = *(const float4*)(Ad + zj + j * 68 + i4);
            if (i4 > j) x[i4] -= a.x * xj;
            if (i4 + 1 > j) x[i4 + 1] -= a.y * xj;
            if (i4 + 2 > j) x[i4 + 2] -= a.z * xj;
            x[i4 + 3] -= a.w * xj;
        }
    }
    const int sj = 32 * blk + cc, jo = D ? 63 - sj : sj;
    const float su = rsu[D * 64 + jo], sw = rsw[D * 64 + jo];
    bf16_t* tu = TM + (D * 2 + 0) * 64 * 72 + jo; bf16_t* tw = TM + (D * 2 + 1) * 64 * 72 + jo;
#pragma unroll
    for (int ii = 0; ii < 32; ++ii) { const int si = 32 * blk + ii, io = D ? 63 - si : si; tu[io * 72] = f2bf(x[ii] * su); tw[io * 72] = f2bf(x[ii] * sw); }
    if (blk == 1) {
        bf16_t* t11 = (bf16_t*)(xl + G2X_T11) + D * 32 * 40 + cc;
#pragma unroll
        for (int ii = 0; ii < 32; ++ii) { const int io = D ? 63 - ii : ii; tu[io * 72] = 0; tw[io * 72] = 0; t11[ii * 40] = f2bf(x[ii]); }
    } else {
        bf16_t* t0u = (bf16_t*)(xl + G2X_T00T) + (D * 2 + 0) * 32 * 40 + cc * 40; bf16_t* t0w = (bf16_t*)(xl + G2X_T00T) + (D * 2 + 1) * 32 * 40 + cc * 40;
#pragma unroll
        for (int q = 0; q < 4; ++q) { uint4 wu, ww;
            wu.x = pk2(x[8 * q] * su, x[8 * q + 1] * su); wu.y = pk2(x[8 * q + 2] * su, x[8 * q + 3] * su); wu.z = pk2(x[8 * q + 4] * su, x[8 * q + 5] * su); wu.w = pk2(x[8 * q + 6] * su, x[8 * q + 7] * su);
            ww.x = pk2(x[8 * q] * sw, x[8 * q + 1] * sw); ww.y = pk2(x[8 * q + 2] * sw, x[8 * q + 3] * sw); ww.z = pk2(x[8 * q + 4] * sw, x[8 * q + 5] * sw); ww.w = pk2(x[8 * q + 6] * sw, x[8 * q + 7] * sw);
            *(uint4*)(t0u + 8 * q) = wu; *(uint4*)(t0w + 8 * q) = ww; }
    }
}
constexpr int G2_KB = 0, G2_QB = 17408, G2_TM = 0  , G2_KT = 36864, G2_VT = 55296, G2_AS = 73728, G2_GT = 108544, G2_XL = 110592;
static_assert(G2_GT + 8 * 64 * 4 <= G2_XL && G2_XL + G2X_BYTES <= LDS_BYTES, "G2 LDS");
__device__ __forceinline__ void phase_gdn_prep(const Params& p, unsigned char* lds) {
    bf16_t* kb = (bf16_t*)(lds + G2_KB); bf16_t* qb = (bf16_t*)(lds + G2_QB); bf16_t* kT = (bf16_t*)(lds + G2_KT); bf16_t* vT = (bf16_t*)(lds + G2_VT);
    float* As = (float*)(lds + G2_AS); bf16_t* TM = (bf16_t*)(lds + G2_TM); float* gt = (float*)(lds + G2_GT); unsigned char* xl = lds + G2_XL;
    float* beta_s = gt; float* gc_s = gt + 128; float* rsu = gt + 256; float* rsw = gt + 384;
    const bf16_t* PG = (const bf16_t*)(p.ws + OFF_PGDN); const float* GATES = (const float*)(p.ws + OFF_GATES);
    const float* cw = p.in[11]; const float* a_log = p.in[12]; const float* dt_bias = p.in[13];
    bf16_t* KT = (bf16_t*)(p.ws + OFF_KT); bf16_t* QO = (bf16_t*)(p.ws + OFF_Q); bf16_t* UW = (bf16_t*)(p.ws + OFF_UW); bf16_t* ATT = (bf16_t*)(p.ws + OFF_ATT);
    float* GSC = (float*)(p.ws + OFF_GSC);
    for (int item = blockIdx.x; item < NITEM; item += gridDim.x) {
        int tid = otid();
        const int lane = tid & 63, wid = __builtin_amdgcn_readfirstlane(tid >> 6), fr = lane & 15, fq = lane >> 4;
        int b, n, h, row0, seq0, seqlen; item_decode(item, b, n, h, row0, seq0, seqlen);
        const bool ctx = n < 4;
        float graw_b = 0.f, graw_a = 0.f;
        if (tid < 128) { const int d = tid >> 6, i = d ? 63 - lane : lane; const float* gp = GATES + (size_t)(row0 + i) * 32; graw_b = gp[d * 8 + h]; graw_a = gp[16 + d * 8 + h]; }
        {   const int r = tid >> 3, c16 = (tid & 7) * 16;
            uint4 raw[3][5][2];
#pragma unroll
            for (int mt = 0; mt < 3; ++mt)
#pragma unroll
                for (int i = 0; i < 5; ++i) { int rr = row0 + r + i - 2; rr = rr < seq0 ? seq0 : (rr >= seq0 + seqlen ? seq0 + seqlen - 1 : rr);
                    const bf16_t* sp = PG + (size_t)rr * 3072 + mt * 1024 + h * 128 + c16; raw[mt][i][0] = *(const uint4*)sp; raw[mt][i][1] = *(const uint4*)(sp + 8); }
#pragma unroll
            for (int mt = 0; mt < 3; ++mt) {
                if (mt == 2 && ctx) break;
                const int col = mt * 1024 + h * 128 + c16;
                float a[16];
#pragma unroll
                for (int j = 0; j < 16; ++j) a[j] = 0.f;
#pragma unroll
                for (int i = 0; i < 5; ++i) {
                    const int rr = row0 + r + i - 2;
                    const float msk = (rr >= seq0 && rr < seq0 + seqlen) ? 1.0f : 0.0f;
                    float f0[8], f1[8]; unpack8(raw[mt][i][0], f0); unpack8(raw[mt][i][1], f1);
                    const float* wp = cw + i * 3072 + col;
#pragma unroll
                    for (int j = 0; j < 8; ++j) { a[j] += (wp[j] * msk) * f0[j]; a[8 + j] += (wp[8 + j] * msk) * f1[j]; }
                }
                float ss = 0.f;
#pragma unroll
                for (int j = 0; j < 16; ++j) { a[j] = silu(a[j]); ss += a[j] * a[j]; }
                if (mt != 1) {
                    ss += __shfl_xor(ss, 1); ss += __shfl_xor(ss, 2); ss += __shfl_xor(ss, 4);
                    const float sc = rsqrtf(ss + EPSF) * (mt == 2 ? 0.08838834764831845f : 1.0f);
#pragma unroll
                    for (int j = 0; j < 16; ++j) a[j] *= sc;
                }
                uint4 w0, w1; w0.x = pk2(a[0], a[1]); w0.y = pk2(a[2], a[3]); w0.z = pk2(a[4], a[5]); w0.w = pk2(a[6], a[7]);
                w1.x = pk2(a[8], a[9]); w1.y = pk2(a[10], a[11]); w1.z = pk2(a[12], a[13]); w1.w = pk2(a[14], a[15]);
                if (mt == 0) {
                    *(uint4*)(kb + r * 136 + c16) = w0; *(uint4*)(kb + r * 136 + c16 + 8) = w1;
#pragma unroll
                    for (int j = 0; j < 16; ++j) kT[(c16 + j) * 72 + r] = f2bf(a[j]);
                } else if (mt == 1) {
#pragma unroll
                    for (int j = 0; j < 16; ++j) vT[(c16 + j) * 72 + r] = f2bf(a[j]);
                } else {
                    *(uint4*)(qb + r * 136 + c16) = w0; *(uint4*)(qb + r * 136 + c16 + 8) = w1;
                    bf16_t* qp = QO + (size_t)item * 8192 + r * 128 + c16; *(uint4*)qp = w0; *(uint4*)(qp + 8) = w1;
                }
            }
        }
        if (tid < 128) {
            const int d = tid >> 6, i = d ? 63 - lane : lane;
            const float beta = 1.0f / (1.0f + __expf(-graw_b));
            const float x = graw_a + dt_bias[d * 8 + h];
            const float sp = x > 20.f ? x : __logf(1.0f + __expf(x));
            float g = -__expf(a_log[d * 8 + h]) * sp;
#pragma unroll
            for (int o = 1; o < 64; o <<= 1) { const float t = __shfl_up(g, o); if (lane >= o) g += t; }
            const float glast = __shfl(g, 63);
            const float eg = __expf(g), ee = __expf(glast - g);
            beta_s[d * 64 + i] = beta; gc_s[d * 64 + i] = g; rsu[d * 64 + i] = beta; rsw[d * 64 + i] = beta * eg;
            float* gs = GSC + ((size_t)item * 2 + d) * 192; gs[i] = eg; gs[64 + i] = ee; if (lane == 63) gs[128] = __expf(glast);
        }
        __syncthreads();
#pragma unroll
        for (int i = 0; i < 2; ++i) { const int q16 = tid + NT * i; *(uint4*)(KT + (size_t)item * 8192 + (size_t)q16 * 8) = *(const uint4*)(kT + (q16 >> 3) * 72 + (q16 & 7) * 8); }
        {   const int mt = wid >> 1, ntp = wid & 1;
            f32x4 ckk[2], cqk[2];
#pragma unroll
            for (int e = 0; e < 2; ++e) { ckk[e] = (f32x4){0.f, 0.f, 0.f, 0.f}; cqk[e] = (f32x4){0.f, 0.f, 0.f, 0.f}; }
#pragma unroll
            for (int ks = 0; ks < 4; ++ks) {
                const bf16x8 ak = *(const bf16x8*)(kb + (16 * mt + fr) * 136 + 32 * ks + 8 * fq);
                bf16x8 aq = ak; if (!ctx) aq = *(const bf16x8*)(qb + (16 * mt + fr) * 136 + 32 * ks + 8 * fq);
#pragma unroll
                for (int e = 0; e < 2; ++e) { const bf16x8 bk = *(const bf16x8*)(kb + (16 * (2 * ntp + e) + fr) * 136 + 32 * ks + 8 * fq);
                    ckk[e] = __builtin_amdgcn_mfma_f32_16x16x32_bf16(ak, bk, ckk[e], 0, 0, 0);
                    cqk[e] = __builtin_amdgcn_mfma_f32_16x16x32_bf16(aq, bk, cqk[e], 0, 0, 0); }
            }
#pragma unroll
            for (int e = 0; e < 2; ++e)
#pragma unroll
                for (int r = 0; r < 4; ++r) {
                    const int i = 16 * mt + 4 * fq + r, j = 16 * (2 * ntp + e) + fr;
#pragma unroll
                    for (int d = 0; d < 2; ++d) {
                        const bool before = d ? (j > i) : (j < i); const bool incl = before || (i == j);
                        const float df = incl ? gc_s[d * 64 + i] - gc_s[d * 64 + j] : 0.f; const float ex = __expf(df);
                        const float av = before ? beta_s[d * 64 + i] * ckk[e][r] * ex : 0.f;
                        const int ii = d ? 63 - i : i, jj = d ? 63 - j : j;
                        As[(d * 64 + jj) * 68 + ii] = av;
                        if (!ctx) ATT[((size_t)item * 2 + d) * 4096 + i * 64 + j] = f2bf(incl ? cqk[e][r] * ex : 0.f);
                    }
                }
        }
        __syncthreads();
        if (wid == 0) g2_tinv_diag<0>(As, lane, rsu, rsw, TM, xl);
        else if (wid == 1) g2_tinv_diag<1>(As, lane, rsu, rsw, TM, xl);
        __syncthreads();
        {   const int dd = wid >> 2, vv = (wid >> 1) & 1, mh = wid & 1;
            const bf16_t* a10 = (const bf16_t*)(xl + G2X_A10) + dd * 32 * 40; const bf16_t* t11 = (const bf16_t*)(xl + G2X_T11) + dd * 32 * 40;
            const bf16_t* t0t = (const bf16_t*)(xl + G2X_T00T) + (dd * 2 + vv) * 32 * 40; bf16_t* xt = (bf16_t*)(xl + G2X_XT) + (dd * 2 + vv) * 32 * 40;
            const bf16x8 aA = *(const bf16x8*)(a10 + (16 * mh + fr) * 40 + 8 * fq);
#pragma unroll
            for (int nt = 0; nt < 2; ++nt) { const bf16x8 bT = *(const bf16x8*)(t0t + (16 * nt + fr) * 40 + 8 * fq);
                f32x4 acc = (f32x4){0.f, 0.f, 0.f, 0.f}; acc = __builtin_amdgcn_mfma_f32_16x16x32_bf16(aA, bT, acc, 0, 0, 0);
                uint2 w; w.x = pk2_c(acc[0], acc[1]); w.y = pk2_c(acc[2], acc[3]);
                *(uint2*)(xt + (16 * nt + fr) * 40 + 16 * mh + 4 * fq) = w; }
            __syncthreads();
            const bf16x8 aT = *(const bf16x8*)(t11 + (16 * mh + fr) * 40 + 8 * fq);
            bf16_t* tm = TM + (dd * 2 + vv) * 64 * 72;
#pragma unroll
            for (int nt = 0; nt < 2; ++nt) { const bf16x8 bX = *(const bf16x8*)(xt + (16 * nt + fr) * 40 + 8 * fq);
                f32x4 acc = (f32x4){0.f, 0.f, 0.f, 0.f}; acc = __builtin_amdgcn_mfma_f32_16x16x32_bf16(aT, bX, acc, 0, 0, 0);
                const int sj = 16 * nt + fr, jo = dd ? 63 - sj : sj;
#pragma unroll
                for (int r = 0; r < 4; ++r) { const int si = 32 + 16 * mh + 4 * fq + r, io = dd ? 63 - si : si; tm[io * 72 + jo] = (bf16_t)(pk2_c(-acc[r], 0.f) & 0xffffu); } }
        }
        __syncthreads();
        {   const int mi = wid >> 1, half = wid & 1, uw = mi & 1;
            const bf16_t* Tm = TM + mi * 64 * 72; const bf16_t* Bm = uw ? kT : vT;
            bf16_t* dst = UW + ((size_t)item * 4 + mi) * 8192;
#pragma unroll
            for (int mm = 0; mm < 2; ++mm) {
                const int mt = 2 * half + mm;
                const bf16x8 a0 = *(const bf16x8*)(Tm + (16 * mt + fr) * 72 + 8 * fq), a1 = *(const bf16x8*)(Tm + (16 * mt + fr) * 72 + 32 + 8 * fq);
#pragma unroll
                for (int nt = 0; nt < 8; ++nt) {
                    const bf16x8 b0 = *(const bf16x8*)(Bm + (16 * nt + fr) * 72 + 8 * fq), b1 = *(const bf16x8*)(Bm + (16 * nt + fr) * 72 + 32 + 8 * fq);
                    f32x4 acc = (f32x4){0.f, 0.f, 0.f, 0.f};
                    acc = __builtin_amdgcn_mfma_f32_16x16x32_bf16(b0, a0, acc, 0, 0, 0);
                    acc = __builtin_amdgcn_mfma_f32_16x16x32_bf16(b1, a1, acc, 0, 0, 0);
                    uint2 w; w.x = pk2_c(acc[0], acc[1]); w.y = pk2_c(acc[2], acc[3]);
                    *(uint2*)(dst + (16 * mt + fr) * 128 + 16 * nt + 4 * fq) = w;
                }
            }
        }
        __syncthreads();
    }
}

constexpr int SC_BUF = 68224, SC_W = 0, SC_KT = 17408, SC_Q = 35840, SC_AT = 53248, SC_U = 62464  , SC_S = 67584  ,
              SC_ST = 2 * SC_BUF, SC_VT = SC_ST + 8704, SC_VE = SC_VT + 4608;
static_assert(SC_S + 132 * 4 <= SC_BUF && SC_VE + 4608 <= LDS_BYTES - 16, "scan LDS");
struct ScanLd { uint4 w[4], k[4], q[4], a[2], u; float sc; };
struct ScanCtx { const bf16_t* KT; const bf16_t* QO; const bf16_t* UW; const bf16_t* ATT; const float* GSC; int lt, fr, fq, wid, sl, d, h, b; };
__device__ __forceinline__ void scan_item(const ScanCtx& c, int s, int& item, bool& ctx, int& row0) {
    const int n = c.d ? (s < 4 ? 3 - s : 135 - s) : s; item = ((c.b * NCHUNK + n) << 3) + c.h; ctx = n < 4;
    row0 = ctx ? MLAT + c.b * CL + n * CHK : c.b * SL + (n - 4) * CHK;
}
__device__ __forceinline__ void scan_load(const ScanCtx& c, ScanLd& L, int s) {
    int it, r0; bool cx; scan_item(c, s, it, cx, r0); (void)cx; (void)r0;
    const bf16_t* wp = c.UW + (((size_t)it * 2 + c.d) * 2 + 1) * 8192; const bf16_t* up = c.UW + (((size_t)it * 2 + c.d) * 2) * 8192;
    const bf16_t* kp = c.KT + (size_t)it * 8192; const bf16_t* qp = c.QO + (size_t)it * 8192; const bf16_t* ap = c.ATT + ((size_t)it * 2 + c.d) * 4096;
    const float* gs = c.GSC + ((size_t)it * 2 + c.d) * 192;
    const unsigned o16 = (unsigned)c.lt * 16u;
#pragma unroll
    for (int i = 0; i < 4; ++i) { const unsigned q = o16 + 4096u * i; L.w[i] = *(const uint4*)((const char*)wp + q); L.k[i] = *(const uint4*)((const char*)kp + q); L.q[i] = *(const uint4*)((const char*)qp + q); }
#pragma unroll
    for (int i = 0; i < 2; ++i) L.a[i] = *(const uint4*)((const char*)ap + o16 + 4096u * i);
    L.u = *(const uint4*)((const char*)up + (unsigned)((c.lt >> 2) * 256 + 64 * c.sl + (c.lt & 3) * 16));
    L.sc = gs[c.lt < 129 ? c.lt : 128];
}
__device__ __forceinline__ void scan_store(const ScanCtx& c, const ScanLd& L, unsigned char* bp) {
#pragma unroll
    for (int i = 0; i < 4; ++i) { const int q = c.lt + 256 * i;
        *(uint4*)(bp + SC_W + (q >> 4) * 272 + (q & 15) * 16) = L.w[i];
        *(uint4*)(bp + SC_KT + (q >> 3) * 144 + (q & 7) * 16) = L.k[i];
        *(uint4*)(bp + SC_Q + (q >> 4) * 272 + (q & 15) * 16) = L.q[i]; }
#pragma unroll
    for (int i = 0; i < 2; ++i) { const int q = c.lt + 256 * i; *(uint4*)(bp + SC_AT + (q >> 3) * 144 + (q & 7) * 16) = L.a[i]; }
    *(uint4*)(bp + SC_U + (c.lt >> 2) * 80 + (c.lt & 3) * 16) = L.u;
    if (c.lt < 129) *(float*)(bp + SC_S + c.lt * 4) = L.sc;
}
__device__ __forceinline__ void scan_alpha(const ScanCtx& c, unsigned char* lds, const unsigned char* bc, bool ctx, f32x4 (&O1)[2]) {
    const int fr = c.fr, fq = c.fq, mt = c.wid;
    f32x4 P[2]; P[0] = (f32x4){0.f, 0.f, 0.f, 0.f}; P[1] = (f32x4){0.f, 0.f, 0.f, 0.f}; O1[0] = (f32x4){0.f, 0.f, 0.f, 0.f}; O1[1] = (f32x4){0.f, 0.f, 0.f, 0.f};
#pragma unroll
    for (int ks = 0; ks < 4; ++ks) {
        const bf16x8 aW = *(const bf16x8*)(bc + SC_W + (16 * mt + fr) * 272 + (32 * ks + 8 * fq) * 2);
        bf16x8 aQ = aW; if (!ctx) aQ = *(const bf16x8*)(bc + SC_Q + (16 * mt + fr) * 272 + (32 * ks + 8 * fq) * 2);
#pragma unroll
        for (int nt = 0; nt < 2; ++nt) {
            const bf16x8 bS = *(const bf16x8*)(lds + SC_ST + (16 * nt + fr) * 272 + (32 * ks + 8 * fq) * 2);
            P[nt] = __builtin_amdgcn_mfma_f32_16x16x32_bf16(aW, bS, P[nt], 0, 0, 0);
            if (!ctx) O1[nt] = __builtin_amdgcn_mfma_f32_16x16x32_bf16(aQ, bS, O1[nt], 0, 0, 0);
        }
    }
    float eec[4];
#pragma unroll
    for (int r = 0; r < 4; ++r) eec[r] = *(const float*)(bc + SC_S + (64 + 16 * mt + 4 * fq + r) * 4);
#pragma unroll
    for (int nt = 0; nt < 2; ++nt) {
        float vn[4];
#pragma unroll
        for (int r = 0; r < 4; ++r) vn[r] = bf2f(*(const bf16_t*)(bc + SC_U + (16 * mt + 4 * fq + r) * 80 + (16 * nt + fr) * 2)) - P[nt][r];
        uint2 w; w.x = pk2(vn[0], vn[1]); w.y = pk2(vn[2], vn[3]);
        *(uint2*)(lds + SC_VT + (16 * nt + fr) * 144 + (16 * mt + 4 * fq) * 2) = w;
        w.x = pk2(vn[0] * eec[0], vn[1] * eec[1]); w.y = pk2(vn[2] * eec[2], vn[3] * eec[3]);
        *(uint2*)(lds + SC_VE + (16 * nt + fr) * 144 + (16 * mt + 4 * fq) * 2) = w;
    }
}
__device__ __forceinline__ void scan_beta(const ScanCtx& c, unsigned char* lds, const unsigned char* bc, bool ctx, int row0, const f32x4 (&O1)[2], f32x4 (&Sacc)[2][2], bf16_t* OD) {
    const int fr = c.fr, fq = c.fq, mt = c.wid;
    const float decc = *(const float*)(bc + SC_S + 128 * 4);
#pragma unroll
    for (int j = 0; j < 2; ++j) {
        const int dt = 2 * c.wid + j;
        const bf16x8 aK0 = *(const bf16x8*)(bc + SC_KT + (16 * dt + fr) * 144 + (8 * fq) * 2), aK1 = *(const bf16x8*)(bc + SC_KT + (16 * dt + fr) * 144 + (32 + 8 * fq) * 2);
#pragma unroll
        for (int e = 0; e < 2; ++e) {
            f32x4 a = Sacc[j][e] * decc;
            const bf16x8 b0 = *(const bf16x8*)(lds + SC_VE + (16 * e + fr) * 144 + (8 * fq) * 2), b1 = *(const bf16x8*)(lds + SC_VE + (16 * e + fr) * 144 + (32 + 8 * fq) * 2);
            a = __builtin_amdgcn_mfma_f32_16x16x32_bf16(aK0, b0, a, 0, 0, 0);
            a = __builtin_amdgcn_mfma_f32_16x16x32_bf16(aK1, b1, a, 0, 0, 0);
            Sacc[j][e] = a;
        }
    }
    if (!ctx) {
        const bf16x8 aA0 = *(const bf16x8*)(bc + SC_AT + (16 * mt + fr) * 144 + (8 * fq) * 2), aA1 = *(const bf16x8*)(bc + SC_AT + (16 * mt + fr) * 144 + (32 + 8 * fq) * 2);
        float egc[4];
#pragma unroll
        for (int r = 0; r < 4; ++r) egc[r] = *(const float*)(bc + SC_S + (16 * mt + 4 * fq + r) * 4);
#pragma unroll
        for (int nt = 0; nt < 2; ++nt) {
            const bf16x8 b0 = *(const bf16x8*)(lds + SC_VT + (16 * nt + fr) * 144 + (8 * fq) * 2), b1 = *(const bf16x8*)(lds + SC_VT + (16 * nt + fr) * 144 + (32 + 8 * fq) * 2);
            f32x4 O2 = (f32x4){0.f, 0.f, 0.f, 0.f};
            O2 = __builtin_amdgcn_mfma_f32_16x16x32_bf16(aA0, b0, O2, 0, 0, 0);
            O2 = __builtin_amdgcn_mfma_f32_16x16x32_bf16(aA1, b1, O2, 0, 0, 0);
#pragma unroll
            for (int r = 0; r < 4; ++r) OD[(size_t)(row0 + 16 * mt + 4 * fq + r) * 1024 + c.h * 128 + 32 * c.sl + 16 * nt + fr] = f2bf(egc[r] * O1[nt][r] + O2[r]);
        }
    }
#pragma unroll
    for (int j = 0; j < 2; ++j)
#pragma unroll
        for (int e = 0; e < 2; ++e) { uint2 w; w.x = pk2_c(Sacc[j][e][0], Sacc[j][e][1]); w.y = pk2_c(Sacc[j][e][2], Sacc[j][e][3]);
            *(uint2*)(lds + SC_ST + (16 * e + fr) * 272 + (16 * (2 * c.wid + j) + 4 * fq) * 2) = w; }
}
__device__ __forceinline__ void phase_gdn_scan(const Params& p, unsigned char* lds) {
    ScanCtx c;
    const int tid = otid(), lane = tid & 63; c.wid = __builtin_amdgcn_readfirstlane(tid >> 6); c.fr = lane & 15; c.fq = lane >> 4;
    const bool loader = c.wid >= 4; c.lt = tid - 256;
    c.KT = (const bf16_t*)(p.ws + OFF_KT); c.QO = (const bf16_t*)(p.ws + OFF_Q); c.UW = (const bf16_t*)(p.ws + OFF_UW);
    c.ATT = (const bf16_t*)(p.ws + OFF_ATT); c.GSC = (const float*)(p.ws + OFF_GSC);
    for (int work = blockIdx.x; work < 256; work += gridDim.x) {
        const int xcd_ = work & 7, idx_ = work >> 3, grp_ = (idx_ >> 2) * 8 + xcd_;
        c.sl = idx_ & 3; c.d = grp_ & 1; c.h = (grp_ >> 1) & 7; c.b = grp_ >> 4;
        bf16_t* OD = (bf16_t*)(p.ws + (c.d ? OFF_OB : OFF_OF));
        for (int i = tid; i < 8704 / 4; i += NT) ((unsigned*)(lds + SC_ST))[i] = 0u;
        if (loader) {
            ScanLd L0, L1;
#define SCAN_ZERO(L_) do { _Pragma("unroll") for (int i = 0; i < 4; ++i) { L_.w[i] = make_uint4(0u, 0u, 0u, 0u); L_.k[i] = make_uint4(0u, 0u, 0u, 0u); L_.q[i] = make_uint4(0u, 0u, 0u, 0u); } \
                L_.a[0] = make_uint4(0u, 0u, 0u, 0u); L_.a[1] = make_uint4(0u, 0u, 0u, 0u); L_.u = make_uint4(0u, 0u, 0u, 0u); L_.sc = 0.f; } while (0)
            SCAN_ZERO(L0); SCAN_ZERO(L1);
#undef SCAN_ZERO
            scan_load(c, L0, 0); scan_store(c, L0, lds); scan_load(c, L1, 1);
            __syncthreads();
#define SCAN_LSTEP(s_, LD_, ST_) do { const int ss_ = (s_); if (ss_ + 2 < NCHUNK) scan_load(c, LD_, ss_ + 2); __syncthreads(); \
                if (ss_ + 1 < NCHUNK) scan_store(c, ST_, lds + ((ss_ + 1) & 1) * SC_BUF); __syncthreads(); } while (0)
#pragma unroll 1
            for (int s = 0; s < NCHUNK; s += 2) {
                SCAN_LSTEP(s, L0, L1); SCAN_LSTEP(s + 1, L1, L0); }
#undef SCAN_LSTEP
        } else {
            f32x4 Sacc[2][2];
#pragma unroll
            for (int j = 0; j < 2; ++j) { Sacc[j][0] = (f32x4){0.f, 0.f, 0.f, 0.f}; Sacc[j][1] = (f32x4){0.f, 0.f, 0.f, 0.f}; }
            __syncthreads();
#pragma unroll 1
            for (int s = 0; s < NCHUNK; ++s) {
                int item, row0; bool ctx; scan_item(c, s, item, ctx, row0); (void)item;
                const unsigned char* bc = lds + (s & 1) * SC_BUF; f32x4 O1[2];
                scan_alpha(c, lds, bc, ctx, O1);
                __syncthreads();
                scan_beta(c, lds, bc, ctx, row0, O1, Sacc, OD);
                __syncthreads();
            }
        }
    }
}

__device__ __forceinline__ void phase_gdn_out(const Params& p) {
    const bf16_t* OFp = (const bf16_t*)(p.ws + OFF_OF); const bf16_t* OBp = (const bf16_t*)(p.ws + OFF_OB); const bf16_t* PZ = (const bf16_t*)(p.ws + OFF_PZ);
    bf16_t* MIX = (bf16_t*)(p.ws + OFF_H); const float* gn = p.in[14];
    const size_t total = (size_t)MLAT * 128, stride = (size_t)gridDim.x * NT;
    size_t e = (size_t)blockIdx.x * NT + otid();
    uint4 ua, ub, uz, na, nb, nz;
    if (e < total) { const size_t row = e >> 7; const int c8 = (int)(e & 127) * 8; ua = *(const uint4*)(OFp + row * 1024 + c8); ub = *(const uint4*)(OBp + row * 1024 + c8); uz = *(const uint4*)(PZ + row * 1024 + c8); }
    for (; e < total; e += stride) {
        const size_t en = e + stride;
        if (en < total) { const size_t row = en >> 7; const int c8 = (int)(en & 127) * 8; na = *(const uint4*)(OFp + row * 1024 + c8); nb = *(const uint4*)(OBp + row * 1024 + c8); nz = *(const uint4*)(PZ + row * 1024 + c8); }
        const size_t row = e >> 7; const int c8 = (int)(e & 127) * 8;
        float a[8], bq[8], z[8];
        unpack8(ua, a); unpack8(ub, bq); unpack8(uz, z);
        float ss = 0.f;
#pragma unroll
        for (int j = 0; j < 8; ++j) { a[j] += bq[j]; ss += a[j] * a[j]; }
        ss += __shfl_xor(ss, 1); ss += __shfl_xor(ss, 2); ss += __shfl_xor(ss, 4); ss += __shfl_xor(ss, 8);
        const float rstd = rsqrtf(ss * (1.0f / 128.0f) + EPSF);
#pragma unroll
        for (int j = 0; j < 8; ++j) a[j] = a[j] * rstd * gn[(c8 & 127) + j] * silu(z[j]);
        *(uint4*)(MIX + row * DM + c8) = pack8(a);
        ua = na; ub = nb; uz = nz;
    }
}

__device__ __forceinline__ void phase_postmix(const Params& p) {
    const int tid_ = otid(), lane = tid_ & 63, wv = __builtin_amdgcn_readfirstlane(tid_ >> 6);
    const float* MOD = (const float*)(p.ws + OFF_MOD); const float* w1 = p.in[7]; const float* w2 = p.in[8];
    const bf16_t* OUT = (const bf16_t*)(p.ws + OFF_OUT); bf16_t* H = (bf16_t*)(p.ws + OFF_H); bf16_t* S1B = (bf16_t*)(p.ws + OFF_S1B);
    const int stride = gridDim.x * 8;
    uint4 ov[4], ovn[4]; float4 xv[8], xvn[8];
    int row = blockIdx.x * 8 + wv;
    if (row < MLAT) {
#pragma unroll
        for (int i = 0; i < 4; ++i) { ov[i] = *(const uint4*)(OUT + (size_t)row * DM + 8 * (lane + 64 * i));
            xv[2 * i] = *(const float4*)(p.in[0] + (size_t)row * DM + 8 * (lane + 64 * i)); xv[2 * i + 1] = *(const float4*)(p.in[0] + (size_t)row * DM + 8 * (lane + 64 * i) + 4); } }
    for (; row < MLAT; row += stride) {
        const int nxt = row + stride;
        if (nxt < MLAT) {
#pragma unroll
            for (int i = 0; i < 4; ++i) { ovn[i] = *(const uint4*)(OUT + (size_t)nxt * DM + 8 * (lane + 64 * i));
                xvn[2 * i] = *(const float4*)(p.in[0] + (size_t)nxt * DM + 8 * (lane + 64 * i)); xvn[2 * i + 1] = *(const float4*)(p.in[0] + (size_t)nxt * DM + 8 * (lane + 64 * i) + 4); } }
        const int b = row >> 13; const float* mb = MOD + b * (6 * DM);
        const float* ga = mb + 2 * DM; const float* shf = mb + 3 * DM; const float* scf = mb + 4 * DM;
        float o[4][8]; float ss = 0.f;
#pragma unroll
        for (int i = 0; i < 4; ++i) { unpack8(ov[i], o[i]);
#pragma unroll
            for (int j = 0; j < 8; ++j) ss += o[i][j] * o[i][j]; }
        ss = wave_sum(ss); const float rstd = rsqrtf(ss * (1.0f / DM) + EPSF);
        float ss2 = 0.f;
#pragma unroll
        for (int i = 0; i < 4; ++i) { const int col = 8 * (lane + 64 * i);
#pragma unroll
            for (int hh = 0; hh < 2; ++hh) { const float4 xq = xv[2 * i + hh], wv4 = *(const float4*)(w1 + col + 4 * hh), gv = *(const float4*)(ga + col + 4 * hh);
                float4 s; s.x = xq.x + gv.x * o[i][4 * hh] * rstd * wv4.x; s.y = xq.y + gv.y * o[i][4 * hh + 1] * rstd * wv4.y; s.z = xq.z + gv.z * o[i][4 * hh + 2] * rstd * wv4.z; s.w = xq.w + gv.w * o[i][4 * hh + 3] * rstd * wv4.w;
                o[i][4 * hh] = s.x; o[i][4 * hh + 1] = s.y; o[i][4 * hh + 2] = s.z; o[i][4 * hh + 3] = s.w;
                ss2 += s.x * s.x + s.y * s.y + s.z * s.z + s.w * s.w; } }
        ss2 = wave_sum(ss2); const float rstd2 = rsqrtf(ss2 * (1.0f / DM) + EPSF);
#pragma unroll
        for (int i = 0; i < 4; ++i) { const int col = 8 * (lane + 64 * i); float f[8];
#pragma unroll
            for (int j = 0; j < 8; ++j) f[j] = o[i][j] * rstd2 * w2[col + j] * (1.f + scf[col + j]) + shf[col + j];
            *(uint4*)(H + (size_t)row * DM + col) = pack8(f); *(uint4*)(S1B + (size_t)row * DM + col) = pack8(o[i]); }
#pragma unroll
        for (int i = 0; i < 4; ++i) { ov[i] = ovn[i]; xv[2 * i] = xvn[2 * i]; xv[2 * i + 1] = xvn[2 * i + 1]; }
    }
}

__device__ __forceinline__ void phase_final(const Params& p) {
    const int tid_ = otid(), lane = tid_ & 63, wv = __builtin_amdgcn_readfirstlane(tid_ >> 6);
    const float* MOD = (const float*)(p.ws + OFF_MOD); const float* w = p.in[9]; const bf16_t* FF = (const bf16_t*)(p.ws + OFF_FF); const bf16_t* S1B = (const bf16_t*)(p.ws + OFF_S1B);
    const int stride = gridDim.x * 8;
    uint4 fv[4], fvn[4], sv[4], svn[4]; float4 pg[4][2]; int b_loaded = -1;
    int row = blockIdx.x * 8 + wv;
    if (row < MLAT) {
#pragma unroll
        for (int i = 0; i < 4; ++i) { fv[i] = *(const uint4*)(FF + (size_t)row * DM + 8 * (lane + 64 * i)); sv[i] = *(const uint4*)(S1B + (size_t)row * DM + 8 * (lane + 64 * i)); } }
    for (; row < MLAT; row += stride) {
        const int nxt = row + stride;
        if (nxt < MLAT) {
#pragma unroll
            for (int i = 0; i < 4; ++i) { fvn[i] = *(const uint4*)(FF + (size_t)nxt * DM + 8 * (lane + 64 * i)); svn[i] = *(const uint4*)(S1B + (size_t)nxt * DM + 8 * (lane + 64 * i)); } }
        const int b = row >> 13;
        if (b != b_loaded) { b_loaded = b; const float* gf = MOD + b * (6 * DM) + 5 * DM;
#pragma unroll
            for (int i = 0; i < 4; ++i)
#pragma unroll
                for (int hh = 0; hh < 2; ++hh) { const int col = 8 * (lane + 64 * i) + 4 * hh; const float4 wv4 = *(const float4*)(w + col), gv = *(const float4*)(gf + col);
                    pg[i][hh] = make_float4(gv.x * wv4.x, gv.y * wv4.y, gv.z * wv4.z, gv.w * wv4.w); } }
        float o[4][8]; float ss = 0.f;
#pragma unroll
        for (int i = 0; i < 4; ++i) { unpack8(fv[i], o[i]);
#pragma unroll
            for (int j = 0; j < 8; ++j) ss += o[i][j] * o[i][j]; }
        ss = wave_sum(ss); const float rstd = rsqrtf(ss * (1.0f / DM) + EPSF);
#pragma unroll
        for (int i = 0; i < 4; ++i) { const int col = 8 * (lane + 64 * i); float s1[8]; unpack8(sv[i], s1);
#pragma unroll
            for (int hh = 0; hh < 2; ++hh) { const float4 gw = pg[i][hh]; float4 s;
                s.x = s1[4 * hh] + gw.x * (o[i][4 * hh] * rstd); s.y = s1[4 * hh + 1] + gw.y * (o[i][4 * hh + 1] * rstd);
                s.z = s1[4 * hh + 2] + gw.z * (o[i][4 * hh + 2] * rstd); s.w = s1[4 * hh + 3] + gw.w * (o[i][4 * hh + 3] * rstd);
                *(float4*)(p.out + (size_t)row * DM + col + 4 * hh) = s; } }
#pragma unroll
        for (int i = 0; i < 4; ++i) { fv[i] = fvn[i]; sv[i] = svn[i]; }
    }
}

#define XB_TMO      128
#define XB_XCNT(j)  (256  + 64 * (j))
#define XB_XSUB(j)  (1280 + 64 * (j))
#define XB_XGEN(j)  (2304 + 64 * (j))
#define XB_TOP      3328
#define XB_TOPGEN   3392
#define XCD_BAR_WORDS 3456
#define XB_SPIN_CAP (1u << 18)
#define LAS __attribute__((address_space(3)))

__device__ __forceinline__ unsigned xb_ld(unsigned* p)              { return __hip_atomic_load(p, __ATOMIC_RELAXED, __HIP_MEMORY_SCOPE_AGENT); }
__device__ __forceinline__ unsigned xb_add(unsigned* p, unsigned v) { return __hip_atomic_fetch_add(p, v, __ATOMIC_RELAXED, __HIP_MEMORY_SCOPE_AGENT); }
__device__ __forceinline__ unsigned xb_xcc_id() { return (unsigned)__builtin_amdgcn_s_getreg((3 << 11) | 20) & 0xFu; }
#define XB_SPIN(cond, bar) do { unsigned _sp = 0; while (cond) { __builtin_amdgcn_s_sleep(1); \
    if ((++_sp & 255u) == 0u) { if (xb_ld(&(bar)[XB_TMO])) break; if (_sp > XB_SPIN_CAP) { atomicAdd(&(bar)[XB_TMO], 1u); break; } } } } while (0)

struct XcdBarrier {
    unsigned* bar; unsigned x;
    volatile LAS unsigned* st;
};

__device__ __forceinline__ XcdBarrier xcd_barrier_post(unsigned* bar, volatile LAS unsigned* st) {
    XcdBarrier b; b.bar = bar; b.x = xb_xcc_id(); b.st = st;
    if (threadIdx.x == 0) (void)xb_add(&bar[XB_XCNT(b.x)], 1u);
    return b;
}
__device__ __forceinline__ void xcd_barrier_complete(unsigned* bar, unsigned x, unsigned& nloc, unsigned& nx) {
    const unsigned G = gridDim.x * gridDim.y * gridDim.z;
    unsigned sum, cnt, mine, sp = 0u;
    for (;;) {
        sum = 0u; cnt = 0u; mine = 0u;
#pragma unroll
        for (unsigned j = 0; j < 16; ++j) { const unsigned c = xb_ld(&bar[XB_XCNT(j)]); sum += c; cnt += (c > 0u) ? 1u : 0u; mine = (j == x) ? c : mine; }
        if (sum == G) break;
        __builtin_amdgcn_s_sleep(1);
        if ((++sp & 255u) == 0u) { if (xb_ld(&bar[XB_TMO])) break; if (sp > XB_SPIN_CAP) { atomicAdd(&bar[XB_TMO], 1u); break; } }
    }
    nloc = mine > 0u ? mine : 1u; nx = cnt > 0u ? cnt : 1u;
}

__device__ __forceinline__ void xcd_barrier(const XcdBarrier& b) {
    asm volatile("s_waitcnt vmcnt(0)" ::: "memory");
    __syncthreads();
    if (threadIdx.x == 0) {
        unsigned* bar = b.bar;
        __builtin_amdgcn_s_waitcnt(0);
        unsigned nloc = b.st[0], nx = b.st[1];
        if (nloc == 0u) { xcd_barrier_complete(bar, b.x, nloc, nx); b.st[0] = nloc; b.st[1] = nx; }
        const unsigned old = xb_add(&bar[XB_XSUB(b.x)], 1u);
        const unsigned gen = old / nloc;
        if (old + 1u == (gen + 1u) * nloc) {
            __builtin_amdgcn_fence(__ATOMIC_RELEASE, "agent");
            asm volatile("s_waitcnt vmcnt(0)" ::: "memory");
            const unsigned og = xb_add(&bar[XB_TOP], 1u);
            const unsigned tg = og / nx;
            if (og + 1u == (tg + 1u) * nx) xb_add(&bar[XB_TOPGEN], 1u);
            else XB_SPIN(xb_ld(&bar[XB_TOPGEN]) == tg, bar);
            __builtin_amdgcn_fence(__ATOMIC_ACQUIRE, "agent");
            xb_add(&bar[XB_XGEN(b.x)], 1u);
            asm volatile("s_waitcnt vmcnt(0)" ::: "memory");
        } else {
            XB_SPIN(xb_ld(&bar[XB_XGEN(b.x)]) == gen, bar);
            __builtin_amdgcn_fence(__ATOMIC_ACQUIRE, "agent");
            asm volatile("s_waitcnt vmcnt(0)" ::: "memory");
        }
    }
    __syncthreads();
}


constexpr int NPHASE = 14;
template <class Epi> __device__ __forceinline__ void run_gemm(unsigned char* lds, const bf16_t* A, const bf16_t* Bt, int M, int N, int K, const Epi& E) {
    pg8::Gemm g{A, Bt, M, N, K}; pg8::StaticOrder S; S.init(M, N, (int)gridDim.x, (int)blockIdx.x);
    pg8::gemm_phase<Epi, pg8::StaticOrder, true, true>((PG8_LAS unsigned char*)lds, g, S, E);
}
__global__ void __launch_bounds__(NT, 2) fwd_kernel(Params p) {
    extern __shared__ __attribute__((aligned(16))) unsigned char lds[];
    cg::grid_group grid = cg::this_grid();
    const int lo = p.ph_lo, hi = p.ph_hi;
    unsigned char* ws = p.ws;
    if (lo < 0) grid.sync();
    if (threadIdx.x == 0) *(uint4*)(lds + LDS_BYTES - 16) = make_uint4(0u, 0u, 0u, 0u);
    __syncthreads();
    XcdBarrier xbar = xcd_barrier_post((unsigned*)(ws + OFF_BAR), (volatile LAS unsigned*)((LAS unsigned char*)lds + (LDS_BYTES - 16)));
#ifndef PH_MASK
#define PH_MASK 0xffff
#endif
#ifndef REP_MASK
#define REP_MASK 0
#endif
#define IN(k) ((((PH_MASK) >> (k)) & 1) && lo <= (k) && (k) < hi)
#define REP(k, stmt) do { if (IN(k)) { const int nrep_ = 1 + ((REP_MASK >> (k)) & 1); _Pragma("unroll 1") for (int rep_ = 0; rep_ < nrep_; ++rep_) { if (rep_) xcd_barrier(xbar); stmt; } } } while (0)
#define SEAM(k) do { if (IN(k) && IN((k) + 1)) xcd_barrier(xbar); } while (0)
    REP(0, phase_prologue(p, lds));
    SEAM(0);
    REP(1, phase_prenorm(p));
    SEAM(1);
    { pg8::EpiProj E{(bf16_t*)(ws + OFF_PGDN), (bf16_t*)(ws + OFF_PZ), (bf16_t*)(ws + OFF_PHY), (float*)(ws + OFF_GATES)};
        REP(2, run_gemm(lds, (const bf16_t*)(ws + OFF_H), (const bf16_t*)(ws + OFF_WIN), MALL, N1, DM, E)); }
    SEAM(2);
#pragma unroll 1
    for (int rep_ = 0; rep_ < 1 + ((REP_MASK >> 3) & 1); ++rep_) {
    if (IN(3)) phase_hy1(p, lds);
    SEAM(3);
    if (IN(4)) phase_hy2(p, lds);
    SEAM(4);
    if (IN(5)) phase_hy3(p, lds);
    SEAM(5);
    }
    REP(6, phase_gdn_prep(p, lds));
    SEAM(6);
    REP(7, phase_gdn_scan(p, lds));
    SEAM(7);
    REP(8, phase_gdn_out(p));
    SEAM(8);
    { pg8::EpiPlain E{(bf16_t*)(ws + OFF_OUT), DM};
        REP(9, run_gemm(lds, (const bf16_t*)(ws + OFF_H), (const bf16_t*)(ws + OFF_WOUT), MLAT, DM, DM, E)); }
    SEAM(9);
    REP(10, phase_postmix(p));
    SEAM(10);
    { pg8::EpiSwiglu E{(bf16_t*)(ws + OFF_ACT), DFF};
        REP(11, run_gemm(lds, (const bf16_t*)(ws + OFF_H), (const bf16_t*)(ws + OFF_WGU), MLAT, 2 * DFF, DM, E)); }
    SEAM(11);
    { pg8::EpiPlain E{(bf16_t*)(ws + OFF_FF), DM};
        REP(12, run_gemm(lds, (const bf16_t*)(ws + OFF_ACT), (const bf16_t*)(ws + OFF_WDOWN), MLAT, DM, DFF, E)); }
    SEAM(12);
    if (IN(13)) phase_final(p);
#undef IN
#undef REP
#undef SEAM
}

extern "C" void kernel_launch(void* const* d_in, const int* in_sizes, int n_in, void* d_out, int out_size, void* d_ws, size_t ws_size, hipStream_t stream) {
    static int grid = 0;
    if (grid == 0) {
        if (n_in != 32 || ws_size < WS_TOTAL) { fprintf(stderr, "kernel_launch: need 32 inputs and %zu bytes of workspace (got %d, %zu)\n", (size_t)WS_TOTAL, n_in, ws_size); grid = -1; return; }
        int dev = 0, cus = 0, per_cu = 0;
        hipGetDevice(&dev); hipDeviceGetAttribute(&cus, hipDeviceAttributeMultiprocessorCount, dev);
        if (hipFuncSetAttribute((const void*)fwd_kernel, hipFuncAttributeMaxDynamicSharedMemorySize, LDS_BYTES) != hipSuccess) { fprintf(stderr, "kernel_launch: hipFuncSetAttribute failed\n"); grid = -1; return; }
        if (hipOccupancyMaxActiveBlocksPerMultiprocessor(&per_cu, (const void*)fwd_kernel, NT, LDS_BYTES) != hipSuccess || per_cu < 1) { fprintf(stderr, "kernel_launch: occupancy query gave %d\n", per_cu); per_cu = 1; }
        (void)hipGetLastError();
        grid = cus * per_cu;
    }
    if (grid < 0) return;
    if (hipMemsetAsync((unsigned char*)d_ws + OFF_BAR, 0, XCD_BAR_WORDS * 4, stream) != hipSuccess) { fprintf(stderr, "kernel_launch: memset of the barrier words failed\n"); return; }
    Params p{};
    for (int i = 0; i < 32; ++i) p.in[i] = (const float*)d_in[i];
    p.out = (float*)d_out; p.ws = (unsigned char*)d_ws;
#if MULTI_LAUNCH
    for (int ph = 0; ph < NPHASE; ++ph) { p.ph_lo = ph; p.ph_hi = ph + 1;
        hipLaunchKernelGGL(fwd_kernel, dim3(grid), dim3(NT), LDS_BYTES, stream, p); }
#else
    p.ph_lo = 0; p.ph_hi = NPHASE;
    void* args[] = {&p};
    hipError_t e = hipLaunchCooperativeKernel((const void*)fwd_kernel, dim3(grid), dim3(NT), args, LDS_BYTES, stream);
    if (e != hipSuccess) fprintf(stderr, "cooperative launch failed: %s (grid %d)\n", hipGetErrorString(e), grid);
#endif
}
```

```cpp
#include <hip/hip_runtime.h>
#include <hip/hip_cooperative_groups.h>
#include <cstdio>
#include <cstdint>
namespace cg = cooperative_groups;

#ifndef MULTI_LAUNCH
#define MULTI_LAUNCH 0
#endif

__device__ __forceinline__ int otid() { int t = threadIdx.x; asm volatile("" : "+v"(t)); return t; }

#undef MULTI_LAUNCH
#define MULTI_LAUNCH 0
#define REP_MASK 0
namespace pg8 {
#define PG8_LAS __attribute__((address_space(3)))
typedef unsigned short bf16_t;
typedef short bf16x8 __attribute__((ext_vector_type(8)));
typedef float f32x4 __attribute__((ext_vector_type(4)));
typedef unsigned u32x4 __attribute__((ext_vector_type(4)));
constexpr int BM = 256, BK = 64, HALF = 128, HTB = HALF * BK * 2  , STAGE_BYTES = 8 * HTB, NXCD = 8, WGM = 8;

__host__ __device__ __forceinline__ int lds_byte(int r, int c) { const int st = (r >> 4) * 2 + (c >> 5), rr = r & 15, cc = c & 31, ob = rr * 64 + cc * 2; return st * 1024 + (ob ^ (((ob >> 9) & 1) << 5)); }
__host__ __device__ __forceinline__ void stage_rc(int b, int& R, int& C) { const int st = b / 1024, sb = b % 1024, swz = sb ^ (((sb >> 9) & 1) << 5); R = (st >> 1) * 16 + swz / 64; C = (st & 1) * 32 + (swz % 64) / 2; }
__host__ __device__ __forceinline__ int perm32(int rho) { const int n = rho >> 4, i = rho & 15; return 8 * (i >> 2) + 4 * n + (i & 3); }

struct Unit { int pm, pn; };
struct Gemm { const bf16_t* A; const bf16_t* Bt; int M, N, K; };

struct StaticOrder {
    int nM, nN, nwg, G, c;
    __host__ __device__ void init(int M, int N, int G_, int c_) { nM = M / BM; nN = N / BM; nwg = nM * nN; G = G_; c = c_; }
    __host__ __device__ bool next(int i, Unit& u) const {
        const long L = (long)i * G + c; if (L >= nwg) return false;
        int wgid = (int)L; { const int q = nwg / NXCD, r = nwg % NXCD, xcd = wgid % NXCD, off = wgid / NXCD; wgid = (xcd < r ? xcd * (q + 1) : r * (q + 1) + (xcd - r) * q) + off; }
        const int nig = WGM * nN, gid = wgid / nig, fm = gid * WGM, gsz = (nM - fm) < WGM ? (nM - fm) : WGM;
        u.pm = fm + ((wgid % nig) % gsz); u.pn = (wgid % nig) / gsz; return true;
    }
    __device__ __forceinline__ void a_ready(const Unit&) const {}
    __device__ __forceinline__ void done(const Unit&) const {}
};

__device__ __forceinline__ unsigned cvt_pk_bf16(float lo, float hi) { unsigned r; asm volatile("v_cvt_pk_bf16_f32 %0, %1, %2" : "=v"(r) : "v"(lo), "v"(hi)); return r; }
__device__ __forceinline__ float silu_f(float x) { return x * __builtin_amdgcn_rcpf(1.0f + __expf(-x)); }

struct EpiPlain {
    static constexpr bool PERM = true, AFTER_DRAIN = false;
    bf16_t* O; int ldc;
    __device__ __forceinline__ void operator()(const f32x4 (&acc)[2][2][4][2], const Unit& u, int wr, int wc, int fr, int fq) const {
        const int row0 = u.pm * BM + wr * 64 + fr, col0 = u.pn * BM + wc * 32 + 8 * fq;
#pragma unroll
        for (int ai = 0; ai < 2; ++ai)
#pragma unroll
            for (int m = 0; m < 4; ++m) { bf16_t* rowp = O + (size_t)(row0 + ai * HALF + m * 16) * ldc + col0;
#pragma unroll
                for (int bj = 0; bj < 2; ++bj) { const f32x4 v0 = acc[ai][bj][m][0], v1 = acc[ai][bj][m][1];
                    u32x4 w; w.x = cvt_pk_bf16(v0[0], v0[1]); w.y = cvt_pk_bf16(v0[2], v0[3]); w.z = cvt_pk_bf16(v1[0], v1[1]); w.w = cvt_pk_bf16(v1[2], v1[3]);
                    *(u32x4*)(rowp + bj * HALF) = w; } }
    }
};
struct EpiProj {
    static constexpr bool PERM = true, AFTER_DRAIN = false;
    bf16_t* pgdn; bf16_t* pz; bf16_t* phy; float* gates;
    __device__ __forceinline__ void operator()(const f32x4 (&acc)[2][2][4][2], const Unit& u, int wr, int wc, int fr, int fq) const {
        const int row0 = u.pm * BM + wr * 64 + fr, pn = u.pn;
        if (pn < 28) {
            bf16_t* base; int ld, colt;
            if (pn < 12) { base = pgdn; ld = 3072; colt = pn * 256; }
            else if (pn < 16) { base = pz; ld = 1024; colt = (pn - 12) * 256; }
            else { base = phy; ld = 3072; colt = (pn - 16) * 256; }
            const int col0 = colt + wc * 32 + 8 * fq;
#pragma unroll
            for (int ai = 0; ai < 2; ++ai)
#pragma unroll
                for (int m = 0; m < 4; ++m) { bf16_t* rowp = base + (size_t)(row0 + ai * HALF + m * 16) * ld + col0;
#pragma unroll
                    for (int bj = 0; bj < 2; ++bj) { const f32x4 v0 = acc[ai][bj][m][0], v1 = acc[ai][bj][m][1];
                        u32x4 w; w.x = cvt_pk_bf16(v0[0], v0[1]); w.y = cvt_pk_bf16(v0[2], v0[3]); w.z = cvt_pk_bf16(v1[0], v1[1]); w.w = cvt_pk_bf16(v1[2], v1[3]);
                        *(u32x4*)(rowp + bj * HALF) = w; } }
        } else if (wc == 0) {
#pragma unroll
            for (int ai = 0; ai < 2; ++ai)
#pragma unroll
                for (int m = 0; m < 4; ++m) { float* rowp = gates + (size_t)(row0 + ai * HALF + m * 16) * 32 + 8 * fq;
                    *(f32x4*)(rowp) = acc[ai][0][m][0]; *(f32x4*)(rowp + 4) = acc[ai][0][m][1]; }
        }
    }
};
struct EpiSwiglu {
    static constexpr bool PERM = true, AFTER_DRAIN = false;
    bf16_t* O; int ldc;
    __device__ __forceinline__ void operator()(const f32x4 (&acc)[2][2][4][2], const Unit& u, int wr, int wc, int fr, int fq) const {
        const int row0 = u.pm * BM + wr * 64 + fr, col0 = u.pn * HALF + wc * 32 + 8 * fq;
#pragma unroll
        for (int ai = 0; ai < 2; ++ai)
#pragma unroll
            for (int m = 0; m < 4; ++m) { bf16_t* rowp = O + (size_t)(row0 + ai * HALF + m * 16) * ldc + col0;
                const f32x4 g0 = acc[ai][0][m][0], g1 = acc[ai][0][m][1], u0 = acc[ai][1][m][0], u1 = acc[ai][1][m][1];
                u32x4 w;
                w.x = cvt_pk_bf16(silu_f(g0[0]) * u0[0], silu_f(g0[1]) * u0[1]); w.y = cvt_pk_bf16(silu_f(g0[2]) * u0[2], silu_f(g0[3]) * u0[3]);
                w.z = cvt_pk_bf16(silu_f(g1[0]) * u1[0], silu_f(g1[1]) * u1[1]); w.w = cvt_pk_bf16(silu_f(g1[2]) * u1[2], silu_f(g1[3]) * u1[3]);
                *(u32x4*)(rowp) = w; }
    }
};

template <class Epi, class Sched, bool ALIGN_EPI = false, bool SP2 = false>
__device__ __forceinline__ void gemm_phase(PG8_LAS unsigned char* lds, const Gemm g, const Sched& S, const Epi& E) {
    const int tid = otid(), wid = __builtin_amdgcn_readfirstlane(tid >> 6), lane = tid & 63, wr = wid >> 2, wc = wid & 3, fr = lane & 15, fq = lane >> 4;
    const int K = g.K, nt = K / BK;
    unsigned voffA[2], voffB[2];
#pragma unroll
    for (int i = 0; i < 2; ++i) { int R, C; stage_rc(tid * 16 + i * 8192, R, C); const int Rb = Epi::PERM ? ((R & ~31) + perm32(R & 31)) : R;
        voffA[i] = (unsigned)(R * K + C) * 2u; voffB[i] = (unsigned)(Rb * K + C) * 2u; }
    const size_t kstep = (size_t)(BK * 2);
    const size_t hstep = (size_t)HALF * K * 2;
    const size_t tstep = 2 * hstep;
    const unsigned ldsw = (unsigned)wid * 1024u;
    const int aoff = lds_byte(wr * 64 + fr, fq * 8), boff = lds_byte(wc * 32 + fr, fq * 8);
#define PG8_SA(b, h) (((b) * 2 + (h)) * HTB)
#define PG8_SB(b, h) ((4 + (b) * 2 + (h)) * HTB)
#define PG8_STAGE(bufoff, gbase, voff) do { _Pragma("unroll") for (int _i = 0; _i < 2; ++_i) \
        __builtin_amdgcn_global_load_lds((const unsigned*)((const char*)(gbase) + (voff)[_i]), (PG8_LAS unsigned*)(lds + (bufoff) + ldsw + _i * 8192), 16, 0, 0); } while (0)
#define PG8_LDA(dst, b, h) do { _Pragma("unroll") for (int m = 0; m < 4; ++m) _Pragma("unroll") for (int k = 0; k < 2; ++k) dst[m][k] = *(const PG8_LAS bf16x8*)(lds + PG8_SA(b, h) + aoff + m * 2048 + k * 1024); } while (0)
#define PG8_LDB(dst, b, h) do { _Pragma("unroll") for (int n = 0; n < 2; ++n) _Pragma("unroll") for (int k = 0; k < 2; ++k) dst[n][k] = *(const PG8_LAS bf16x8*)(lds + PG8_SB(b, h) + boff + n * 2048 + k * 1024); } while (0)
#define PG8_MMA(ai, bj, At, Bt) do { __builtin_amdgcn_s_setprio(1); _Pragma("unroll") for (int m = 0; m < 4; ++m) _Pragma("unroll") for (int n = 0; n < 2; ++n) _Pragma("unroll") for (int k = 0; k < 2; ++k) \
        acc[ai][bj][m][n] = __builtin_amdgcn_mfma_f32_16x16x32_bf16(Bt[n][k], At[m][k], acc[ai][bj][m][n], 0, 0, 0); __builtin_amdgcn_s_setprio(0); } while (0)
#define PG8_WAIT_V(n) asm volatile("s_waitcnt vmcnt(" #n ")" ::: "memory")
#define PG8_WAIT_L(n) asm volatile("s_waitcnt lgkmcnt(" #n ")" ::: "memory")
#define PG8_BAR __builtin_amdgcn_s_barrier()
#define PG8_SCHED __builtin_amdgcn_sched_barrier(0)
    Unit cur, nxt; int ui = 0;
    if (!S.next(0, cur)) return;
    f32x4 acc[2][2][4][2];
#pragma unroll
    for (int a = 0; a < 2; ++a)
#pragma unroll
        for (int b = 0; b < 2; ++b)
#pragma unroll
            for (int m = 0; m < 4; ++m)
#pragma unroll
                for (int n = 0; n < 2; ++n) acc[a][b][m][n] = (f32x4){0.f, 0.f, 0.f, 0.f};
    bf16x8 At[4][2], B0[2][2], B1[2][2];
    const char* cA = (const char*)g.A + (size_t)cur.pm * tstep; const char* cB = (const char*)g.Bt + (size_t)cur.pn * tstep;
    S.a_ready(cur);
    if constexpr (SP2) {
        PG8_STAGE(PG8_SB(0, 0), cB, voffB); PG8_STAGE(PG8_SB(0, 1), cB + hstep, voffB); PG8_STAGE(PG8_SA(0, 0), cA, voffA); PG8_STAGE(PG8_SA(0, 1), cA + hstep, voffA);
        if (wr == 1) PG8_BAR;
        PG8_WAIT_V(2); PG8_BAR;
        PG8_STAGE(PG8_SB(1, 0), cB + kstep, voffB); PG8_STAGE(PG8_SA(1, 0), cA + kstep, voffA); PG8_STAGE(PG8_SB(1, 1), cB + hstep + kstep, voffB);
        PG8_WAIT_V(6); PG8_BAR;
    } else {
        PG8_STAGE(PG8_SB(0, 0), cB, voffB); PG8_STAGE(PG8_SA(0, 0), cA, voffA); PG8_STAGE(PG8_SB(0, 1), cB + hstep, voffB); PG8_STAGE(PG8_SA(0, 1), cA + hstep, voffA);
        if (wr == 1) PG8_BAR;
        PG8_WAIT_V(4); PG8_BAR;
        PG8_STAGE(PG8_SB(1, 0), cB + kstep, voffB); PG8_STAGE(PG8_SA(1, 0), cA + kstep, voffA); PG8_STAGE(PG8_SB(1, 1), cB + hstep + kstep, voffB);
        PG8_WAIT_V(6); PG8_BAR;
    }
    for (;;) {
        const bool has_next = S.next(ui + 1, nxt);
        const char* nA = has_next ? (const char*)g.A + (size_t)nxt.pm * tstep : cA; const char* nB = has_next ? (const char*)g.Bt + (size_t)nxt.pn * tstep : cB;
        for (int t = 0; t < nt; t += 2) {
            const bool last = (t == nt - 2);
            const char* a1 = cA + (size_t)(t + 1) * kstep;
            const char* a2 = last ? nA : cA + (size_t)(t + 2) * kstep; const char* b2 = last ? nB : cB + (size_t)(t + 2) * kstep;
            const char* a3 = a2 + kstep; const char* b3 = b2 + kstep;
            if (last && has_next) S.a_ready(nxt);
            if constexpr (SP2) {
            PG8_LDB(B0, 0, 0); PG8_LDB(B1, 0, 1); PG8_SCHED; PG8_LDA(At, 0, 0); PG8_STAGE(PG8_SA(1, 1), a1 + hstep, voffA);
            PG8_WAIT_V(8); PG8_WAIT_L(0); PG8_BAR; PG8_MMA(0, 0, At, B0); PG8_MMA(0, 1, At, B1); PG8_BAR; PG8_SCHED;
            PG8_LDA(At, 0, 1); PG8_STAGE(PG8_SB(0, 0), b2, voffB); PG8_STAGE(PG8_SB(0, 1), b2 + hstep, voffB); PG8_STAGE(PG8_SA(0, 0), a2, voffA);
            PG8_WAIT_V(8); PG8_WAIT_L(0); PG8_BAR; PG8_MMA(1, 0, At, B0); PG8_MMA(1, 1, At, B1); PG8_BAR; PG8_SCHED;
            PG8_LDB(B0, 1, 0); PG8_LDB(B1, 1, 1); PG8_SCHED; PG8_LDA(At, 1, 0); PG8_STAGE(PG8_SA(0, 1), a2 + hstep, voffA);
            PG8_WAIT_V(8); PG8_WAIT_L(0); PG8_BAR; PG8_MMA(0, 0, At, B0); PG8_MMA(0, 1, At, B1); PG8_BAR; PG8_SCHED;
            PG8_LDA(At, 1, 1); PG8_STAGE(PG8_SB(1, 0), b3, voffB); PG8_STAGE(PG8_SB(1, 1), b3 + hstep, voffB); PG8_STAGE(PG8_SA(1, 0), a3, voffA);
            PG8_WAIT_V(8); PG8_WAIT_L(0); PG8_BAR; PG8_MMA(1, 0, At, B0); PG8_MMA(1, 1, At, B1); PG8_BAR; PG8_SCHED;
            } else {
            PG8_LDB(B0, 0, 0); PG8_SCHED; PG8_LDA(At, 0, 0); PG8_STAGE(PG8_SA(1, 1), a1 + hstep, voffA);
            PG8_WAIT_L(8); PG8_BAR; PG8_WAIT_L(0); PG8_MMA(0, 0, At, B0); PG8_BAR; PG8_SCHED;
            PG8_LDB(B1, 0, 1); PG8_STAGE(PG8_SB(0, 0), b2, voffB);
            PG8_BAR; PG8_WAIT_L(0); PG8_MMA(0, 1, At, B1); PG8_BAR;
            PG8_LDA(At, 0, 1); PG8_STAGE(PG8_SA(0, 0), a2, voffA);
            PG8_BAR; PG8_WAIT_L(0); PG8_MMA(1, 0, At, B0); PG8_BAR; PG8_SCHED;
            PG8_STAGE(PG8_SB(0, 1), b2 + hstep, voffB);
            PG8_WAIT_V(6); PG8_BAR; PG8_MMA(1, 1, At, B1); PG8_BAR;
            PG8_LDB(B0, 1, 0); PG8_SCHED; PG8_LDA(At, 1, 0); PG8_STAGE(PG8_SA(0, 1), a2 + hstep, voffA);
            PG8_WAIT_L(8); PG8_BAR; PG8_WAIT_L(0); PG8_MMA(0, 0, At, B0); PG8_BAR; PG8_SCHED;
            PG8_LDB(B1, 1, 1); PG8_STAGE(PG8_SB(1, 0), b3, voffB);
            PG8_BAR; PG8_WAIT_L(0); PG8_MMA(0, 1, At, B1); PG8_BAR;
            PG8_LDA(At, 1, 1); PG8_STAGE(PG8_SA(1, 0), a3, voffA);
            PG8_BAR; PG8_WAIT_L(0); PG8_MMA(1, 0, At, B0); PG8_BAR; PG8_SCHED;
            PG8_STAGE(PG8_SB(1, 1), b3 + hstep, voffB);
            PG8_WAIT_V(6); PG8_BAR; PG8_MMA(1, 1, At, B1); PG8_BAR;
            }
        }
        if constexpr (ALIGN_EPI) { if (wr == 0) PG8_BAR; }
        if constexpr (!Epi::AFTER_DRAIN) { E(acc, cur, wr, wc, fr, fq); S.done(cur); }
        if (!has_next) break;
#pragma unroll
        for (int a = 0; a < 2; ++a)
#pragma unroll
            for (int b = 0; b < 2; ++b)
#pragma unroll
                for (int m = 0; m < 4; ++m)
#pragma unroll
                    for (int n = 0; n < 2; ++n) acc[a][b][m][n] = (f32x4){0.f, 0.f, 0.f, 0.f};
        cur = nxt; cA = nA; cB = nB; ++ui;
        if constexpr (ALIGN_EPI) { if (wr == 1) PG8_BAR; }
    }
    PG8_WAIT_V(0);
    if constexpr (!ALIGN_EPI) { if (wr == 0) PG8_BAR; }
    PG8_BAR;
    if constexpr (Epi::AFTER_DRAIN) { E.fused(acc, cur, wr, wc, fr, fq, lds, wid, lane); S.done(cur); }
#undef PG8_SA
#undef PG8_SB
#undef PG8_STAGE
#undef PG8_LDA
#undef PG8_LDB
#undef PG8_MMA
#undef PG8_WAIT_V
#undef PG8_WAIT_L
#undef PG8_BAR
#undef PG8_SCHED
}
}

typedef unsigned short bf16_t;
typedef short bf16x8 __attribute__((ext_vector_type(8)));
typedef float f32x4 __attribute__((ext_vector_type(4)));
constexpr int NT = 512;
constexpr int DM = 2048, NB = 4, SL = 8192, CL = 256, MLAT = NB * SL, MCTX = NB * CL, MALL = MLAT + MCTX;
constexpr int NHD = 8, HD = 128, CHK = 64, DFF = 5632, N1 = 7424;
constexpr int NCHUNK = 132;
constexpr int NITEM = NB * NCHUNK * NHD;
constexpr float EPSF = 1e-6f;
constexpr int LDS_BYTES = 156 * 1024;

constexpr size_t al256(size_t x) { return (x + 255) & ~(size_t)255; }
constexpr size_t OFF_MOD = 0;
constexpr size_t OFF_GSC = OFF_MOD + al256((size_t)5 * 6 * DM * 4);
constexpr size_t OFF_GATES = OFF_GSC + al256((size_t)NITEM * 2 * 192 * 4);
constexpr size_t OFF_WIN = OFF_GATES + al256((size_t)MALL * 32 * 4);
constexpr size_t OFF_WOUT = OFF_WIN + al256((size_t)N1 * DM * 2);
constexpr size_t OFF_WGU = OFF_WOUT + al256((size_t)DM * DM * 2);
constexpr size_t OFF_WDOWN = OFF_WGU + al256((size_t)2 * DFF * DM * 2);
constexpr size_t OFF_H = OFF_WDOWN + al256((size_t)DM * DFF * 2);
constexpr size_t OFF_PGDN = OFF_H + al256((size_t)MALL * DM * 2);
constexpr size_t OFF_PZ = OFF_PGDN + al256((size_t)MALL * 3072 * 2);
constexpr size_t OFF_PHY = OFF_PZ + al256((size_t)MALL * 1024 * 2);
constexpr size_t OFF_UHT = OFF_PHY + al256((size_t)MALL * 3072 * 2);
constexpr size_t OFF_TAPS = OFF_UHT + al256((size_t)NB * 1024 * SL * 4);
constexpr size_t END_TAPS = OFF_TAPS + al256((size_t)1024 * 16384 * 4);
constexpr size_t OFF_KSPEC = END_TAPS;
constexpr size_t OFF_KT = OFF_PHY;
constexpr size_t OFF_Q = OFF_KT + (size_t)NITEM * 16384;
constexpr size_t OFF_UW = OFF_Q + (size_t)NITEM * 16384;
constexpr size_t OFF_ATT = OFF_UW + (size_t)NITEM * 2 * 32768;
constexpr size_t END_G2 = OFF_ATT + (size_t)NITEM * 2 * 8192;
constexpr size_t WS_END = END_G2 > END_TAPS ? END_G2 : END_TAPS;
constexpr size_t OFF_S1B = OFF_UHT;
constexpr size_t OFF_OF = OFF_PGDN;
constexpr size_t OFF_OB = OFF_PGDN + (size_t)MLAT * 1024 * 2;
constexpr size_t OFF_OUT = OFF_PGDN;
constexpr size_t OFF_ACT = OFF_PGDN;
constexpr size_t OFF_FF = OFF_H;
static_assert((size_t)MLAT * DFF * 2 <= OFF_UHT - OFF_PGDN, "act overlay");
constexpr size_t OFF_BAR = al256(WS_END);
constexpr size_t WS_TOTAL = OFF_BAR + 16384;
static_assert(WS_TOTAL <= ((size_t)1 << 30), "workspace over 1 GiB");

struct Params { const float* in[32]; float* out; unsigned char* ws; int ph_lo, ph_hi; };

__device__ __forceinline__ float bf_lo(unsigned w) { return __uint_as_float(w << 16); }
__device__ __forceinline__ float bf_hi(unsigned w) { return __uint_as_float(w & 0xffff0000u); }
__device__ __forceinline__ float bf2f(bf16_t v) { return __uint_as_float(((unsigned)v) << 16); }
__device__ __forceinline__ unsigned pk2(float lo, float hi) { return pg8::cvt_pk_bf16(lo, hi); }
__device__ __forceinline__ unsigned pk2_c(float lo, float hi) { unsigned a = __float_as_uint(lo), b = __float_as_uint(hi);
    a += 0x7fffu + ((a >> 16) & 1u); b += 0x7fffu + ((b >> 16) & 1u); return (a >> 16) | (b & 0xffff0000u); }
__device__ __forceinline__ bf16_t f2bf(float f) { return (bf16_t)(pk2(f, 0.f) & 0xffffu); }
__device__ __forceinline__ float silu(float x) { return x * __builtin_amdgcn_rcpf(1.0f + __expf(-x)); }
__device__ __forceinline__ void unpack8(const uint4 w, float (&f)[8]) {
    f[0] = bf_lo(w.x); f[1] = bf_hi(w.x); f[2] = bf_lo(w.y); f[3] = bf_hi(w.y); f[4] = bf_lo(w.z); f[5] = bf_hi(w.z); f[6] = bf_lo(w.w); f[7] = bf_hi(w.w);
}
__device__ __forceinline__ uint4 pack8(const float (&f)[8]) { uint4 w; w.x = pk2(f[0], f[1]); w.y = pk2(f[2], f[3]); w.z = pk2(f[4], f[5]); w.w = pk2(f[6], f[7]); return w; }
__device__ __forceinline__ float fsin(float x) { return __builtin_amdgcn_sinf(__builtin_amdgcn_fractf(x * 0.15915494309189535f)); }
__device__ __forceinline__ float wave_sum(float v) {
#pragma unroll
    for (int o = 32; o >= 1; o >>= 1) v += __shfl_xor(v, o);
    return v;
}

__device__ __forceinline__ void adaln_block(const Params& p, unsigned char* lds, int cb) {
    float* sc = (float*)lds;
    float* red = (float*)(lds + 5 * DM * 4);
    const int tid = otid();
    const float* c = p.in[1]; const float* cc = p.in[3]; const float* wm = p.in[4]; const float* bm = p.in[5];
    for (int i = tid; i < 5 * DM; i += NT) { const int r = i / DM, k = i % DM; const float v = r < 4 ? c[r * DM + k] : cc[k]; sc[i] = silu(v); }
    __syncthreads();
    const int l4 = tid % 12, kg = tid / 12;
    if (tid < 504) {
        float acc[5][4];
#pragma unroll
        for (int r = 0; r < 5; ++r)
#pragma unroll
            for (int j = 0; j < 4; ++j) acc[r][j] = 0.f;
#pragma unroll 7
        for (int k = kg; k < DM; k += 42) {
            const float4 w = *(const float4*)(wm + (size_t)k * (6 * DM) + cb * 48 + l4 * 4);
#pragma unroll
            for (int r = 0; r < 5; ++r) { const float s = sc[r * DM + k]; acc[r][0] += s * w.x; acc[r][1] += s * w.y; acc[r][2] += s * w.z; acc[r][3] += s * w.w; }
        }
#pragma unroll
        for (int r = 0; r < 5; ++r)
#pragma unroll
            for (int j = 0; j < 4; ++j) red[(kg * 5 + r) * 48 + l4 * 4 + j] = acc[r][j];
    }
    __syncthreads();
    if (tid < 240) {
        const int r = tid / 48, col = tid % 48; float s = 0.f;
        for (int g = 0; g < 42; ++g) s += red[(g * 5 + r) * 48 + col];
        float* MOD = (float*)(p.ws + OFF_MOD);
        MOD[r * (6 * DM) + cb * 48 + col] = s + bm[cb * 48 + col];
    }
    __syncthreads();
}

__device__ __forceinline__ void taps_block(const Params& p, unsigned char* lds, int tile) {
    float* zs = (float*)lds;
    float* h1 = zs + 32 * 33;
    float* h2 = h1 + 32 * 65;
    float* h3 = h2 + 32 * 65;
    float* w4s = (float*)(lds + 32768);
    const int tid = otid(), t0 = tile * 32;
    const float* w1 = p.in[17]; const float* b1 = p.in[18]; const float* f1 = p.in[19];
    const float* w2 = p.in[20]; const float* b2 = p.in[21]; const float* f2 = p.in[22];
    const float* w3 = p.in[23]; const float* b3 = p.in[24]; const float* f3 = p.in[25];
    const float* w4 = p.in[26]; const float* hb = p.in[27];
    float* ws1 = w4s; float* ws2 = w4s + 2112; float* ws3 = ws2 + 4096;
    for (int i = tid; i < 2112 / 4; i += NT) *(float4*)(ws1 + 4 * i) = *(const float4*)(w1 + 4 * i);
    for (int i = tid; i < 1024; i += NT) { *(float4*)(ws2 + 4 * i) = *(const float4*)(w2 + 4 * i); *(float4*)(ws3 + 4 * i) = *(const float4*)(w3 + 4 * i); }
    for (int i = tid; i < 32 * 33; i += NT) {
        const int r = i / 33, f = i % 33; const float t = (float)(t0 + r);
        float v;
        if (f == 0) v = t / 8191.0f;
        else { const int bi = (f - 1) & 15; const float fr = 1e-4f + (float)bi * ((15.0f - 1e-4f) / 15.0f); const float rev = t * fr * (1.0f / 8192.0f);
            v = (f <= 16) ? __builtin_amdgcn_cosf(__builtin_amdgcn_fractf(rev)) : -__builtin_amdgcn_sinf(__builtin_amdgcn_fractf(rev)); }
        zs[i] = v;
    }
    __syncthreads();
    const int row = tid & 31, ug = tid >> 5;
    {   float a[4] = {0.f, 0.f, 0.f, 0.f};
#pragma unroll 3
        for (int k = 0; k < 33; ++k) { const float z = zs[row * 33 + k]; const float4 w = *(const float4*)(ws1 + k * 64 + ug * 4); a[0] += z * w.x; a[1] += z * w.y; a[2] += z * w.z; a[3] += z * w.w; }
#pragma unroll
        for (int j = 0; j < 4; ++j) h1[row * 65 + ug * 4 + j] = fsin(f1[ug * 4 + j] * (a[j] + b1[ug * 4 + j]));
    }
    __syncthreads();
    {   float a[4] = {0.f, 0.f, 0.f, 0.f};
#pragma unroll 4
        for (int k = 0; k < 64; ++k) { const float z = h1[row * 65 + k]; const float4 w = *(const float4*)(ws2 + k * 64 + ug * 4); a[0] += z * w.x; a[1] += z * w.y; a[2] += z * w.z; a[3] += z * w.w; }
#pragma unroll
        for (int j = 0; j < 4; ++j) h2[row * 65 + ug * 4 + j] = fsin(f2[ug * 4 + j] * (a[j] + b2[ug * 4 + j]));
    }
    __syncthreads();
    {   float a[4] = {0.f, 0.f, 0.f, 0.f};
#pragma unroll 4
        for (int k = 0; k < 64; ++k) { const float z = h2[row * 65 + k]; const float4 w = *(const float4*)(ws3 + k * 64 + ug * 4); a[0] += z * w.x; a[1] += z * w.y; a[2] += z * w.z; a[3] += z * w.w; }
#pragma unroll
        for (int j = 0; j < 4; ++j) h3[row * 65 + ug * 4 + j] = fsin(f3[ug * 4 + j] * (a[j] + b3[ug * 4 + j]));
    }
    __syncthreads();
    bf16_t* Ah = (bf16_t*)(lds + 98304); bf16_t* Al = Ah + 32 * 72;
    {   float hv[4]; unsigned short hh[4], hl[4];
#pragma unroll
        for (int j = 0; j < 4; ++j) { hv[j] = h3[row * 65 + ug * 4 + j]; const unsigned u = pk2_c(hv[j], 0.f) & 0xffffu; hh[j] = (unsigned short)u; hl[j] = (unsigned short)(pk2_c(hv[j] - __uint_as_float(u << 16), 0.f) & 0xffffu); }
        uint2 wh, wl; wh.x = hh[0] | ((unsigned)hh[1] << 16); wh.y = hh[2] | ((unsigned)hh[3] << 16); wl.x = hl[0] | ((unsigned)hl[1] << 16); wl.y = hl[2] | ((unsigned)hl[3] << 16);
        *(uint2*)(Ah + row * 72 + ug * 4) = wh; *(uint2*)(Al + row * 72 + ug * 4) = wl; }
    float* TAPS = (float*)(p.ws + OFF_TAPS);
    const float mind = -3.0701134573253946f, maxd = -15.350567286626973f;
    const int lane = tid & 63, wid = __builtin_amdgcn_readfirstlane(tid >> 6), fr = lane & 15, fq = lane >> 4;
    for (int cc = 0; cc < 8; ++cc) {
        for (int i = tid; i < 64 * 64; i += NT) { const int k = i >> 6, c4 = (i & 63) * 4; *(float4*)(w4s + k * 256 + c4) = *(const float4*)(w4 + (size_t)k * 2048 + cc * 256 + c4); }
        __syncthreads();
#pragma unroll 1
        for (int nn = 0; nn < 2; ++nn) {
            const int nt = wid * 2 + nn;
            f32x4 acc[2]; acc[0] = (f32x4){0.f, 0.f, 0.f, 0.f}; acc[1] = (f32x4){0.f, 0.f, 0.f, 0.f};
#pragma unroll
            for (int ks = 0; ks < 2; ++ks) {
                bf16x8 bh, bl;
#pragma unroll
                for (int e = 0; e < 8; ++e) { const float x = w4s[(32 * ks + 8 * fq + e) * 256 + 16 * nt + fr]; const unsigned u = pk2_c(x, 0.f) & 0xffffu;
                    bh[e] = (short)u; bl[e] = (short)(pk2_c(x - __uint_as_float(u << 16), 0.f) & 0xffffu); }
#pragma unroll
                for (int mt = 0; mt < 2; ++mt) {
                    const bf16x8 ah = *(const bf16x8*)(Ah + (16 * mt + fr) * 72 + 32 * ks + 8 * fq), al = *(const bf16x8*)(Al + (16 * mt + fr) * 72 + 32 * ks + 8 * fq);
                    acc[mt] = __builtin_amdgcn_mfma_f32_16x16x32_bf16(ah, bh, acc[mt], 0, 0, 0);
                    acc[mt] = __builtin_amdgcn_mfma_f32_16x16x32_bf16(ah, bl, acc[mt], 0, 0, 0);
                    acc[mt] = __builtin_amdgcn_mfma_f32_16x16x32_bf16(al, bh, acc[mt], 0, 0, 0);
                }
            }
            const int c2 = cc * 256 + 16 * nt + fr, c = c2 & 1023;
            const float delta = fabsf(mind + (float)c * ((maxd - mind) / 1023.0f));
#pragma unroll
            for (int mt = 0; mt < 2; ++mt)
#pragma unroll
                for (int r = 0; r < 4; ++r) {
                    const int t = t0 + 16 * mt + 4 * fq + r; const float t01 = (float)t / 8191.0f;
                    float v = acc[mt][r] * __expf(-t01 * delta);
                    if (c2 < 1024) { if (t == 0) v += hb[c]; TAPS[(size_t)c * 16384 + t] = v; }
                    else { if (t == 0) TAPS[(size_t)c * 16384 + 8192] = 0.f; else TAPS[(size_t)c * 16384 + 16384 - t] = v; }
                }
        }
        __syncthreads();
    }
}

struct TDesc { const float* src; bf16_t* dst; int srcN, scol, K, kt, nt; };
__device__ __forceinline__ void transpose_decode(const Params& p, int idx, int tid, TDesc& d) {
    int mode, nK;
    if (idx < 928) { mode = 0; nK = 8; } else if (idx < 1184) { mode = 1; nK = 8; idx -= 928; } else if (idx < 2592) { mode = 2; nK = 8; idx -= 1184; } else { mode = 3; nK = 22; idx -= 2592; }
    d.kt = idx % nK; d.nt = idx / nK; d.K = (mode == 3) ? DFF : DM;
    d.dst = (bf16_t*)(p.ws + (mode == 0 ? OFF_WIN : mode == 1 ? OFF_WOUT : mode == 2 ? OFF_WGU : OFF_WDOWN));
    const int nc = (tid & 15) * 4, n = d.nt * 64 + nc;
    if (mode == 0) { d.src = p.in[10]; d.srcN = 7200; d.scol = (n < 3072) ? n : (n < 7168) ? n + 32 : (n < 7200) ? n - 4096 : -1; }
    else if (mode == 1) { d.src = p.in[28]; d.srcN = DM; d.scol = n; }
    else if (mode == 2) { const int pn = n >> 8, w = n & 255; d.src = (w < 128) ? p.in[29] : p.in[30]; d.srcN = DFF; d.scol = pn * 128 + (w & 127); }
    else { d.src = p.in[31]; d.srcN = DM; d.scol = n; }
}
__device__ __forceinline__ void transpose_load(const TDesc& d, int tid, float4 (&v)[8]) {
    const int kr = tid >> 4;
#pragma unroll
    for (int it = 0; it < 8; ++it) { v[it] = make_float4(0.f, 0.f, 0.f, 0.f); if (d.scol >= 0) v[it] = *(const float4*)(d.src + (size_t)(d.kt * 256 + kr + it * 32) * d.srcN + d.scol); }
}
__device__ __forceinline__ void transpose_store(const TDesc& d, int tid, const float4 (&v)[8], float* tile  ) {
    const int kr = tid >> 4, nc = (tid & 15) * 4;
#pragma unroll
    for (int it = 0; it < 8; ++it) { float* tp = tile + (kr + it * 32) * 65 + nc; tp[0] = v[it].x; tp[1] = v[it].y; tp[2] = v[it].z; tp[3] = v[it].w; }
    __syncthreads();
    {   const int nn = tid >> 3, k8 = (tid & 7) * 8;
#pragma unroll
        for (int w = 0; w < 4; ++w) { float f[8];
#pragma unroll
            for (int j = 0; j < 8; ++j) f[j] = tile[(k8 + 64 * w + j) * 65 + nn];
            *(uint4*)(d.dst + (size_t)(d.nt * 64 + nn) * d.K + d.kt * 256 + k8 + 64 * w) = pack8(f); }
    }
    __syncthreads();
}

__device__ __forceinline__ void phase_prologue(const Params& p, unsigned char* lds) {
    const int G = gridDim.x, bx = blockIdx.x;
#ifndef P0_MASK
#define P0_MASK 7
#endif
    if (P0_MASK & 1) for (int cb = bx; cb < 256; cb += G) adaln_block(p, lds, cb);
    if (P0_MASK & 2) for (int t = bx; t < 256; t += G) taps_block(p, lds, t);
    if (P0_MASK & 4) {
        const int tid = otid(); float4 v[8], vn[8]; TDesc d, dn; int i = bx;
        if (i < 3296) { transpose_decode(p, i, tid, d); transpose_load(d, tid, v); }
        for (; i < 3296; i += G) {
            if (i + G < 3296) { transpose_decode(p, i + G, tid, dn); transpose_load(dn, tid, vn); }
            transpose_store(d, tid, v, (float*)lds);
            d = dn;
#pragma unroll
            for (int it = 0; it < 8; ++it) v[it] = vn[it];
        }
    }
}

__device__ __forceinline__ void phase_prenorm(const Params& p) {
    const int tid_ = otid(), lane = tid_ & 63, wv = __builtin_amdgcn_readfirstlane(tid_ >> 6);
    const float* MOD = (const float*)(p.ws + OFF_MOD); const float* g = p.in[6];
    bf16_t* H = (bf16_t*)(p.ws + OFF_H);
    const int stride = gridDim.x * 8;
    float4 v[8], vn[8], pa[8], ps[8]; int r_loaded = -1;
#define PRE_SRC(row_) ((row_) < MLAT ? p.in[0] + (size_t)(row_) * DM : p.in[2] + (size_t)((row_) - MLAT) * DM)
    int row = blockIdx.x * 8 + wv;
    if (row < MALL) { const float* src = PRE_SRC(row);
#pragma unroll
        for (int i = 0; i < 8; ++i) v[i] = *(const float4*)(src + 4 * (lane + 64 * i)); }
    for (; row < MALL; row += stride) {
        const int nxt = row + stride;
        if (nxt < MALL) { const float* src = PRE_SRC(nxt);
#pragma unroll
            for (int i = 0; i < 8; ++i) vn[i] = *(const float4*)(src + 4 * (lane + 64 * i)); }
        const int r = row < MLAT ? (row >> 13) : 4;
        if (r != r_loaded) { r_loaded = r;
            const float* sh = MOD + r * (6 * DM); const float* sc = sh + DM;
#pragma unroll
            for (int i = 0; i < 8; ++i) { const int col = 4 * (lane + 64 * i); const float4 gg = *(const float4*)(g + col), s1 = *(const float4*)(sc + col);
                pa[i] = make_float4(gg.x * (1.f + s1.x), gg.y * (1.f + s1.y), gg.z * (1.f + s1.z), gg.w * (1.f + s1.w)); ps[i] = *(const float4*)(sh + col); } }
        float ss = 0.f;
#pragma unroll
        for (int i = 0; i < 8; ++i) ss += v[i].x * v[i].x + v[i].y * v[i].y + v[i].z * v[i].z + v[i].w * v[i].w;
        ss = wave_sum(ss);
        const float rstd = rsqrtf(ss * (1.0f / DM) + EPSF);
#pragma unroll
        for (int i = 0; i < 8; ++i) { const int col = 4 * (lane + 64 * i);
            uint2 w; w.x = pk2(v[i].x * rstd * pa[i].x + ps[i].x, v[i].y * rstd * pa[i].y + ps[i].y);
            w.y = pk2(v[i].z * rstd * pa[i].z + ps[i].z, v[i].w * rstd * pa[i].w + ps[i].w);
            *(uint2*)(H + (size_t)row * DM + col) = w; }
#pragma unroll
        for (int i = 0; i < 8; ++i) v[i] = vn[i];
    }
#undef PRE_SRC
}

__device__ __forceinline__ void phase_hy1(const Params& p, unsigned char* lds) {
    float* tile = (float*)lds;
    const int tid = otid();
    const bf16_t* PHY = (const bf16_t*)(p.ws + OFF_PHY); bf16_t* MIX = (bf16_t*)(p.ws + OFF_H); bf16_t* UHT = (bf16_t*)(p.ws + OFF_UHT);
    const float* cw = p.in[15]; const float* cb = p.in[16];
    const bool g16 = (gridDim.x & 15) == 0;
    const int c8 = (tid & 7) * 8, tr = tid >> 3;
    float wr[3][3][8], br[3][8]; int ct_loaded = -1; uint4 raw[3][3], rawn[3][3];
    for (int k = 0;; ++k) {
        int ct, tt;
        if (g16) { ct = blockIdx.x & 15; tt = (int)(blockIdx.x >> 4) + k * (int)(gridDim.x >> 4); if (tt >= 512) break; }
        else { const int tl = blockIdx.x + k * gridDim.x; if (tl >= 512 * 16) break; ct = tl & 15; tt = tl >> 4; }
        const int c0 = ct * 64, row0 = tt * 64;
        if (ct != ct_loaded) { ct_loaded = ct;
#pragma unroll
            for (int gI = 0; gI < 3; ++gI) { const int col = gI * 1024 + c0 + c8;
#pragma unroll
                for (int j = 0; j < 8; ++j) br[gI][j] = cb[col + j];
#pragma unroll
                for (int i = 0; i < 3; ++i)
#pragma unroll
                    for (int j = 0; j < 8; ++j) wr[gI][i][j] = cw[i * 3072 + col + j]; } }
        const int row = row0 + tr, tpos = row & (SL - 1);
        if (k == 0) {
#pragma unroll
            for (int gI = 0; gI < 3; ++gI)
#pragma unroll
                for (int i = 0; i < 3; ++i) { int tp = tpos + i - 1; tp = tp < 0 ? 0 : (tp >= SL ? SL - 1 : tp);
                    raw[gI][i] = *(const uint4*)(PHY + (size_t)(row - tpos + tp) * 3072 + gI * 1024 + c0 + c8); }
        }
        {
            int ctn, ttn; bool have;
            if (g16) { ctn = ct; ttn = tt + (int)(gridDim.x >> 4); have = ttn < 512; } else { const int tl = blockIdx.x + (k + 1) * gridDim.x; have = tl < 512 * 16; ctn = tl & 15; ttn = tl >> 4; }
            if (have) { const int rown = ttn * 64 + tr, tposn = rown & (SL - 1);
#pragma unroll
                for (int gI = 0; gI < 3; ++gI)
#pragma unroll
                    for (int i = 0; i < 3; ++i) { int tp = tposn + i - 1; tp = tp < 0 ? 0 : (tp >= SL ? SL - 1 : tp);
                        rawn[gI][i] = *(const uint4*)(PHY + (size_t)(rown - tposn + tp) * 3072 + gI * 1024 + ctn * 64 + c8); } }
        }
        float res[3][8];
#pragma unroll
        for (int gI = 0; gI < 3; ++gI) {
            float a[8];
#pragma unroll
            for (int j = 0; j < 8; ++j) a[j] = br[gI][j];
#pragma unroll
            for (int i = 0; i < 3; ++i) {
                const int tp = tpos + i - 1; const float msk = (tp >= 0 && tp < SL) ? 1.0f : 0.0f;
                float f[8]; unpack8(raw[gI][i], f);
#pragma unroll
                for (int j = 0; j < 8; ++j) a[j] += (wr[gI][i][j] * msk) * f[j];
            }
#pragma unroll
            for (int j = 0; j < 8; ++j) res[gI][j] = a[j];
        }
#pragma unroll
        for (int gI = 0; gI < 3; ++gI)
#pragma unroll
            for (int i = 0; i < 3; ++i) raw[gI][i] = rawn[gI][i];
        *(uint4*)(MIX + (size_t)row * DM + 1024 + c0 + c8) = pack8(res[0]);
#pragma unroll
        for (int j = 0; j < 8; ++j) tile[(c8 + j) * 65 + tr] = res[1][j] * res[2][j];
        __syncthreads();
        {   const int c = tid >> 3, t8 = (tid & 7) * 8; const int b = row0 >> 13, tb = (row0 & (SL - 1)) + t8;
            bf16_t* dp = UHT + ((size_t)(b * 1024 + c0 + c)) * SL + tb; float f[8];
#pragma unroll
            for (int j = 0; j < 8; ++j) f[j] = tile[c * 65 + t8 + j];
            *(uint4*)dp = pack8(f); }
        __syncthreads();
    }
}

__device__ __forceinline__ void phase_hy3(const Params& p, unsigned char* lds) {
    float* tile = (float*)lds;
    const int tid = otid();
    bf16_t* MIX = (bf16_t*)(p.ws + OFF_H); const bf16_t* UHT = (const bf16_t*)(p.ws + OFF_UHT);
    const int c = tid >> 3, t8 = (tid & 7) * 8, tr = tid >> 3, c8 = (tid & 7) * 8;
    uint4 uy, um, ny, nm;
#define HY3_LOAD(tl_, y_, m_) do { const int ct_ = (tl_) & 15, tt_ = (tl_) >> 4, c0_ = ct_ * 64, row0_ = tt_ * 64; const int b_ = row0_ >> 13, tb_ = (row0_ & (SL - 1)) + t8; \
        y_ = *(const uint4*)(UHT + ((size_t)(b_ * 1024 + c0_ + c)) * SL + tb_); m_ = *(const uint4*)(MIX + (size_t)(row0_ + tr) * DM + 1024 + c0_ + c8); } while (0)
    int tl = blockIdx.x;
    if (tl < 512 * 16) HY3_LOAD(tl, uy, um);
    for (; tl < 512 * 16; tl += gridDim.x) {
        const int ct = tl & 15, tt = tl >> 4, c0 = ct * 64, row0 = tt * 64;
        if (tl + (int)gridDim.x < 512 * 16) HY3_LOAD(tl + (int)gridDim.x, ny, nm);
        {   float f[8]; unpack8(uy, f); float* tp = tile + c * 65 + t8;
#pragma unroll
            for (int j = 0; j < 8; ++j) tp[j] = f[j]; }
        __syncthreads();
        {   bf16_t* mp = MIX + (size_t)(row0 + tr) * DM + 1024 + c0 + c8;
            float f[8]; unpack8(um, f);
#pragma unroll
            for (int j = 0; j < 8; ++j) f[j] *= tile[(c8 + j) * 65 + tr];
            *(uint4*)mp = pack8(f); }
        __syncthreads();
        uy = ny; um = nm;
    }
#undef HY3_LOAD
}


__device__ __forceinline__ float2 cmul(float2 a, float2 b) { return make_float2(a.x * b.x - a.y * b.y, a.x * b.y + a.y * b.x); }
__device__ __forceinline__ int pidx(int i) { return i + ((i >> 6) << 2); }
template <bool INV> __device__ __forceinline__ float2 mulw16(float2 d, int m) {
    const float C1 = 0.9238795325112867f, S1 = 0.3826834323650898f, C2 = 0.7071067811865476f;
    float c, s;
    switch (m & 7) {
        case 0: return d;
        case 1: c = C1; s = S1; break;
        case 2: c = C2; s = C2; break;
        case 3: c = S1; s = C1; break;
        case 4: return INV ? make_float2(-d.y, d.x) : make_float2(d.y, -d.x);
        case 5: c = -S1; s = C1; break;
        case 6: c = -C2; s = C2; break;
        default: c = -C1; s = S1; break;
    }
    if (!INV) s = -s;
    return make_float2(d.x * c - d.y * s, d.x * s + d.y * c);
}
template <int R> __device__ __forceinline__ constexpr int brev(int q) { int r = 0; for (int b = 1, o = R >> 1; b < R; b <<= 1, o >>= 1) if (q & b) r |= o; return r; }
template <int R, int LOG, int S0 = 0> __device__ __forceinline__ void dft_fwd(float2 (&v)[R]) {
#pragma unroll
    for (int s = S0; s < LOG; ++s) {
        const int h = (R / 2) >> s;
#pragma unroll
        for (int j = 0; j < R; ++j) {
            if (j & h) continue;
            const int m = (j & (h - 1)) * (R / (2 * h)) * (16 / R);
            const float2 a = v[j], b = v[j + h];
            v[j] = make_float2(a.x + b.x, a.y + b.y);
            v[j + h] = mulw16<false>(make_float2(a.x - b.x, a.y - b.y), m);
        }
    }
}
template <int R, int LOG, int S0 = 0> __device__ __forceinline__ void dft_inv(float2 (&v)[R]) {
#pragma unroll
    for (int s = LOG - 1; s >= S0; --s) {
        const int h = (R / 2) >> s;
#pragma unroll
        for (int j = 0; j < R; ++j) {
            if (j & h) continue;
            const int m = (j & (h - 1)) * (R / (2 * h)) * (16 / R);
            const float2 a = v[j], b = mulw16<true>(v[j + h], m);
            v[j] = make_float2(a.x + b.x, a.y + b.y);
            v[j + h] = make_float2(a.x - b.x, a.y - b.y);
        }
    }
}
__device__ __forceinline__ void tw_powers(float2 w1, float2 (&w)[16]) {
    w[1] = w1; w[2] = cmul(w1, w1); w[3] = cmul(w[2], w1); w[4] = cmul(w[2], w[2]); w[5] = cmul(w[4], w1); w[6] = cmul(w[4], w[2]); w[7] = cmul(w[4], w[3]);
    w[8] = cmul(w[4], w[4]);
#pragma unroll
    for (int k = 1; k < 8; ++k) w[8 + k] = cmul(w[8], w[k]);
}
template <int n, bool INV, bool HALF = false, bool TW = false> __device__ __forceinline__ void fft_pass16(float2* X, int tid, const float2 (&wpre)[16]) {
    constexpr int st = n / 16, PST = (st >= 64) ? st + 4 * (st / 64) : st;
#pragma unroll 1
    for (int g = tid; g < 1024; g += NT) {
        int lo = g & (st - 1); asm volatile("" : "+v"(lo));
        const int blk = g / st, base = blk * n + lo;
        float2* Xp = X + pidx(base);
        float2 w[16];
        if (TW) {
#pragma unroll
            for (int k = 1; k < 16; ++k) w[k] = make_float2(wpre[k].x, INV ? -wpre[k].y : wpre[k].y);
        } else {   const float rev = (float)lo * (1.0f / n); const float c = __builtin_amdgcn_cosf(rev), s = __builtin_amdgcn_sinf(rev);
            tw_powers(make_float2(c, INV ? s : -s), w); }
        float2 v[16];
        if (!INV) {
            if (HALF) {
#pragma unroll
                for (int j = 0; j < 8; ++j) { v[j] = Xp[j * PST]; v[j + 8] = mulw16<false>(v[j], j); }
                dft_fwd<16, 4, 1>(v);
            } else {
#pragma unroll
                for (int j = 0; j < 16; ++j) v[j] = Xp[j * PST];
                dft_fwd<16, 4>(v);
            }
#pragma unroll
            for (int q = 1; q < 16; ++q) v[q] = cmul(v[q], w[brev<16>(q)]);
#pragma unroll
            for (int q = 0; q < 16; ++q) Xp[brev<16>(q) * PST] = v[q];
        } else {
#pragma unroll
            for (int q = 0; q < 16; ++q) { const int k = brev<16>(q); float2 t = Xp[k * PST]; if (k) t = cmul(t, w[k]); v[q] = t; }
            if (HALF) {
                dft_inv<16, 4, 1>(v);
#pragma unroll
                for (int j = 0; j < 8; ++j) { const float2 b = mulw16<true>(v[j + 8], j); Xp[j * PST] = make_float2(v[j].x + b.x, v[j].y + b.y); }
            } else {
                dft_inv<16, 4>(v);
#pragma unroll
                for (int j = 0; j < 16; ++j) Xp[j * PST] = v[j];
            }
        }
    }
}
__device__ __forceinline__ void phase_hy2(const Params& p, unsigned char* lds) {
    float2* X = (float2*)lds;
    const int tid = otid();
    const float* TAPS = (const float*)(p.ws + OFF_TAPS); bf16_t* UHT = (bf16_t*)(p.ws + OFF_UHT);
    float2 w64[16];
    {   const float r64 = (float)(tid & 3) * (1.0f / 64.0f);
        tw_powers(make_float2(__builtin_amdgcn_cosf(r64), -__builtin_amdgcn_sinf(r64)), w64); w64[0] = make_float2(1.f, 0.f); }
    for (int c = blockIdx.x; c < 1024; c += gridDim.x) {
        float4* KS = (float4*)(p.ws + OFF_KSPEC) + (size_t)blockIdx.x * 8192;
#pragma unroll
        for (int i = 0; i < 8; ++i) { const int t = 4 * (tid + NT * i); const float4 v = *(const float4*)(TAPS + (size_t)c * 16384 + t);
            float4* xp = (float4*)(X + pidx(t)); xp[0] = make_float4(v.x, 0.f, v.y, 0.f); xp[1] = make_float4(v.z, 0.f, v.w, 0.f); }
        __syncthreads();
        fft_pass16<16384, false, false, false>(X, tid, w64); __syncthreads();
        fft_pass16<1024, false, false, false>(X, tid, w64); __syncthreads();
        fft_pass16<64, false, false, true>(X, tid, w64); __syncthreads();
#pragma unroll 2
        for (int i = 0; i < 8; ++i) { const float4* xp = (const float4*)(X + pidx(4 * (tid + NT * i))); const float4 a = xp[0], b = xp[1];
            float2 v[4] = {make_float2(a.x, a.y), make_float2(a.z, a.w), make_float2(b.x, b.y), make_float2(b.z, b.w)};
            dft_fwd<4, 2>(v);
            const float sc = 1.0f / 16384.0f;
            KS[2 * (tid + NT * i)] = make_float4(v[0].x * sc, v[0].y * sc, v[1].x * sc, v[1].y * sc); KS[2 * (tid + NT * i) + 1] = make_float4(v[2].x * sc, v[2].y * sc, v[3].x * sc, v[3].y * sc); }
        __syncthreads();
        for (int pr = 0; pr < 2; ++pr) {
            bf16_t* u1 = UHT + ((size_t)((2 * pr) * 1024 + c)) * SL; bf16_t* u2 = UHT + ((size_t)((2 * pr + 1) * 1024 + c)) * SL;
#pragma unroll
            for (int i = 0; i < 4; ++i) { const int t = 4 * (tid + NT * i); const uint2 ua = *(const uint2*)(u1 + t), ub = *(const uint2*)(u2 + t);
                const float4 a = make_float4(bf_lo(ua.x), bf_hi(ua.x), bf_lo(ua.y), bf_hi(ua.y)), b = make_float4(bf_lo(ub.x), bf_hi(ub.x), bf_lo(ub.y), bf_hi(ub.y));
                float4* xp = (float4*)(X + pidx(t)); xp[0] = make_float4(a.x, b.x, a.y, b.y); xp[1] = make_float4(a.z, b.z, a.w, b.w); }
            __syncthreads();
            fft_pass16<16384, false, true, false>(X, tid, w64); __syncthreads();
            fft_pass16<1024, false, false, false>(X, tid, w64); __syncthreads();
            fft_pass16<64, false, false, true>(X, tid, w64); __syncthreads();
#pragma unroll 2
            for (int i = 0; i < 8; ++i) { float4* xp = (float4*)(X + pidx(4 * (tid + NT * i))); const float4 a = xp[0], b = xp[1];
                float2 v[4] = {make_float2(a.x, a.y), make_float2(a.z, a.w), make_float2(b.x, b.y), make_float2(b.z, b.w)};
                dft_fwd<4, 2>(v);
                const float4 k0 = KS[2 * (tid + NT * i)], k1 = KS[2 * (tid + NT * i) + 1];
                v[0] = cmul(v[0], make_float2(k0.x, k0.y)); v[1] = cmul(v[1], make_float2(k0.z, k0.w)); v[2] = cmul(v[2], make_float2(k1.x, k1.y)); v[3] = cmul(v[3], make_float2(k1.z, k1.w));
                dft_inv<4, 2>(v);
                xp[0] = make_float4(v[0].x, v[0].y, v[1].x, v[1].y); xp[1] = make_float4(v[2].x, v[2].y, v[3].x, v[3].y); }
            __syncthreads();
            fft_pass16<64, true, false, true>(X, tid, w64); __syncthreads();
            fft_pass16<1024, true, false, false>(X, tid, w64); __syncthreads();
            fft_pass16<16384, true, true, false>(X, tid, w64); __syncthreads();
#pragma unroll
            for (int i = 0; i < 4; ++i) { const int t = 4 * (tid + NT * i); const float4* xp = (const float4*)(X + pidx(t)); const float4 a = xp[0], b = xp[1];
                uint2 w1, w2; w1.x = pk2(a.x, a.z); w1.y = pk2(b.x, b.z); w2.x = pk2(a.y, a.w); w2.y = pk2(b.y, b.w);
                *(uint2*)(u1 + t) = w1; *(uint2*)(u2 + t) = w2; }
            __syncthreads();
        }
    }
}


__device__ __forceinline__ void item_decode(int item, int& b, int& n, int& h, int& row0, int& seq0, int& seqlen) {
    h = item & 7; const int cidx = item >> 3; b = cidx / NCHUNK; n = cidx % NCHUNK;
    if (n < 4) { seq0 = MLAT + b * CL; seqlen = CL; row0 = seq0 + n * CHK; } else { seq0 = b * SL; seqlen = SL; row0 = seq0 + (n - 4) * CHK; }
}
constexpr int G2X_A10 = 0, G2X_T11 = 5120, G2X_T00T = 10240, G2X_XT = 20480, G2X_BYTES = 30720;
template <int D> __device__ __forceinline__ void g2_tinv_diag(const float* As, int lane, const float* rsu, const float* rsw, bf16_t* TM, unsigned char* xl) {
    const int blk = lane >> 5, cc = lane & 31;
    int abase = D * 64 * 68 + blk * (32 * 68 + 32); asm volatile("" : "+v"(abase));
    const float* Ad = As + abase;
    {   const float* ap = As + D * 64 * 68 + cc * 68 + 32 + 16 * blk; bf16_t* a10 = (bf16_t*)(xl + G2X_A10) + D * 32 * 40;
#pragma unroll
        for (int q = 0; q < 4; ++q) { const float4 v = *(const float4*)(ap + 4 * q);
            a10[(16 * blk + 4 * q + 0) * 40 + cc] = f2bf(v.x); a10[(16 * blk + 4 * q + 1) * 40 + cc] = f2bf(v.y); a10[(16 * blk + 4 * q + 2) * 40 + cc] = f2bf(v.z); a10[(16 * blk + 4 * q + 3) * 40 + cc] = f2bf(v.w); } }
    float x[32];
#pragma unroll
    for (int i = 0; i < 32; ++i) x[i] = (i == cc) ? 1.0f : 0.0f;
#pragma clang loop unroll(full)
    for (int j = 0; j < 31; ++j) {
        const float xj = x[j];
        int zj = 0; asm volatile("" : "+v"(zj) : "v"(x[j > 0 ? j - 1 : 0])); zj &= ~3;
#pragma clang loop unroll(full)
        for (int i4 = ((j + 1) & ~3); i4 < 32; i4 += 4) {
            const float4 a = *(const float4*)(Ad + zj + j * 68 + i4);
            if (i4 > j) x[i4] -= a.x * xj;
            if (i4 + 1 > j) x[i4 + 1] -= a.y * xj;
            if (i4 + 2 > j) x[i4 + 2] -= a.z * xj;
            x[i4 + 3] -= a.w * xj;
        }
    }
    const int sj = 32 * blk + cc, jo = D ? 63 - sj : sj;
    const float su = rsu[D * 64 + jo], sw = rsw[D * 64 + jo];
    bf16_t* tu = TM + (D * 2 + 0) * 64 * 72 + jo; bf16_t* tw = TM + (D * 2 + 1) * 64 * 72 + jo;
#pragma unroll
    for (int ii = 0; ii < 32; ++ii) { const int si = 32 * blk + ii, io = D ? 63 - si : si; tu[io * 72] = f2bf(x[ii] * su); tw[io * 72] = f2bf(x[ii] * sw); }
    if (blk == 1) {
        bf16_t* t11 = (bf16_t*)(xl + G2X_T11) + D * 32 * 40 + cc;
#pragma unroll
        for (int ii = 0; ii < 32; ++ii) { const int io = D ? 63 - ii : ii; tu[io * 72] = 0; tw[io * 72] = 0; t11[ii * 40] = f2bf(x[ii]); }
    } else {
        bf16_t* t0u = (bf16_t*)(xl + G2X_T00T) + (D * 2 + 0) * 32 * 40 + cc * 40; bf16_t* t0w = (bf16_t*)(xl + G2X_T00T) + (D * 2 + 1) * 32 * 40 + cc * 40;
#pragma unroll
        for (int q = 0; q < 4; ++q) { uint4 wu, ww;
            wu.x = pk2(x[8 * q] * su, x[8 * q + 1] * su); wu.y = pk2(x[8 * q + 2] * su, x[8 * q + 3] * su); wu.z = pk2(x[8 * q + 4] * su, x[8 * q + 5] * su); wu.w = pk2(x[8 * q + 6] * su, x[8 * q + 7] * su);
            ww.x = pk2(x[8 * q] * sw, x[8 * q + 1] * sw); ww.y = pk2(x[8 * q + 2] * sw, x[8 * q + 3] * sw); ww.z = pk2(x[8 * q + 4] * sw, x[8 * q + 5] * sw); ww.w = pk2(x[8 * q + 6] * sw, x[8 * q + 7] * sw);
            *(uint4*)(t0u + 8 * q) = wu; *(uint4*)(t0w + 8 * q) = ww; }
    }
}
constexpr int G2_KB = 0, G2_QB = 17408, G2_TM = 0  , G2_KT = 36864, G2_VT = 55296, G2_AS = 73728, G2_GT = 108544, G2_XL = 110592;
static_assert(G2_GT + 8 * 64 * 4 <= G2_XL && G2_XL + G2X_BYTES <= LDS_BYTES, "G2 LDS");
__device__ __forceinline__ void phase_gdn_prep(const Params& p, unsigned char* lds) {
    bf16_t* kb = (bf16_t*)(lds + G2_KB); bf16_t* qb = (bf16_t*)(lds + G2_QB); bf16_t* kT = (bf16_t*)(lds + G2_KT); bf16_t* vT = (bf16_t*)(lds + G2_VT);
    float* As = (float*)(lds + G2_AS); bf16_t* TM = (bf16_t*)(lds + G2_TM); float* gt = (float*)(lds + G2_GT); unsigned char* xl = lds + G2_XL;
    float* beta_s = gt; float* gc_s = gt + 128; float* rsu = gt + 256; float* rsw = gt + 384;
    const bf16_t* PG = (const bf16_t*)(p.ws + OFF_PGDN); const float* GATES = (const float*)(p.ws + OFF_GATES);
    const float* cw = p.in[11]; const float* a_log = p.in[12]; const float* dt_bias = p.in[13];
    bf16_t* KT = (bf16_t*)(p.ws + OFF_KT); bf16_t* QO = (bf16_t*)(p.ws + OFF_Q); bf16_t* UW = (bf16_t*)(p.ws + OFF_UW); bf16_t* ATT = (bf16_t*)(p.ws + OFF_ATT);
    float* GSC = (float*)(p.ws + OFF_GSC);
    for (int item = blockIdx.x; item < NITEM; item += gridDim.x) {
        int tid = otid();
        const int lane = tid & 63, wid = __builtin_amdgcn_readfirstlane(tid >> 6), fr = lane & 15, fq = lane >> 4;
        int b, n, h, row0, seq0, seqlen; item_decode(item, b, n, h, row0, seq0, seqlen);
        const bool ctx = n < 4;
        float graw_b = 0.f, graw_a = 0.f;
        if (tid < 128) { const int d = tid >> 6, i = d ? 63 - lane : lane; const float* gp = GATES + (size_t)(row0 + i) * 32; graw_b = gp[d * 8 + h]; graw_a = gp[16 + d * 8 + h]; }
        {   const int r = tid >> 3, c16 = (tid & 7) * 16;
            uint4 raw[3][5][2];
#pragma unroll
            for (int mt = 0; mt < 3; ++mt)
#pragma unroll
                for (int i = 0; i < 5; ++i) { int rr = row0 + r + i - 2; rr = rr < seq0 ? seq0 : (rr >= seq0 + seqlen ? seq0 + seqlen - 1 : rr);
                    const bf16_t* sp = PG + (size_t)rr * 3072 + mt * 1024 + h * 128 + c16; raw[mt][i][0] = *(const uint4*)sp; raw[mt][i][1] = *(const uint4*)(sp + 8); }
#pragma unroll
            for (int mt = 0; mt < 3; ++mt) {
                if (mt == 2 && ctx) break;
                const int col = mt * 1024 + h * 128 + c16;
                float a[16];
#pragma unroll
                for (int j = 0; j < 16; ++j) a[j] = 0.f;
#pragma unroll
                for (int i = 0; i < 5; ++i) {
                    const int rr = row0 + r + i - 2;
                    const float msk = (rr >= seq0 && rr < seq0 + seqlen) ? 1.0f : 0.0f;
                    float f0[8], f1[8]; unpack8(raw[mt][i][0], f0); unpack8(raw[mt][i][1], f1);
                    const float* wp = cw + i * 3072 + col;
#pragma unroll
                    for (int j = 0; j < 8; ++j) { a[j] += (wp[j] * msk) * f0[j]; a[8 + j] += (wp[8 + j] * msk) * f1[j]; }
                }
                float ss = 0.f;
#pragma unroll
                for (int j = 0; j < 16; ++j) { a[j] = silu(a[j]); ss += a[j] * a[j]; }
                if (mt != 1) {
                    ss += __shfl_xor(ss, 1); ss += __shfl_xor(ss, 2); ss += __shfl_xor(ss, 4);
                    const float sc = rsqrtf(ss + EPSF) * (mt == 2 ? 0.08838834764831845f : 1.0f);
#pragma unroll
                    for (int j = 0; j < 16; ++j) a[j] *= sc;
                }
                uint4 w0, w1; w0.x = pk2(a[0], a[1]); w0.y = pk2(a[2], a[3]); w0.z = pk2(a[4], a[5]); w0.w = pk2(a[6], a[7]);
                w1.x = pk2(a[8], a[9]); w1.y = pk2(a[10], a[11]); w1.z = pk2(a[12], a[13]); w1.w = pk2(a[14], a[15]);
                if (mt == 0) {
                    *(uint4*)(kb + r * 136 + c16) = w0; *(uint4*)(kb + r * 136 + c16 + 8) = w1;
#pragma unroll
                    for (int j = 0; j < 16; ++j) kT[(c16 + j) * 72 + r] = f2bf(a[j]);
                } else if (mt == 1) {
#pragma unroll
                    for (int j = 0; j < 16; ++j) vT[(c16 + j) * 72 + r] = f2bf(a[j]);
                } else {
                    *(uint4*)(qb + r * 136 + c16) = w0; *(uint4*)(qb + r * 136 + c16 + 8) = w1;
                    bf16_t* qp = QO + (size_t)item * 8192 + r * 128 + c16; *(uint4*)qp = w0; *(uint4*)(qp + 8) = w1;
                }
            }
        }
        if (tid < 128) {
            const int d = tid >> 6, i = d ? 63 - lane : lane;
            const float beta = 1.0f / (1.0f + __expf(-graw_b));
            const float x = graw_a + dt_bias[d * 8 + h];
            const float sp = x > 20.f ? x : __logf(1.0f + __expf(x));
            float g = -__expf(a_log[d * 8 + h]) * sp;
#pragma unroll
            for (int o = 1; o < 64; o <<= 1) { const float t = __shfl_up(g, o); if (lane >= o) g += t; }
            const float glast = __shfl(g, 63);
            const float eg = __expf(g), ee = __expf(glast - g);
            beta_s[d * 64 + i] = beta; gc_s[d * 64 + i] = g; rsu[d * 64 + i] = beta; rsw[d * 64 + i] = beta * eg;
            float* gs = GSC + ((size_t)item * 2 + d) * 192; gs[i] = eg; gs[64 + i] = ee; if (lane == 63) gs[128] = __expf(glast);
        }
        __syncthreads();
#pragma unroll
        for (int i = 0; i < 2; ++i) { const int q16 = tid + NT * i; *(uint4*)(KT + (size_t)item * 8192 + (size_t)q16 * 8) = *(const uint4*)(kT + (q16 >> 3) * 72 + (q16 & 7) * 8); }
        {   const int mt = wid >> 1, ntp = wid & 1;
            f32x4 ckk[2], cqk[2];
#pragma unroll
            for (int e = 0; e < 2; ++e) { ckk[e] = (f32x4){0.f, 0.f, 0.f, 0.f}; cqk[e] = (f32x4){0.f, 0.f, 0.f, 0.f}; }
#pragma unroll
            for (int ks = 0; ks < 4; ++ks) {
                const bf16x8 ak = *(const bf16x8*)(kb + (16 * mt + fr) * 136 + 32 * ks + 8 * fq);
                bf16x8 aq = ak; if (!ctx) aq = *(const bf16x8*)(qb + (16 * mt + fr) * 136 + 32 * ks + 8 * fq);
#pragma unroll
                for (int e = 0; e < 2; ++e) { const bf16x8 bk = *(const bf16x8*)(kb + (16 * (2 * ntp + e) + fr) * 136 + 32 * ks + 8 * fq);
                    ckk[e] = __builtin_amdgcn_mfma_f32_16x16x32_bf16(ak, bk, ckk[e], 0, 0, 0);
                    cqk[e] = __builtin_amdgcn_mfma_f32_16x16x32_bf16(aq, bk, cqk[e], 0, 0, 0); }
            }
#pragma unroll
            for (int e = 0; e < 2; ++e)
#pragma unroll
                for (int r = 0; r < 4; ++r) {
                    const int i = 16 * mt + 4 * fq + r, j = 16 * (2 * ntp + e) + fr;
#pragma unroll
                    for (int d = 0; d < 2; ++d) {
                        const bool before = d ? (j > i) : (j < i); const bool incl = before || (i == j);
                        const float df = incl ? gc_s[d * 64 + i] - gc_s[d * 64 + j] : 0.f; const float ex = __expf(df);
                        const float av = before ? beta_s[d * 64 + i] * ckk[e][r] * ex : 0.f;
                        const int ii = d ? 63 - i : i, jj = d ? 63 - j : j;
                        As[(d * 64 + jj) * 68 + ii] = av;
                        if (!ctx) ATT[((size_t)item * 2 + d) * 4096 + i * 64 + j] = f2bf(incl ? cqk[e][r] * ex : 0.f);
                    }
                }
        }
        __syncthreads();
        if (wid == 0) g2_tinv_diag<0>(As, lane, rsu, rsw, TM, xl);
        else if (wid == 1) g2_tinv_diag<1>(As, lane, rsu, rsw, TM, xl);
        __syncthreads();
        {   const int dd = wid >> 2, vv = (wid >> 1) & 1, mh = wid & 1;
            const bf16_t* a10 = (const bf16_t*)(xl + G2X_A10) + dd * 32 * 40; const bf16_t* t11 = (const bf16_t*)(xl + G2X_T11) + dd * 32 * 40;
            const bf16_t* t0t = (const bf16_t*)(xl + G2X_T00T) + (dd * 2 + vv) * 32 * 40; bf16_t* xt = (bf16_t*)(xl + G2X_XT) + (dd * 2 + vv) * 32 * 40;
            const bf16x8 aA = *(const bf16x8*)(a10 + (16 * mh + fr) * 40 + 8 * fq);
#pragma unroll
            for (int nt = 0; nt < 2; ++nt) { const bf16x8 bT = *(const bf16x8*)(t0t + (16 * nt + fr) * 40 + 8 * fq);
                f32x4 acc = (f32x4){0.f, 0.f, 0.f, 0.f}; acc = __builtin_amdgcn_mfma_f32_16x16x32_bf16(aA, bT, acc, 0, 0, 0);
                uint2 w; w.x = pk2_c(acc[0], acc[1]); w.y = pk2_c(acc[2], acc[3]);
                *(uint2*)(xt + (16 * nt + fr) * 40 + 16 * mh + 4 * fq) = w; }
            __syncthreads();
            const bf16x8 aT = *(const bf16x8*)(t11 + (16 * mh + fr) * 40 + 8 * fq);
            bf16_t* tm = TM + (dd * 2 + vv) * 64 * 72;
#pragma unroll
            for (int nt = 0; nt < 2; ++nt) { const bf16x8 bX = *(const bf16x8*)(xt + (16 * nt + fr) * 40 + 8 * fq);
                f32x4 acc = (f32x4){0.f, 0.f, 0.f, 0.f}; acc = __builtin_amdgcn_mfma_f32_16x16x32_bf16(aT, bX, acc, 0, 0, 0);
                const int sj = 16 * nt + fr, jo = dd ? 63 - sj : sj;
#pragma unroll
                for (int r = 0; r < 4; ++r) { const int si = 32 + 16 * mh + 4 * fq + r, io = dd ? 63 - si : si; tm[io * 72 + jo] = (bf16_t)(pk2_c(-acc[r], 0.f) & 0xffffu); } }
        }
        __syncthreads();
        {   const int mi = wid >> 1, half = wid & 1, uw = mi & 1;
            const bf16_t* Tm = TM + mi * 64 * 72; const bf16_t* Bm = uw ? kT : vT;
            bf16_t* dst = UW + ((size_t)item * 4 + mi) * 8192;
#pragma unroll
            for (int mm = 0; mm < 2; ++mm) {
                const int mt = 2 * half + mm;
                const bf16x8 a0 = *(const bf16x8*)(Tm + (16 * mt + fr) * 72 + 8 * fq), a1 = *(const bf16x8*)(Tm + (16 * mt + fr) * 72 + 32 + 8 * fq);
#pragma unroll
                for (int nt = 0; nt < 8; ++nt) {
                    const bf16x8 b0 = *(const bf16x8*)(Bm + (16 * nt + fr) * 72 + 8 * fq), b1 = *(const bf16x8*)(Bm + (16 * nt + fr) * 72 + 32 + 8 * fq);
                    f32x4 acc = (f32x4){0.f, 0.f, 0.f, 0.f};
                    acc = __builtin_amdgcn_mfma_f32_16x16x32_bf16(b0, a0, acc, 0, 0, 0);
                    acc = __builtin_amdgcn_mfma_f32_16x16x32_bf16(b1, a1, acc, 0, 0, 0);
                    uint2 w; w.x = pk2_c(acc[0], acc[1]); w.y = pk2_c(acc[2], acc[3]);
                    *(uint2*)(dst + (16 * mt + fr) * 128 + 16 * nt + 4 * fq) = w;
                }
            }
        }
        __syncthreads();
    }
}

constexpr int SC_BUF = 68224, SC_W = 0, SC_KT = 17408, SC_Q = 35840, SC_AT = 53248, SC_U = 62464  , SC_S = 67584  ,
              SC_ST = 2 * SC_BUF, SC_VT = SC_ST + 8704, SC_VE = SC_VT + 4608;
static_assert(SC_S + 132 * 4 <= SC_BUF && SC_VE + 4608 <= LDS_BYTES - 16, "scan LDS");
struct ScanLd { uint4 w[4], k[4], q[4], a[2], u; float sc; };
struct ScanCtx { const bf16_t* KT; const bf16_t* QO; const bf16_t* UW; const bf16_t* ATT; const float* GSC; int lt, fr, fq, wid, sl, d, h, b; };
__device__ __forceinline__ void scan_item(const ScanCtx& c, int s, int& item, bool& ctx, int& row0) {
    const int n = c.d ? (s < 4 ? 3 - s : 135 - s) : s; item = ((c.b * NCHUNK + n) << 3) + c.h; ctx = n < 4;
    row0 = ctx ? MLAT + c.b * CL + n * CHK : c.b * SL + (n - 4) * CHK;
}
__device__ __forceinline__ void scan_load(const ScanCtx& c, ScanLd& L, int s) {
    int it, r0; bool cx; scan_item(c, s, it, cx, r0); (void)cx; (void)r0;
    const bf16_t* wp = c.UW + (((size_t)it * 2 + c.d) * 2 + 1) * 8192; const bf16_t* up = c.UW + (((size_t)it * 2 + c.d) * 2) * 8192;
    const bf16_t* kp = c.KT + (size_t)it * 8192; const bf16_t* qp = c.QO + (size_t)it * 8192; const bf16_t* ap = c.ATT + ((size_t)it * 2 + c.d) * 4096;
    const float* gs = c.GSC + ((size_t)it * 2 + c.d) * 192;
    const unsigned o16 = (unsigned)c.lt * 16u;
#pragma unroll
    for (int i = 0; i < 4; ++i) { const unsigned q = o16 + 4096u * i; L.w[i] = *(const uint4*)((const char*)wp + q); L.k[i] = *(const uint4*)((const char*)kp + q); L.q[i] = *(const uint4*)((const char*)qp + q); }
#pragma unroll
    for (int i = 0; i < 2; ++i) L.a[i] = *(const uint4*)((const char*)ap + o16 + 4096u * i);
    L.u = *(const uint4*)((const char*)up + (unsigned)((c.lt >> 2) * 256 + 64 * c.sl + (c.lt & 3) * 16));
    L.sc = gs[c.lt < 129 ? c.lt : 128];
}
__device__ __forceinline__ void scan_store(const ScanCtx& c, const ScanLd& L, unsigned char* bp) {
#pragma unroll
    for (int i = 0; i < 4; ++i) { const int q = c.lt + 256 * i;
        *(uint4*)(bp + SC_W + (q >> 4) * 272 + (q & 15) * 16) = L.w[i];
        *(uint4*)(bp + SC_KT + (q >> 3) * 144 + (q & 7) * 16) = L.k[i];
        *(uint4*)(bp + SC_Q + (q >> 4) * 272 + (q & 15) * 16) = L.q[i]; }
#pragma unroll
    for (int i = 0; i < 2; ++i) { const int q = c.lt + 256 * i; *(uint4*)(bp + SC_AT + (q >> 3) * 144 + (q & 7) * 16) = L.a[i]; }
    *(uint4*)(bp + SC_U + (c.lt >> 2) * 80 + (c.lt & 3) * 16) = L.u;
    if (c.lt < 129) *(float*)(bp + SC_S + c.lt * 4) = L.sc;
}
__device__ __forceinline__ void scan_alpha(const ScanCtx& c, unsigned char* lds, const unsigned char* bc, bool ctx, f32x4 (&O1)[2]) {
    const int fr = c.fr, fq = c.fq, mt = c.wid;
    f32x4 P[2]; P[0] = (f32x4){0.f, 0.f, 0.f, 0.f}; P[1] = (f32x4){0.f, 0.f, 0.f, 0.f}; O1[0] = (f32x4){0.f, 0.f, 0.f, 0.f}; O1[1] = (f32x4){0.f, 0.f, 0.f, 0.f};
#pragma unroll
    for (int ks = 0; ks < 4; ++ks) {
        const bf16x8 aW = *(const bf16x8*)(bc + SC_W + (16 * mt + fr) * 272 + (32 * ks + 8 * fq) * 2);
        bf16x8 aQ = aW; if (!ctx) aQ = *(const bf16x8*)(bc + SC_Q + (16 * mt + fr) * 272 + (32 * ks + 8 * fq) * 2);
#pragma unroll
        for (int nt = 0; nt < 2; ++nt) {
            const bf16x8 bS = *(const bf16x8*)(lds + SC_ST + (16 * nt + fr) * 272 + (32 * ks + 8 * fq) * 2);
            P[nt] = __builtin_amdgcn_mfma_f32_16x16x32_bf16(aW, bS, P[nt], 0, 0, 0);
            if (!ctx) O1[nt] = __builtin_amdgcn_mfma_f32_16x16x32_bf16(aQ, bS, O1[nt], 0, 0, 0);
        }
    }
    float eec[4];
#pragma unroll
    for (int r = 0; r < 4; ++r) eec[r] = *(const float*)(bc + SC_S + (64 + 16 * mt + 4 * fq + r) * 4);
#pragma unroll
    for (int nt = 0; nt < 2; ++nt) {
        float vn[4];
#pragma unroll
        for (int r = 0; r < 4; ++r) vn[r] = bf2f(*(const bf16_t*)(bc + SC_U + (16 * mt + 4 * fq + r) * 80 + (16 * nt + fr) * 2)) - P[nt][r];
        uint2 w; w.x = pk2(vn[0], vn[1]); w.y = pk2(vn[2], vn[3]);
        *(uint2*)(lds + SC_VT + (16 * nt + fr) * 144 + (16 * mt + 4 * fq) * 2) = w;
        w.x = pk2(vn[0] * eec[0], vn[1] * eec[1]); w.y = pk2(vn[2] * eec[2], vn[3] * eec[3]);
        *(uint2*)(lds + SC_VE + (16 * nt + fr) * 144 + (16 * mt + 4 * fq) * 2) = w;
    }
}
__device__ __forceinline__ void scan_beta(const ScanCtx& c, unsigned char* lds, const unsigned char* bc, bool ctx, int row0, const f32x4 (&O1)[2], f32x4 (&Sacc)[2][2], bf16_t* OD) {
    const int fr = c.fr, fq = c.fq, mt = c.wid;
    const float decc = *(const float*)(bc + SC_S + 128 * 4);
#pragma unroll
    for (int j = 0; j < 2; ++j) {
        const int dt = 2 * c.wid + j;
        const bf16x8 aK0 = *(const bf16x8*)(bc + SC_KT + (16 * dt + fr) * 144 + (8 * fq) * 2), aK1 = *(const bf16x8*)(bc + SC_KT + (16 * dt + fr) * 144 + (32 + 8 * fq) * 2);
#pragma unroll
        for (int e = 0; e < 2; ++e) {
            f32x4 a = Sacc[j][e] * decc;
            const bf16x8 b0 = *(const bf16x8*)(lds + SC_VE + (16 * e + fr) * 144 + (8 * fq) * 2), b1 = *(const bf16x8*)(lds + SC_VE + (16 * e + fr) * 144 + (32 + 8 * fq) * 2);
            a = __builtin_amdgcn_mfma_f32_16x16x32_bf16(aK0, b0, a, 0, 0, 0);
            a = __builtin_amdgcn_mfma_f32_16x16x32_bf16(aK1, b1, a, 0, 0, 0);
            Sacc[j][e] = a;
        }
    }
    if (!ctx) {
        const bf16x8 aA0 = *(const bf16x8*)(bc + SC_AT + (16 * mt + fr) * 144 + (8 * fq) * 2), aA1 = *(const bf16x8*)(bc + SC_AT + (16 * mt + fr) * 144 + (32 + 8 * fq) * 2);
        float egc[4];
#pragma unroll
        for (int r = 0; r < 4; ++r) egc[r] = *(const float*)(bc + SC_S + (16 * mt + 4 * fq + r) * 4);
#pragma unroll
        for (int nt = 0; nt < 2; ++nt) {
            const bf16x8 b0 = *(const bf16x8*)(lds + SC_VT + (16 * nt + fr) * 144 + (8 * fq) * 2), b1 = *(const bf16x8*)(lds + SC_VT + (16 * nt + fr) * 144 + (32 + 8 * fq) * 2);
            f32x4 O2 = (f32x4){0.f, 0.f, 0.f, 0.f};
            O2 = __builtin_amdgcn_mfma_f32_16x16x32_bf16(aA0, b0, O2, 0, 0, 0);
            O2 = __builtin_amdgcn_mfma_f32_16x16x32_bf16(aA1, b1, O2, 0, 0, 0);
#pragma unroll
            for (int r = 0; r < 4; ++r) OD[(size_t)(row0 + 16 * mt + 4 * fq + r) * 1024 + c.h * 128 + 32 * c.sl + 16 * nt + fr] = f2bf(egc[r] * O1[nt][r] + O2[r]);
        }
    }
#pragma unroll
    for (int j = 0; j < 2; ++j)
#pragma unroll
        for (int e = 0; e < 2; ++e) { uint2 w; w.x = pk2_c(Sacc[j][e][0], Sacc[j][e][1]); w.y = pk2_c(Sacc[j][e][2], Sacc[j][e][3]);
            *(uint2*)(lds + SC_ST + (16 * e + fr) * 272 + (16 * (2 * c.wid + j) + 4 * fq) * 2) = w; }
}
__device__ __forceinline__ void phase_gdn_scan(const Params& p, unsigned char* lds) {
    ScanCtx c;
    const int tid = otid(), lane = tid & 63; c.wid = __builtin_amdgcn_readfirstlane(tid >> 6); c.fr = lane & 15; c.fq = lane >> 4;
    const bool loader = c.wid >= 4; c.lt = tid - 256;
    c.KT = (const bf16_t*)(p.ws + OFF_KT); c.QO = (const bf16_t*)(p.ws + OFF_Q); c.UW = (const bf16_t*)(p.ws + OFF_UW);
    c.ATT = (const bf16_t*)(p.ws + OFF_ATT); c.GSC = (const float*)(p.ws + OFF_GSC);
    for (int work = blockIdx.x; work < 256; work += gridDim.x) {
        const int xcd_ = work & 7, idx_ = work >> 3, grp_ = (idx_ >> 2) * 8 + xcd_;
        c.sl = idx_ & 3; c.d = grp_ & 1; c.h = (grp_ >> 1) & 7; c.b = grp_ >> 4;
        bf16_t* OD = (bf16_t*)(p.ws + (c.d ? OFF_OB : OFF_OF));
        for (int i = tid; i < 8704 / 4; i += NT) ((unsigned*)(lds + SC_ST))[i] = 0u;
        if (loader) {
            ScanLd L0, L1;
#define SCAN_ZERO(L_) do { _Pragma("unroll") for (int i = 0; i < 4; ++i) { L_.w[i] = make_uint4(0u, 0u, 0u, 0u); L_.k[i] = make_uint4(0u, 0u, 0u, 0u); L_.q[i] = make_uint4(0u, 0u, 0u, 0u); } \
                L_.a[0] = make_uint4(0u, 0u, 0u, 0u); L_.a[1] = make_uint4(0u, 0u, 0u, 0u); L_.u = make_uint4(0u, 0u, 0u, 0u); L_.sc = 0.f; } while (0)
            SCAN_ZERO(L0); SCAN_ZERO(L1);
#undef SCAN_ZERO
            scan_load(c, L0, 0); scan_store(c, L0, lds); scan_load(c, L1, 1);
            __syncthreads();
#define SCAN_LSTEP(s_, LD_, ST_) do { const int ss_ = (s_); if (ss_ + 2 < NCHUNK) scan_load(c, LD_, ss_ + 2); __syncthreads(); \
                if (ss_ + 1 < NCHUNK) scan_store(c, ST_, lds + ((ss_ + 1) & 1) * SC_BUF); __syncthreads(); } while (0)
#pragma unroll 1
            for (int s = 0; s < NCHUNK; s += 2) {
                SCAN_LSTEP(s, L0, L1); SCAN_LSTEP(s + 1, L1, L0); }
#undef SCAN_LSTEP
        } else {
            f32x4 Sacc[2][2];
#pragma unroll
            for (int j = 0; j < 2; ++j) { Sacc[j][0] = (f32x4){0.f, 0.f, 0.f, 0.f}; Sacc[j][1] = (f32x4){0.f, 0.f, 0.f, 0.f}; }
            __syncthreads();
#pragma unroll 1
            for (int s = 0; s < NCHUNK; ++s) {
                int item, row0; bool ctx; scan_item(c, s, item, ctx, row0); (void)item;
                const unsigned char* bc = lds + (s & 1) * SC_BUF; f32x4 O1[2];
                scan_alpha(c, lds, bc, ctx, O1);
                __syncthreads();
                scan_beta(c, lds, bc, ctx, row0, O1, Sacc, OD);
                __syncthreads();
            }
        }
    }
}

__device__ __forceinline__ void phase_gdn_out(const Params& p) {
    const bf16_t* OFp = (const bf16_t*)(p.ws + OFF_OF); const bf16_t* OBp = (const bf16_t*)(p.ws + OFF_OB); const bf16_t* PZ = (const bf16_t*)(p.ws + OFF_PZ);
    bf16_t* MIX = (bf16_t*)(p.ws + OFF_H); const float* gn = p.in[14];
    const size_t total = (size_t)MLAT * 128, stride = (size_t)gridDim.x * NT;
    size_t e = (size_t)blockIdx.x * NT + otid();
    const bool gn_fixed = ((stride & 127) == 0); float gnr[8];
#pragma unroll
    for (int j = 0; j < 8; ++j) gnr[j] = gn[(((int)(e & 127) * 8) & 127) + j];
    uint4 ua, ub, uz, na, nb, nz;
    if (e < total) { const size_t row = e >> 7; const int c8 = (int)(e & 127) * 8; ua = *(const uint4*)(OFp + row * 1024 + c8); ub = *(const uint4*)(OBp + row * 1024 + c8); uz = *(const uint4*)(PZ + row * 1024 + c8); }
    for (; e < total; e += stride) {
        const size_t en = e + stride;
        if (en < total) { const size_t row = en >> 7; const int c8 = (int)(en & 127) * 8; na = *(const uint4*)(OFp + row * 1024 + c8); nb = *(const uint4*)(OBp + row * 1024 + c8); nz = *(const uint4*)(PZ + row * 1024 + c8); }
        const size_t row = e >> 7; const int c8 = (int)(e & 127) * 8;
        float a[8], bq[8], z[8];
        unpack8(ua, a); unpack8(ub, bq); unpack8(uz, z);
        float ss = 0.f;
#pragma unroll
        for (int j = 0; j < 8; ++j) { a[j] += bq[j]; ss += a[j] * a[j]; }
        ss += __shfl_xor(ss, 1); ss += __shfl_xor(ss, 2); ss += __shfl_xor(ss, 4); ss += __shfl_xor(ss, 8);
        const float rstd = rsqrtf(ss * (1.0f / 128.0f) + EPSF);
#pragma unroll
        for (int j = 0; j < 8; ++j) a[j] = a[j] * rstd * (gn_fixed ? gnr[j] : gn[(c8 & 127) + j]) * silu(z[j]);
        *(uint4*)(MIX + row * DM + c8) = pack8(a);
        ua = na; ub = nb; uz = nz;
    }
}

__device__ __forceinline__ void phase_postmix(const Params& p) {
    const int tid_ = otid(), lane = tid_ & 63, wv = __builtin_amdgcn_readfirstlane(tid_ >> 6);
    const float* MOD = (const float*)(p.ws + OFF_MOD); const float* w1 = p.in[7]; const float* w2 = p.in[8];
    const bf16_t* OUT = (const bf16_t*)(p.ws + OFF_OUT); bf16_t* H = (bf16_t*)(p.ws + OFF_H); bf16_t* S1B = (bf16_t*)(p.ws + OFF_S1B);
    const int stride = gridDim.x * 8;
    uint4 ov[4], ovn[4]; float4 xv[8], xvn[8];
    int row = blockIdx.x * 8 + wv;
    if (row < MLAT) {
#pragma unroll
        for (int i = 0; i < 4; ++i) { ov[i] = *(const uint4*)(OUT + (size_t)row * DM + 8 * (lane + 64 * i));
            xv[2 * i] = *(const float4*)(p.in[0] + (size_t)row * DM + 8 * (lane + 64 * i)); xv[2 * i + 1] = *(const float4*)(p.in[0] + (size_t)row * DM + 8 * (lane + 64 * i) + 4); } }
    for (; row < MLAT; row += stride) {
        const int nxt = row + stride;
        if (nxt < MLAT) {
#pragma unroll
            for (int i = 0; i < 4; ++i) { ovn[i] = *(const uint4*)(OUT + (size_t)nxt * DM + 8 * (lane + 64 * i));
                xvn[2 * i] = *(const float4*)(p.in[0] + (size_t)nxt * DM + 8 * (lane + 64 * i)); xvn[2 * i + 1] = *(const float4*)(p.in[0] + (size_t)nxt * DM + 8 * (lane + 64 * i) + 4); } }
        const int b = row >> 13; const float* mb = MOD + b * (6 * DM);
        const float* ga = mb + 2 * DM; const float* shf = mb + 3 * DM; const float* scf = mb + 4 * DM;
        float o[4][8]; float ss = 0.f;
#pragma unroll
        for (int i = 0; i < 4; ++i) { unpack8(ov[i], o[i]);
#pragma unroll
            for (int j = 0; j < 8; ++j) ss += o[i][j] * o[i][j]; }
        ss = wave_sum(ss); const float rstd = rsqrtf(ss * (1.0f / DM) + EPSF);
        float ss2 = 0.f;
#pragma unroll
        for (int i = 0; i < 4; ++i) { const int col = 8 * (lane + 64 * i);
#pragma unroll
            for (int hh = 0; hh < 2; ++hh) { const float4 xq = xv[2 * i + hh], wv4 = *(const float4*)(w1 + col + 4 * hh), gv = *(const float4*)(ga + col + 4 * hh);
                float4 s; s.x = xq.x + gv.x * o[i][4 * hh] * rstd * wv4.x; s.y = xq.y + gv.y * o[i][4 * hh + 1] * rstd * wv4.y; s.z = xq.z + gv.z * o[i][4 * hh + 2] * rstd * wv4.z; s.w = xq.w + gv.w * o[i][4 * hh + 3] * rstd * wv4.w;
                o[i][4 * hh] = s.x; o[i][4 * hh + 1] = s.y; o[i][4 * hh + 2] = s.z; o[i][4 * hh + 3] = s.w;
                ss2 += s.x * s.x + s.y * s.y + s.z * s.z + s.w * s.w; } }
        ss2 = wave_sum(ss2); const float rstd2 = rsqrtf(ss2 * (1.0f / DM) + EPSF);
#pragma unroll
        for (int i = 0; i < 4; ++i) { const int col = 8 * (lane + 64 * i); float f[8];
#pragma unroll
            for (int j = 0; j < 8; ++j) f[j] = o[i][j] * rstd2 * w2[col + j] * (1.f + scf[col + j]) + shf[col + j];
            *(uint4*)(H + (size_t)row * DM + col) = pack8(f); *(uint4*)(S1B + (size_t)row * DM + col) = pack8(o[i]); }
#pragma unroll
        for (int i = 0; i < 4; ++i) { ov[i] = ovn[i]; xv[2 * i] = xvn[2 * i]; xv[2 * i + 1] = xvn[2 * i + 1]; }
    }
}

__device__ __forceinline__ void phase_final(const Params& p) {
    const int tid_ = otid(), lane = tid_ & 63, wv = __builtin_amdgcn_readfirstlane(tid_ >> 6);
    const float* MOD = (const float*)(p.ws + OFF_MOD); const float* w = p.in[9]; const bf16_t* FF = (const bf16_t*)(p.ws + OFF_FF); const bf16_t* S1B = (const bf16_t*)(p.ws + OFF_S1B);
    const int stride = gridDim.x * 8;
    uint4 fv[4], fvn[4], sv[4], svn[4]; float4 pg[4][2]; int b_loaded = -1;
    int row = blockIdx.x * 8 + wv;
    if (row < MLAT) {
#pragma unroll
        for (int i = 0; i < 4; ++i) { fv[i] = *(const uint4*)(FF + (size_t)row * DM + 8 * (lane + 64 * i)); sv[i] = *(const uint4*)(S1B + (size_t)row * DM + 8 * (lane + 64 * i)); } }
    for (; row < MLAT; row += stride) {
        const int nxt = row + stride;
        if (nxt < MLAT) {
#pragma unroll
            for (int i = 0; i < 4; ++i) { fvn[i] = *(const uint4*)(FF + (size_t)nxt * DM + 8 * (lane + 64 * i)); svn[i] = *(const uint4*)(S1B + (size_t)nxt * DM + 8 * (lane + 64 * i)); } }
        const int b = row >> 13;
        if (b != b_loaded) { b_loaded = b; const float* gf = MOD + b * (6 * DM) + 5 * DM;
#pragma unroll
            for (int i = 0; i < 4; ++i)
#pragma unroll
                for (int hh = 0; hh < 2; ++hh) { const int col = 8 * (lane + 64 * i) + 4 * hh; const float4 wv4 = *(const float4*)(w + col), gv = *(const float4*)(gf + col);
                    pg[i][hh] = make_float4(gv.x * wv4.x, gv.y * wv4.y, gv.z * wv4.z, gv.w * wv4.w); } }
        float o[4][8]; float ss = 0.f;
#pragma unroll
        for (int i = 0; i < 4; ++i) { unpack8(fv[i], o[i]);
#pragma unroll
            for (int j = 0; j < 8; ++j) ss += o[i][j] * o[i][j]; }
        ss = wave_sum(ss); const float rstd = rsqrtf(ss * (1.0f / DM) + EPSF);
#pragma unroll
        for (int i = 0; i < 4; ++i) { const int col = 8 * (lane + 64 * i); float s1[8]; unpack8(sv[i], s1);
#pragma unroll
            for (int hh = 0; hh < 2; ++hh) { const float4 gw = pg[i][hh]; float4 s;
                s.x = s1[4 * hh] + gw.x * (o[i][4 * hh] * rstd); s.y = s1[4 * hh + 1] + gw.y * (o[i][4 * hh + 1] * rstd);
                s.z = s1[4 * hh + 2] + gw.z * (o[i][4 * hh + 2] * rstd); s.w = s1[4 * hh + 3] + gw.w * (o[i][4 * hh + 3] * rstd);
                *(float4*)(p.out + (size_t)row * DM + col + 4 * hh) = s; } }
#pragma unroll
        for (int i = 0; i < 4; ++i) { fv[i] = fvn[i]; sv[i] = svn[i]; }
    }
}

#define XB_TMO      128
#define XB_XCNT(j)  (256  + 64 * (j))
#define XB_XSUB(j)  (1280 + 64 * (j))
#define XB_XGEN(j)  (2304 + 64 * (j))
#define XB_TOP      3328
#define XB_TOPGEN   3392
#define XCD_BAR_WORDS 3456
#define XB_SPIN_CAP (1u << 18)
#define LAS __attribute__((address_space(3)))

__device__ __forceinline__ unsigned xb_ld(unsigned* p)              { return __hip_atomic_load(p, __ATOMIC_RELAXED, __HIP_MEMORY_SCOPE_AGENT); }
__device__ __forceinline__ unsigned xb_add(unsigned* p, unsigned v) { return __hip_atomic_fetch_add(p, v, __ATOMIC_RELAXED, __HIP_MEMORY_SCOPE_AGENT); }
__device__ __forceinline__ unsigned xb_xcc_id() { return (unsigned)__builtin_amdgcn_s_getreg((3 << 11) | 20) & 0xFu; }
#define XB_SPIN(cond, bar) do { unsigned _sp = 0; while (cond) { __builtin_amdgcn_s_sleep(1); \
    if ((++_sp & 255u) == 0u) { if (xb_ld(&(bar)[XB_TMO])) break; if (_sp > XB_SPIN_CAP) { atomicAdd(&(bar)[XB_TMO], 1u); break; } } } } while (0)

struct XcdBarrier {
    unsigned* bar; unsigned x;
    volatile LAS unsigned* st;
};

__device__ __forceinline__ XcdBarrier xcd_barrier_post(unsigned* bar, volatile LAS unsigned* st) {
    XcdBarrier b; b.bar = bar; b.x = xb_xcc_id(); b.st = st;
    if (threadIdx.x == 0) (void)xb_add(&bar[XB_XCNT(b.x)], 1u);
    return b;
}
__device__ __forceinline__ void xcd_barrier_complete(unsigned* bar, unsigned x, unsigned& nloc, unsigned& nx) {
    const unsigned G = gridDim.x * gridDim.y * gridDim.z;
    unsigned sum, cnt, mine, sp = 0u;
    for (;;) {
        sum = 0u; cnt = 0u; mine = 0u;
#pragma unroll
        for (unsigned j = 0; j < 16; ++j) { const unsigned c = xb_ld(&bar[XB_XCNT(j)]); sum += c; cnt += (c > 0u) ? 1u : 0u; mine = (j == x) ? c : mine; }
        if (sum == G) break;
        __builtin_amdgcn_s_sleep(1);
        if ((++sp & 255u) == 0u) { if (xb_ld(&bar[XB_TMO])) break; if (sp > XB_SPIN_CAP) { atomicAdd(&bar[XB_TMO], 1u); break; } }
    }
    nloc = mine > 0u ? mine : 1u; nx = cnt > 0u ? cnt : 1u;
}

__device__ __forceinline__ void xcd_barrier(const XcdBarrier& b) {
    asm volatile("s_waitcnt vmcnt(0)" ::: "memory");
    __syncthreads();
    if (threadIdx.x == 0) {
        unsigned* bar = b.bar;
        __builtin_amdgcn_s_waitcnt(0);
        unsigned nloc = b.st[0], nx = b.st[1];
        if (nloc == 0u) { xcd_barrier_complete(bar, b.x, nloc, nx); b.st[0] = nloc; b.st[1] = nx; }
        const unsigned old = xb_add(&bar[XB_XSUB(b.x)], 1u);
        const unsigned gen = old / nloc;
        if (old + 1u == (gen + 1u) * nloc) {
            __builtin_amdgcn_fence(__ATOMIC_RELEASE, "agent");
            asm volatile("s_waitcnt vmcnt(0)" ::: "memory");
            const unsigned og = xb_add(&bar[XB_TOP], 1u);
            const unsigned tg = og / nx;
            if (og + 1u == (tg + 1u) * nx) xb_add(&bar[XB_TOPGEN], 1u);
            else XB_SPIN(xb_ld(&bar[XB_TOPGEN]) == tg, bar);
            __builtin_amdgcn_fence(__ATOMIC_ACQUIRE, "agent");
            xb_add(&bar[XB_XGEN(b.x)], 1u);
            asm volatile("s_waitcnt vmcnt(0)" ::: "memory");
        } else {
            XB_SPIN(xb_ld(&bar[XB_XGEN(b.x)]) == gen, bar);
            __builtin_amdgcn_fence(__ATOMIC_ACQUIRE, "agent");
            asm volatile("s_waitcnt vmcnt(0)" ::: "memory");
        }
    }
    __syncthreads();
}


constexpr int NPHASE = 14;
template <class Epi> __device__ __forceinline__ void run_gemm(unsigned char* lds, const bf16_t* A, const bf16_t* Bt, int M, int N, int K, const Epi& E) {
    pg8::Gemm g{A, Bt, M, N, K}; pg8::StaticOrder S; S.init(M, N, (int)gridDim.x, (int)blockIdx.x);
    pg8::gemm_phase<Epi, pg8::StaticOrder, true, true>((PG8_LAS unsigned char*)lds, g, S, E);
}
__global__ void __launch_bounds__(NT, 2) fwd_kernel(Params p) {
    extern __shared__ __attribute__((aligned(16))) unsigned char lds[];
    cg::grid_group grid = cg::this_grid();
    const int lo = p.ph_lo, hi = p.ph_hi;
    unsigned char* ws = p.ws;
    if (lo < 0) grid.sync();
    if (threadIdx.x == 0) *(uint4*)(lds + LDS_BYTES - 16) = make_uint4(0u, 0u, 0u, 0u);
    __syncthreads();
    XcdBarrier xbar = xcd_barrier_post((unsigned*)(ws + OFF_BAR), (volatile LAS unsigned*)((LAS unsigned char*)lds + (LDS_BYTES - 16)));
#ifndef PH_MASK
#define PH_MASK 0xffff
#endif
#ifndef REP_MASK
#define REP_MASK 0
#endif
#define IN(k) ((((PH_MASK) >> (k)) & 1) && lo <= (k) && (k) < hi)
#define REP(k, stmt) do { if (IN(k)) { const int nrep_ = 1 + ((REP_MASK >> (k)) & 1); _Pragma("unroll 1") for (int rep_ = 0; rep_ < nrep_; ++rep_) { if (rep_) xcd_barrier(xbar); stmt; } } } while (0)
#define SEAM(k) do { if (IN(k) && IN((k) + 1)) xcd_barrier(xbar); } while (0)
    REP(0, phase_prologue(p, lds));
    SEAM(0);
    REP(1, phase_prenorm(p));
    SEAM(1);
    { pg8::EpiProj E{(bf16_t*)(ws + OFF_PGDN), (bf16_t*)(ws + OFF_PZ), (bf16_t*)(ws + OFF_PHY), (float*)(ws + OFF_GATES)};
        REP(2, run_gemm(lds, (const bf16_t*)(ws + OFF_H), (const bf16_t*)(ws + OFF_WIN), MALL, N1, DM, E)); }
    SEAM(2);
#pragma unroll 1
    for (int rep_ = 0; rep_ < 1 + ((REP_MASK >> 3) & 1); ++rep_) {
    if (IN(3)) phase_hy1(p, lds);
    SEAM(3);
    if (IN(4)) phase_hy2(p, lds);
    SEAM(4);
    if (IN(5)) phase_hy3(p, lds);
    SEAM(5);
    }
    REP(6, phase_gdn_prep(p, lds));
    SEAM(6);
    REP(7, phase_gdn_scan(p, lds));
    SEAM(7);
    REP(8, phase_gdn_out(p));
    SEAM(8);
    { pg8::EpiPlain E{(bf16_t*)(ws + OFF_OUT), DM};
        REP(9, run_gemm(lds, (const bf16_t*)(ws + OFF_H), (const bf16_t*)(ws + OFF_WOUT), MLAT, DM, DM, E)); }
    SEAM(9);
    REP(10, phase_postmix(p));
    SEAM(10);
    { pg8::EpiSwiglu E{(bf16_t*)(ws + OFF_ACT), DFF};
        REP(11, run_gemm(lds, (const bf16_t*)(ws + OFF_H), (const bf16_t*)(ws + OFF_WGU), MLAT, 2 * DFF, DM, E)); }
    SEAM(11);
    { pg8::EpiPlain E{(bf16_t*)(ws + OFF_FF), DM};
        REP(12, run_gemm(lds, (const bf16_t*)(ws + OFF_ACT), (const bf16_t*)(ws + OFF_WDOWN), MLAT, DM, DFF, E)); }
    SEAM(12);
    if (IN(13)) phase_final(p);
#undef IN
#undef REP
#undef SEAM
}

extern "C" void kernel_launch(void* const* d_in, const int* in_sizes, int n_in, void* d_out, int out_size, void* d_ws, size_t ws_size, hipStream_t stream) {
    static int grid = 0;
    if (grid == 0) {
        if (n_in != 32 || ws_size < WS_TOTAL) { fprintf(stderr, "kernel_launch: need 32 inputs and %zu bytes of workspace (got %d, %zu)\n", (size_t)WS_TOTAL, n_in, ws_size); grid = -1; return; }
        int dev = 0, cus = 0, per_cu = 0;
        hipGetDevice(&dev); hipDeviceGetAttribute(&cus, hipDeviceAttributeMultiprocessorCount, dev);
        if (hipFuncSetAttribute((const void*)fwd_kernel, hipFuncAttributeMaxDynamicSharedMemorySize, LDS_BYTES) != hipSuccess) { fprintf(stderr, "kernel_launch: hipFuncSetAttribute failed\n"); grid = -1; return; }
        if (hipOccupancyMaxActiveBlocksPerMultiprocessor(&per_cu, (const void*)fwd_kernel, NT, LDS_BYTES) != hipSuccess || per_cu < 1) { fprintf(stderr, "kernel_launch: occupancy query gave %d\n", per_cu); per_cu = 1; }
        (void)hipGetLastError();
        grid = cus * per_cu;
    }
    if (grid < 0) return;
    if (hipMemsetAsync((unsigned char*)d_ws + OFF_BAR, 0, XCD_BAR_WORDS * 4, stream) != hipSuccess) { fprintf(stderr, "kernel_launch: memset of the barrier words failed\n"); return; }
    Params p{};
    for (int i = 0; i < 32; ++i) p.in[i] = (const float*)d_in[i];
    p.out = (float*)d_out; p.ws = (unsigned char*)d_ws;
#if MULTI_LAUNCH
    for (int ph = 0; ph < NPHASE; ++ph) { p.ph_lo = ph; p.ph_hi = ph + 1;
        hipLaunchKernelGGL(fwd_kernel, dim3(grid), dim3(NT), LDS_BYTES, stream, p); }
#else
    p.ph_lo = 0; p.ph_hi = NPHASE;
    void* args[] = {&p};
    hipError_t e = hipLaunchCooperativeKernel((const void*)fwd_kernel, dim3(grid), dim3(NT), args, LDS_BYTES, stream);
    if (e != hipSuccess) fprintf(stderr, "cooperative launch failed: %s (grid %d)\n", hipGetErrorString(e), grid);
#endif
}
```

```cpp
#include <hip/hip_runtime.h>
#include <hip/hip_cooperative_groups.h>
#include <cstdio>
#include <cstdint>
namespace cg = cooperative_groups;

#ifndef MULTI_LAUNCH
#define MULTI_LAUNCH 0
#endif

__device__ __forceinline__ int otid() { int t = threadIdx.x; asm volatile("" : "+v"(t)); return t; }

#undef MULTI_LAUNCH
#define MULTI_LAUNCH 0
#define REP_MASK 0
namespace pg8 {
#define PG8_LAS __attribute__((address_space(3)))
typedef unsigned short bf16_t;
typedef short bf16x8 __attribute__((ext_vector_type(8)));
typedef float f32x4 __attribute__((ext_vector_type(4)));
typedef unsigned u32x4 __attribute__((ext_vector_type(4)));
constexpr int BM = 256, BK = 64, HALF = 128, HTB = HALF * BK * 2  , STAGE_BYTES = 8 * HTB, NXCD = 8, WGM = 8;

__host__ __device__ __forceinline__ int lds_byte(int r, int c) { const int st = (r >> 4) * 2 + (c >> 5), rr = r & 15, cc = c & 31, ob = rr * 64 + cc * 2; return st * 1024 + (ob ^ (((ob >> 9) & 1) << 5)); }
__host__ __device__ __forceinline__ void stage_rc(int b, int& R, int& C) { const int st = b / 1024, sb = b % 1024, swz = sb ^ (((sb >> 9) & 1) << 5); R = (st >> 1) * 16 + swz / 64; C = (st & 1) * 32 + (swz % 64) / 2; }
__host__ __device__ __forceinline__ int perm32(int rho) { const int n = rho >> 4, i = rho & 15; return 8 * (i >> 2) + 4 * n + (i & 3); }

struct Unit { int pm, pn; };
struct Gemm { const bf16_t* A; const bf16_t* Bt; int M, N, K; };

struct StaticOrder {
    int nM, nN, nwg, G, c;
    __host__ __device__ void init(int M, int N, int G_, int c_) { nM = M / BM; nN = N / BM; nwg = nM * nN; G = G_; c = c_; }
    __host__ __device__ bool next(int i, Unit& u) const {
        const long L = (long)i * G + c; if (L >= nwg) return false;
        int wgid = (int)L; { const int q = nwg / NXCD, r = nwg % NXCD, xcd = wgid % NXCD, off = wgid / NXCD; wgid = (xcd < r ? xcd * (q + 1) : r * (q + 1) + (xcd - r) * q) + off; }
        const int nig = WGM * nN, gid = wgid / nig, fm = gid * WGM, gsz = (nM - fm) < WGM ? (nM - fm) : WGM;
        u.pm = fm + ((wgid % nig) % gsz); u.pn = (wgid % nig) / gsz; return true;
    }
    __device__ __forceinline__ void a_ready(const Unit&) const {}
    __device__ __forceinline__ void done(const Unit&) const {}
};

__device__ __forceinline__ unsigned cvt_pk_bf16(float lo, float hi) { unsigned r; asm volatile("v_cvt_pk_bf16_f32 %0, %1, %2" : "=v"(r) : "v"(lo), "v"(hi)); return r; }
__device__ __forceinline__ float silu_f(float x) { return x * __builtin_amdgcn_rcpf(1.0f + __expf(-x)); }

struct EpiPlain {
    static constexpr bool PERM = true, AFTER_DRAIN = false;
    bf16_t* O; int ldc;
    __device__ __forceinline__ void operator()(const f32x4 (&acc)[2][2][4][2], const Unit& u, int wr, int wc, int fr, int fq) const {
        const int row0 = u.pm * BM + wr * 64 + fr, col0 = u.pn * BM + wc * 32 + 8 * fq;
#pragma unroll
        for (int ai = 0; ai < 2; ++ai)
#pragma unroll
            for (int m = 0; m < 4; ++m) { bf16_t* rowp = O + (size_t)(row0 + ai * HALF + m * 16) * ldc + col0;
#pragma unroll
                for (int bj = 0; bj < 2; ++bj) { const f32x4 v0 = acc[ai][bj][m][0], v1 = acc[ai][bj][m][1];
                    u32x4 w; w.x = cvt_pk_bf16(v0[0], v0[1]); w.y = cvt_pk_bf16(v0[2], v0[3]); w.z = cvt_pk_bf16(v1[0], v1[1]); w.w = cvt_pk_bf16(v1[2], v1[3]);
                    *(u32x4*)(rowp + bj * HALF) = w; } }
    }
};
struct EpiProj {
    static constexpr bool PERM = true, AFTER_DRAIN = false;
    bf16_t* pgdn; bf16_t* pz; bf16_t* phy; float* gates;
    __device__ __forceinline__ void operator()(const f32x4 (&acc)[2][2][4][2], const Unit& u, int wr, int wc, int fr, int fq) const {
        const int row0 = u.pm * BM + wr * 64 + fr, pn = u.pn;
        if (pn < 28) {
            bf16_t* base; int ld, colt;
            if (pn < 12) { base = pgdn; ld = 3072; colt = pn * 256; }
            else if (pn < 16) { base = pz; ld = 1024; colt = (pn - 12) * 256; }
            else { base = phy; ld = 3072; colt = (pn - 16) * 256; }
            const int col0 = colt + wc * 32 + 8 * fq;
#pragma unroll
            for (int ai = 0; ai < 2; ++ai)
#pragma unroll
                for (int m = 0; m < 4; ++m) { bf16_t* rowp = base + (size_t)(row0 + ai * HALF + m * 16) * ld + col0;
#pragma unroll
                    for (int bj = 0; bj < 2; ++bj) { const f32x4 v0 = acc[ai][bj][m][0], v1 = acc[ai][bj][m][1];
                        u32x4 w; w.x = cvt_pk_bf16(v0[0], v0[1]); w.y = cvt_pk_bf16(v0[2], v0[3]); w.z = cvt_pk_bf16(v1[0], v1[1]); w.w = cvt_pk_bf16(v1[2], v1[3]);
                        *(u32x4*)(rowp + bj * HALF) = w; } }
        } else if (wc == 0) {
#pragma unroll
            for (int ai = 0; ai < 2; ++ai)
#pragma unroll
                for (int m = 0; m < 4; ++m) { float* rowp = gates + (size_t)(row0 + ai * HALF + m * 16) * 32 + 8 * fq;
                    *(f32x4*)(rowp) = acc[ai][0][m][0]; *(f32x4*)(rowp + 4) = acc[ai][0][m][1]; }
        }
    }
};
struct EpiSwiglu {
    static constexpr bool PERM = true, AFTER_DRAIN = false;
    bf16_t* O; int ldc;
    __device__ __forceinline__ void operator()(const f32x4 (&acc)[2][2][4][2], const Unit& u, int wr, int wc, int fr, int fq) const {
        const int row0 = u.pm * BM + wr * 64 + fr, col0 = u.pn * HALF + wc * 32 + 8 * fq;
#pragma unroll
        for (int ai = 0; ai < 2; ++ai)
#pragma unroll
            for (int m = 0; m < 4; ++m) { bf16_t* rowp = O + (size_t)(row0 + ai * HALF + m * 16) * ldc + col0;
                const f32x4 g0 = acc[ai][0][m][0], g1 = acc[ai][0][m][1], u0 = acc[ai][1][m][0], u1 = acc[ai][1][m][1];
                u32x4 w;
                w.x = cvt_pk_bf16(silu_f(g0[0]) * u0[0], silu_f(g0[1]) * u0[1]); w.y = cvt_pk_bf16(silu_f(g0[2]) * u0[2], silu_f(g0[3]) * u0[3]);
                w.z = cvt_pk_bf16(silu_f(g1[0]) * u1[0], silu_f(g1[1]) * u1[1]); w.w = cvt_pk_bf16(silu_f(g1[2]) * u1[2], silu_f(g1[3]) * u1[3]);
                *(u32x4*)(rowp) = w; }
    }
};

template <class Epi, class Sched, bool ALIGN_EPI = false, bool SP2 = false>
__device__ __forceinline__ void gemm_phase(PG8_LAS unsigned char* lds, const Gemm g, const Sched& S, const Epi& E) {
    const int tid = otid(), wid = __builtin_amdgcn_readfirstlane(tid >> 6), lane = tid & 63, wr = wid >> 2, wc = wid & 3, fr = lane & 15, fq = lane >> 4;
    const int K = g.K, nt = K / BK;
    unsigned voffA[2], voffB[2];
#pragma unroll
    for (int i = 0; i < 2; ++i) { int R, C; stage_rc(tid * 16 + i * 8192, R, C); const int Rb = Epi::PERM ? ((R & ~31) + perm32(R & 31)) : R;
        voffA[i] = (unsigned)(R * K + C) * 2u; voffB[i] = (unsigned)(Rb * K + C) * 2u; }
    const size_t kstep = (size_t)(BK * 2);
    const size_t hstep = (size_t)HALF * K * 2;
    const size_t tstep = 2 * hstep;
    const unsigned ldsw = (unsigned)wid * 1024u;
    const int aoff = lds_byte(wr * 64 + fr, fq * 8), boff = lds_byte(wc * 32 + fr, fq * 8);
#define PG8_SA(b, h) (((b) * 2 + (h)) * HTB)
#define PG8_SB(b, h) ((4 + (b) * 2 + (h)) * HTB)
#define PG8_STAGE(bufoff, gbase, voff) do { _Pragma("unroll") for (int _i = 0; _i < 2; ++_i) \
        __builtin_amdgcn_global_load_lds((const unsigned*)((const char*)(gbase) + (voff)[_i]), (PG8_LAS unsigned*)(lds + (bufoff) + ldsw + _i * 8192), 16, 0, 0); } while (0)
#define PG8_LDA(dst, b, h) do { _Pragma("unroll") for (int m = 0; m < 4; ++m) _Pragma("unroll") for (int k = 0; k < 2; ++k) dst[m][k] = *(const PG8_LAS bf16x8*)(lds + PG8_SA(b, h) + aoff + m * 2048 + k * 1024); } while (0)
#define PG8_LDB(dst, b, h) do { _Pragma("unroll") for (int n = 0; n < 2; ++n) _Pragma("unroll") for (int k = 0; k < 2; ++k) dst[n][k] = *(const PG8_LAS bf16x8*)(lds + PG8_SB(b, h) + boff + n * 2048 + k * 1024); } while (0)
#define PG8_MMA(ai, bj, At, Bt) do { __builtin_amdgcn_s_setprio(1); _Pragma("unroll") for (int m = 0; m < 4; ++m) _Pragma("unroll") for (int n = 0; n < 2; ++n) _Pragma("unroll") for (int k = 0; k < 2; ++k) \
        acc[ai][bj][m][n] = __builtin_amdgcn_mfma_f32_16x16x32_bf16(Bt[n][k], At[m][k], acc[ai][bj][m][n], 0, 0, 0); __builtin_amdgcn_s_setprio(0); } while (0)
#define PG8_WAIT_V(n) asm volatile("s_waitcnt vmcnt(" #n ")" ::: "memory")
#define PG8_WAIT_L(n) asm volatile("s_waitcnt lgkmcnt(" #n ")" ::: "memory")
#define PG8_BAR __builtin_amdgcn_s_barrier()
#define PG8_SCHED __builtin_amdgcn_sched_barrier(0)
    Unit cur, nxt; int ui = 0;
    if (!S.next(0, cur)) return;
    f32x4 acc[2][2][4][2];
#pragma unroll
    for (int a = 0; a < 2; ++a)
#pragma unroll
        for (int b = 0; b < 2; ++b)
#pragma unroll
            for (int m = 0; m < 4; ++m)
#pragma unroll
                for (int n = 0; n < 2; ++n) acc[a][b][m][n] = (f32x4){0.f, 0.f, 0.f, 0.f};
    bf16x8 At[4][2], B0[2][2], B1[2][2];
    const char* cA = (const char*)g.A + (size_t)cur.pm * tstep; const char* cB = (const char*)g.Bt + (size_t)cur.pn * tstep;
    S.a_ready(cur);
    if constexpr (SP2) {
        PG8_STAGE(PG8_SB(0, 0), cB, voffB); PG8_STAGE(PG8_SB(0, 1), cB + hstep, voffB); PG8_STAGE(PG8_SA(0, 0), cA, voffA); PG8_STAGE(PG8_SA(0, 1), cA + hstep, voffA);
        if (wr == 1) PG8_BAR;
        PG8_WAIT_V(2); PG8_BAR;
        PG8_STAGE(PG8_SB(1, 0), cB + kstep, voffB); PG8_STAGE(PG8_SA(1, 0), cA + kstep, voffA); PG8_STAGE(PG8_SB(1, 1), cB + hstep + kstep, voffB);
        PG8_WAIT_V(6); PG8_BAR;
    } else {
        PG8_STAGE(PG8_SB(0, 0), cB, voffB); PG8_STAGE(PG8_SA(0, 0), cA, voffA); PG8_STAGE(PG8_SB(0, 1), cB + hstep, voffB); PG8_STAGE(PG8_SA(0, 1), cA + hstep, voffA);
        if (wr == 1) PG8_BAR;
        PG8_WAIT_V(4); PG8_BAR;
        PG8_STAGE(PG8_SB(1, 0), cB + kstep, voffB); PG8_STAGE(PG8_SA(1, 0), cA + kstep, voffA); PG8_STAGE(PG8_SB(1, 1), cB + hstep + kstep, voffB);
        PG8_WAIT_V(6); PG8_BAR;
    }
    for (;;) {
        const bool has_next = S.next(ui + 1, nxt);
        const char* nA = has_next ? (const char*)g.A + (size_t)nxt.pm * tstep : cA; const char* nB = has_next ? (const char*)g.Bt + (size_t)nxt.pn * tstep : cB;
        for (int t = 0; t < nt; t += 2) {
            const bool last = (t == nt - 2);
            const char* a1 = cA + (size_t)(t + 1) * kstep;
            const char* a2 = last ? nA : cA + (size_t)(t + 2) * kstep; const char* b2 = last ? nB : cB + (size_t)(t + 2) * kstep;
            const char* a3 = a2 + kstep; const char* b3 = b2 + kstep;
            if (last && has_next) S.a_ready(nxt);
            if constexpr (SP2) {
            PG8_LDB(B0, 0, 0); PG8_LDB(B1, 0, 1); PG8_SCHED; PG8_LDA(At, 0, 0); PG8_STAGE(PG8_SA(1, 1), a1 + hstep, voffA);
            PG8_WAIT_V(8); PG8_WAIT_L(0); PG8_BAR; PG8_MMA(0, 0, At, B0); PG8_MMA(0, 1, At, B1); PG8_BAR; PG8_SCHED;
            PG8_LDA(At, 0, 1); PG8_STAGE(PG8_SB(0, 0), b2, voffB); PG8_STAGE(PG8_SB(0, 1), b2 + hstep, voffB); PG8_STAGE(PG8_SA(0, 0), a2, voffA);
            PG8_WAIT_V(8); PG8_WAIT_L(0); PG8_BAR; PG8_MMA(1, 0, At, B0); PG8_MMA(1, 1, At, B1); PG8_BAR; PG8_SCHED;
            PG8_LDB(B0, 1, 0); PG8_LDB(B1, 1, 1); PG8_SCHED; PG8_LDA(At, 1, 0); PG8_STAGE(PG8_SA(0, 1), a2 + hstep, voffA);
            PG8_WAIT_V(8); PG8_WAIT_L(0); PG8_BAR; PG8_MMA(0, 0, At, B0); PG8_MMA(0, 1, At, B1); PG8_BAR; PG8_SCHED;
            PG8_LDA(At, 1, 1); PG8_STAGE(PG8_SB(1, 0), b3, voffB); PG8_STAGE(PG8_SB(1, 1), b3 + hstep, voffB); PG8_STAGE(PG8_SA(1, 0), a3, voffA);
            PG8_WAIT_V(8); PG8_WAIT_L(0); PG8_BAR; PG8_MMA(1, 0, At, B0); PG8_MMA(1, 1, At, B1); PG8_BAR; PG8_SCHED;
            } else {
            PG8_LDB(B0, 0, 0); PG8_SCHED; PG8_LDA(At, 0, 0); PG8_STAGE(PG8_SA(1, 1), a1 + hstep, voffA);
            PG8_WAIT_L(8); PG8_BAR; PG8_WAIT_L(0); PG8_MMA(0, 0, At, B0); PG8_BAR; PG8_SCHED;
            PG8_LDB(B1, 0, 1); PG8_STAGE(PG8_SB(0, 0), b2, voffB);
            PG8_BAR; PG8_WAIT_L(0); PG8_MMA(0, 1, At, B1); PG8_BAR;
            PG8_LDA(At, 0, 1); PG8_STAGE(PG8_SA(0, 0), a2, voffA);
            PG8_BAR; PG8_WAIT_L(0); PG8_MMA(1, 0, At, B0); PG8_BAR; PG8_SCHED;
            PG8_STAGE(PG8_SB(0, 1), b2 + hstep, voffB);
            PG8_WAIT_V(6); PG8_BAR; PG8_MMA(1, 1, At, B1); PG8_BAR;
            PG8_LDB(B0, 1, 0); PG8_SCHED; PG8_LDA(At, 1, 0); PG8_STAGE(PG8_SA(0, 1), a2 + hstep, voffA);
            PG8_WAIT_L(8); PG8_BAR; PG8_WAIT_L(0); PG8_MMA(0, 0, At, B0); PG8_BAR; PG8_SCHED;
            PG8_LDB(B1, 1, 1); PG8_STAGE(PG8_SB(1, 0), b3, voffB);
            PG8_BAR; PG8_WAIT_L(0); PG8_MMA(0, 1, At, B1); PG8_BAR;
            PG8_LDA(At, 1, 1); PG8_STAGE(PG8_SA(1, 0), a3, voffA);
            PG8_BAR; PG8_WAIT_L(0); PG8_MMA(1, 0, At, B0); PG8_BAR; PG8_SCHED;
            PG8_STAGE(PG8_SB(1, 1), b3 + hstep, voffB);
            PG8_WAIT_V(6); PG8_BAR; PG8_MMA(1, 1, At, B1); PG8_BAR;
            }
        }
        if constexpr (ALIGN_EPI) { if (wr == 0) PG8_BAR; }
        if constexpr (!Epi::AFTER_DRAIN) { E(acc, cur, wr, wc, fr, fq); S.done(cur); }
        if (!has_next) break;
#pragma unroll
        for (int a = 0; a < 2; ++a)
#pragma unroll
            for (int b = 0; b < 2; ++b)
#pragma unroll
                for (int m = 0; m < 4; ++m)
#pragma unroll
                    for (int n = 0; n < 2; ++n) acc[a][b][m][n] = (f32x4){0.f, 0.f, 0.f, 0.f};
        cur = nxt; cA = nA; cB = nB; ++ui;
        if constexpr (ALIGN_EPI) { if (wr == 1) PG8_BAR; }
    }
    PG8_WAIT_V(0);
    if constexpr (!ALIGN_EPI) { if (wr == 0) PG8_BAR; }
    PG8_BAR;
    if constexpr (Epi::AFTER_DRAIN) { E.fused(acc, cur, wr, wc, fr, fq, lds, wid, lane); S.done(cur); }
#undef PG8_SA
#undef PG8_SB
#undef PG8_STAGE
#undef PG8_LDA
#undef PG8_LDB
#undef PG8_MMA
#undef PG8_WAIT_V
#undef PG8_WAIT_L
#undef PG8_BAR
#undef PG8_SCHED
}
}

typedef unsigned short bf16_t;
typedef short bf16x8 __attribute__((ext_vector_type(8)));
typedef float f32x4 __attribute__((ext_vector_type(4)));
constexpr int NT = 512;
constexpr int DM = 2048, NB = 4, SL = 8192, CL = 256, MLAT = NB * SL, MCTX = NB * CL, MALL = MLAT + MCTX;
constexpr int NHD = 8, HD = 128, CHK = 64, DFF = 5632, N1 = 7424;
constexpr int NCHUNK = 132;
constexpr int NITEM = NB * NCHUNK * NHD;
constexpr float EPSF = 1e-6f;
constexpr int LDS_BYTES = 156 * 1024;

constexpr size_t al256(size_t x) { return (x + 255) & ~(size_t)255; }
constexpr size_t OFF_MOD = 0;
constexpr size_t OFF_GSC = OFF_MOD + al256((size_t)5 * 6 * DM * 4);
constexpr size_t OFF_GATES = OFF_GSC + al256((size_t)NITEM * 2 * 192 * 4);
constexpr size_t OFF_WIN = OFF_GATES + al256((size_t)MALL * 32 * 4);
constexpr size_t OFF_WOUT = OFF_WIN + al256((size_t)N1 * DM * 2);
constexpr size_t OFF_WGU = OFF_WOUT + al256((size_t)DM * DM * 2);
constexpr size_t OFF_WDOWN = OFF_WGU + al256((size_t)2 * DFF * DM * 2);
constexpr size_t OFF_H = OFF_WDOWN + al256((size_t)DM * DFF * 2);
constexpr size_t OFF_PGDN = OFF_H + al256((size_t)MALL * DM * 2);
constexpr size_t OFF_PZ = OFF_PGDN + al256((size_t)MALL * 3072 * 2);
constexpr size_t OFF_PHY = OFF_PZ + al256((size_t)MALL * 1024 * 2);
constexpr size_t OFF_UHT = OFF_PHY + al256((size_t)MALL * 3072 * 2);
constexpr size_t OFF_TAPS = OFF_UHT + al256((size_t)NB * 1024 * SL * 4);
constexpr size_t END_TAPS = OFF_TAPS + al256((size_t)1024 * 16384 * 4);
constexpr size_t OFF_KSPEC = END_TAPS;
constexpr size_t OFF_KT = OFF_PHY;
constexpr size_t OFF_Q = OFF_KT + (size_t)NITEM * 16384;
constexpr size_t OFF_UW = OFF_Q + (size_t)NITEM * 16384;
constexpr size_t OFF_ATT = OFF_UW + (size_t)NITEM * 2 * 32768;
constexpr size_t END_G2 = OFF_ATT + (size_t)NITEM * 2 * 8192;
constexpr size_t WS_END = END_G2 > END_TAPS ? END_G2 : END_TAPS;
constexpr size_t OFF_S1B = OFF_UHT;
constexpr size_t OFF_OF = OFF_PGDN;
constexpr size_t OFF_OB = OFF_PGDN + (size_t)MLAT * 1024 * 2;
constexpr size_t OFF_OUT = OFF_PGDN;
constexpr size_t OFF_ACT = OFF_PGDN;
constexpr size_t OFF_FF = OFF_H;
static_assert((size_t)MLAT * DFF * 2 <= OFF_UHT - OFF_PGDN, "act overlay");
constexpr size_t OFF_BAR = al256(WS_END);
constexpr size_t WS_TOTAL = OFF_BAR + 16384;
static_assert(WS_TOTAL <= ((size_t)1 << 30), "workspace over 1 GiB");

struct Params { const float* in[32]; float* out; unsigned char* ws; int ph_lo, ph_hi; };

__device__ __forceinline__ float bf_lo(unsigned w) { return __uint_as_float(w << 16); }
__device__ __forceinline__ float bf_hi(unsigned w) { return __uint_as_float(w & 0xffff0000u); }
__device__ __forceinline__ float bf2f(bf16_t v) { return __uint_as_float(((unsigned)v) << 16); }
__device__ __forceinline__ unsigned pk2(float lo, float hi) { return pg8::cvt_pk_bf16(lo, hi); }
__device__ __forceinline__ unsigned pk2_c(float lo, float hi) { unsigned a = __float_as_uint(lo), b = __float_as_uint(hi);
    a += 0x7fffu + ((a >> 16) & 1u); b += 0x7fffu + ((b >> 16) & 1u); return (a >> 16) | (b & 0xffff0000u); }
__device__ __forceinline__ bf16_t f2bf(float f) { return (bf16_t)(pk2(f, 0.f) & 0xffffu); }
__device__ __forceinline__ float silu(float x) { return x * __builtin_amdgcn_rcpf(1.0f + __expf(-x)); }
__device__ __forceinline__ void unpack8(const uint4 w, float (&f)[8]) {
    f[0] = bf_lo(w.x); f[1] = bf_hi(w.x); f[2] = bf_lo(w.y); f[3] = bf_hi(w.y); f[4] = bf_lo(w.z); f[5] = bf_hi(w.z); f[6] = bf_lo(w.w); f[7] = bf_hi(w.w);
}
__device__ __forceinline__ uint4 pack8(const float (&f)[8]) { uint4 w; w.x = pk2(f[0], f[1]); w.y = pk2(f[2], f[3]); w.z = pk2(f[4], f[5]); w.w = pk2(f[6], f[7]); return w; }
__device__ __forceinline__ float fsin(float x) { return __builtin_amdgcn_sinf(__builtin_amdgcn_fractf(x * 0.15915494309189535f)); }
__device__ __forceinline__ float wave_sum(float v) {
#pragma unroll
    for (int o = 32; o >= 1; o >>= 1) v += __shfl_xor(v, o);
    return v;
}

__device__ __forceinline__ void adaln_block(const Params& p, unsigned char* lds, int cb) {
    float* sc = (float*)lds;
    float* red = (float*)(lds + 5 * DM * 4);
    const int tid = otid();
    const float* c = p.in[1]; const float* cc = p.in[3]; const float* wm = p.in[4]; const float* bm = p.in[5];
    for (int i = tid; i < 5 * DM; i += NT) { const int r = i / DM, k = i % DM; const float v = r < 4 ? c[r * DM + k] : cc[k]; sc[i] = silu(v); }
    __syncthreads();
    const int l4 = tid % 12, kg = tid / 12;
    if (tid < 504) {
        float acc[5][4];
#pragma unroll
        for (int r = 0; r < 5; ++r)
#pragma unroll
            for (int j = 0; j < 4; ++j) acc[r][j] = 0.f;
#pragma unroll 7
        for (int k = kg; k < DM; k += 42) {
            const float4 w = *(const float4*)(wm + (size_t)k * (6 * DM) + cb * 48 + l4 * 4);
#pragma unroll
            for (int r = 0; r < 5; ++r) { const float s = sc[r * DM + k]; acc[r][0] += s * w.x; acc[r][1] += s * w.y; acc[r][2] += s * w.z; acc[r][3] += s * w.w; }
        }
#pragma unroll
        for (int r = 0; r < 5; ++r)
#pragma unroll
            for (int j = 0; j < 4; ++j) red[(kg * 5 + r) * 48 + l4 * 4 + j] = acc[r][j];
    }
    __syncthreads();
    if (tid < 240) {
        const int r = tid / 48, col = tid % 48; float s = 0.f;
        for (int g = 0; g < 42; ++g) s += red[(g * 5 + r) * 48 + col];
        float* MOD = (float*)(p.ws + OFF_MOD);
        MOD[r * (6 * DM) + cb * 48 + col] = s + bm[cb * 48 + col];
    }
    __syncthreads();
}

__device__ __forceinline__ void taps_block(const Params& p, unsigned char* lds, int tile) {
    float* zs = (float*)lds;
    float* h1 = zs + 32 * 33;
    float* h2 = h1 + 32 * 65;
    float* h3 = h2 + 32 * 65;
    float* w4s = (float*)(lds + 32768);
    const int tid = otid(), t0 = tile * 32;
    const float* w1 = p.in[17]; const float* b1 = p.in[18]; const float* f1 = p.in[19];
    const float* w2 = p.in[20]; const float* b2 = p.in[21]; const float* f2 = p.in[22];
    const float* w3 = p.in[23]; const float* b3 = p.in[24]; const float* f3 = p.in[25];
    const float* w4 = p.in[26]; const float* hb = p.in[27];
    float* ws1 = w4s; float* ws2 = w4s + 2112; float* ws3 = ws2 + 4096;
    for (int i = tid; i < 2112 / 4; i += NT) *(float4*)(ws1 + 4 * i) = *(const float4*)(w1 + 4 * i);
    for (int i = tid; i < 1024; i += NT) { *(float4*)(ws2 + 4 * i) = *(const float4*)(w2 + 4 * i); *(float4*)(ws3 + 4 * i) = *(const float4*)(w3 + 4 * i); }
    for (int i = tid; i < 32 * 33; i += NT) {
        const int r = i / 33, f = i % 33; const float t = (float)(t0 + r);
        float v;
        if (f == 0) v = t / 8191.0f;
        else { const int bi = (f - 1) & 15; const float fr = 1e-4f + (float)bi * ((15.0f - 1e-4f) / 15.0f); const float rev = t * fr * (1.0f / 8192.0f);
            v = (f <= 16) ? __builtin_amdgcn_cosf(__builtin_amdgcn_fractf(rev)) : -__builtin_amdgcn_sinf(__builtin_amdgcn_fractf(rev)); }
        zs[i] = v;
    }
    __syncthreads();
    const int row = tid & 31, ug = tid >> 5;
    {   float a[4] = {0.f, 0.f, 0.f, 0.f};
#pragma unroll 3
        for (int k = 0; k < 33; ++k) { const float z = zs[row * 33 + k]; const float4 w = *(const float4*)(ws1 + k * 64 + ug * 4); a[0] += z * w.x; a[1] += z * w.y; a[2] += z * w.z; a[3] += z * w.w; }
#pragma unroll
        for (int j = 0; j < 4; ++j) h1[row * 65 + ug * 4 + j] = fsin(f1[ug * 4 + j] * (a[j] + b1[ug * 4 + j]));
    }
    __syncthreads();
    {   float a[4] = {0.f, 0.f, 0.f, 0.f};
#pragma unroll 4
        for (int k = 0; k < 64; ++k) { const float z = h1[row * 65 + k]; const float4 w = *(const float4*)(ws2 + k * 64 + ug * 4); a[0] += z * w.x; a[1] += z * w.y; a[2] += z * w.z; a[3] += z * w.w; }
#pragma unroll
        for (int j = 0; j < 4; ++j) h2[row * 65 + ug * 4 + j] = fsin(f2[ug * 4 + j] * (a[j] + b2[ug * 4 + j]));
    }
    __syncthreads();
    {   float a[4] = {0.f, 0.f, 0.f, 0.f};
#pragma unroll 4
        for (int k = 0; k < 64; ++k) { const float z = h2[row * 65 + k]; const float4 w = *(const float4*)(ws3 + k * 64 + ug * 4); a[0] += z * w.x; a[1] += z * w.y; a[2] += z * w.z; a[3] += z * w.w; }
#pragma unroll
        for (int j = 0; j < 4; ++j) h3[row * 65 + ug * 4 + j] = fsin(f3[ug * 4 + j] * (a[j] + b3[ug * 4 + j]));
    }
    __syncthreads();
    bf16_t* Ah = (bf16_t*)(lds + 98304); bf16_t* Al = Ah + 32 * 72;
    {   float hv[4]; unsigned short hh[4], hl[4];
#pragma unroll
        for (int j = 0; j < 4; ++j) { hv[j] = h3[row * 65 + ug * 4 + j]; const unsigned u = pk2_c(hv[j], 0.f) & 0xffffu; hh[j] = (unsigned short)u; hl[j] = (unsigned short)(pk2_c(hv[j] - __uint_as_float(u << 16), 0.f) & 0xffffu); }
        uint2 wh, wl; wh.x = hh[0] | ((unsigned)hh[1] << 16); wh.y = hh[2] | ((unsigned)hh[3] << 16); wl.x = hl[0] | ((unsigned)hl[1] << 16); wl.y = hl[2] | ((unsigned)hl[3] << 16);
        *(uint2*)(Ah + row * 72 + ug * 4) = wh; *(uint2*)(Al + row * 72 + ug * 4) = wl; }
    float* TAPS = (float*)(p.ws + OFF_TAPS);
    const float mind = -3.0701134573253946f, maxd = -15.350567286626973f;
    const int lane = tid & 63, wid = __builtin_amdgcn_readfirstlane(tid >> 6), fr = lane & 15, fq = lane >> 4;
    for (int cc = 0; cc < 8; ++cc) {
        for (int i = tid; i < 64 * 64; i += NT) { const int k = i >> 6, c4 = (i & 63) * 4; *(float4*)(w4s + k * 256 + c4) = *(const float4*)(w4 + (size_t)k * 2048 + cc * 256 + c4); }
        __syncthreads();
#pragma unroll 1
        for (int nn = 0; nn < 2; ++nn) {
            const int nt = wid * 2 + nn;
            f32x4 acc[2]; acc[0] = (f32x4){0.f, 0.f, 0.f, 0.f}; acc[1] = (f32x4){0.f, 0.f, 0.f, 0.f};
#pragma unroll
            for (int ks = 0; ks < 2; ++ks) {
                bf16x8 bh, bl;
#pragma unroll
                for (int e = 0; e < 8; ++e) { const float x = w4s[(32 * ks + 8 * fq + e) * 256 + 16 * nt + fr]; const unsigned u = pk2_c(x, 0.f) & 0xffffu;
                    bh[e] = (short)u; bl[e] = (short)(pk2_c(x - __uint_as_float(u << 16), 0.f) & 0xffffu); }
#pragma unroll
                for (int mt = 0; mt < 2; ++mt) {
                    const bf16x8 ah = *(const bf16x8*)(Ah + (16 * mt + fr) * 72 + 32 * ks + 8 * fq), al = *(const bf16x8*)(Al + (16 * mt + fr) * 72 + 32 * ks + 8 * fq);
                    acc[mt] = __builtin_amdgcn_mfma_f32_16x16x32_bf16(ah, bh, acc[mt], 0, 0, 0);
                    acc[mt] = __builtin_amdgcn_mfma_f32_16x16x32_bf16(ah, bl, acc[mt], 0, 0, 0);
                    acc[mt] = __builtin_amdgcn_mfma_f32_16x16x32_bf16(al, bh, acc[mt], 0, 0, 0);
                }
            }
            const int c2 = cc * 256 + 16 * nt + fr, c = c2 & 1023;
            const float delta = fabsf(mind + (float)c * ((maxd - mind) / 1023.0f));
#pragma unroll
            for (int mt = 0; mt < 2; ++mt)
#pragma unroll
                for (int r = 0; r < 4; ++r) {
                    const int t = t0 + 16 * mt + 4 * fq + r; const float t01 = (float)t / 8191.0f;
                    float v = acc[mt][r] * __expf(-t01 * delta);
                    if (c2 < 1024) { if (t == 0) v += hb[c]; TAPS[(size_t)c * 16384 + t] = v; }
                    else { if (t == 0) TAPS[(size_t)c * 16384 + 8192] = 0.f; else TAPS[(size_t)c * 16384 + 16384 - t] = v; }
                }
        }
        __syncthreads();
    }
}

struct TDesc { const float* src; bf16_t* dst; int srcN, scol, K, kt, nt; };
__device__ __forceinline__ void transpose_decode(const Params& p, int idx, int tid, TDesc& d) {
    int mode, nK;
    if (idx < 928) { mode = 0; nK = 8; } else if (idx < 1184) { mode = 1; nK = 8; idx -= 928; } else if (idx < 2592) { mode = 2; nK = 8; idx -= 1184; } else { mode = 3; nK = 22; idx -= 2592; }
    d.kt = idx % nK; d.nt = idx / nK; d.K = (mode == 3) ? DFF : DM;
    d.dst = (bf16_t*)(p.ws + (mode == 0 ? OFF_WIN : mode == 1 ? OFF_WOUT : mode == 2 ? OFF_WGU : OFF_WDOWN));
    const int nc = (tid & 15) * 4, n = d.nt * 64 + nc;
    if (mode == 0) { d.src = p.in[10]; d.srcN = 7200; d.scol = (n < 3072) ? n : (n < 7168) ? n + 32 : (n < 7200) ? n - 4096 : -1; }
    else if (mode == 1) { d.src = p.in[28]; d.srcN = DM; d.scol = n; }
    else if (mode == 2) { const int pn = n >> 8, w = n & 255; d.src = (w < 128) ? p.in[29] : p.in[30]; d.srcN = DFF; d.scol = pn * 128 + (w & 127); }
    else { d.src = p.in[31]; d.srcN = DM; d.scol = n; }
}
__device__ __forceinline__ void transpose_load(const TDesc& d, int tid, float4 (&v)[8]) {
    const int kr = tid >> 4;
#pragma unroll
    for (int it = 0; it < 8; ++it) { v[it] = make_float4(0.f, 0.f, 0.f, 0.f); if (d.scol >= 0) v[it] = *(const float4*)(d.src + (size_t)(d.kt * 256 + kr + it * 32) * d.srcN + d.scol); }
}
__device__ __forceinline__ void transpose_store(const TDesc& d, int tid, const float4 (&v)[8], float* tile  ) {
    const int kr = tid >> 4, nc = (tid & 15) * 4;
#pragma unroll
    for (int it = 0; it < 8; ++it) { float* tp = tile + (kr + it * 32) * 65 + nc; tp[0] = v[it].x; tp[1] = v[it].y; tp[2] = v[it].z; tp[3] = v[it].w; }
    __syncthreads();
    {   const int nn = tid >> 3, k8 = (tid & 7) * 8;
#pragma unroll
        for (int w = 0; w < 4; ++w) { float f[8];
#pragma unroll
            for (int j = 0; j < 8; ++j) f[j] = tile[(k8 + 64 * w + j) * 65 + nn];
            *(uint4*)(d.dst + (size_t)(d.nt * 64 + nn) * d.K + d.kt * 256 + k8 + 64 * w) = pack8(f); }
    }
    __syncthreads();
}

__device__ __forceinline__ void phase_prologue(const Params& p, unsigned char* lds) {
    const int G = gridDim.x, bx = blockIdx.x;
#ifndef P0_MASK
#define P0_MASK 7
#endif
    if (P0_MASK & 1) for (int cb = bx; cb < 256; cb += G) adaln_block(p, lds, cb);
    if (P0_MASK & 2) for (int t = bx; t < 256; t += G) taps_block(p, lds, t);
    if (P0_MASK & 4) {
        const int tid = otid(); float4 v[8], vn[8]; TDesc d, dn; int i = bx;
        if (i < 3296) { transpose_decode(p, i, tid, d); transpose_load(d, tid, v); }
        for (; i < 3296; i += G) {
            if (i + G < 3296) { transpose_decode(p, i + G, tid, dn); transpose_load(dn, tid, vn); }
            transpose_store(d, tid, v, (float*)lds);
            d = dn;
#pragma unroll
            for (int it = 0; it < 8; ++it) v[it] = vn[it];
        }
    }
}

__device__ __forceinline__ void phase_prenorm(const Params& p) {
    const int tid_ = otid(), lane = tid_ & 63, wv = __builtin_amdgcn_readfirstlane(tid_ >> 6);
    const float* MOD = (const float*)(p.ws + OFF_MOD); const float* g = p.in[6];
    bf16_t* H = (bf16_t*)(p.ws + OFF_H);
    const int stride = gridDim.x * 8;
    float4 v[8], vn[8], pa[8], ps[8]; int r_loaded = -1;
#define PRE_SRC(row_) ((row_) < MLAT ? p.in[0] + (size_t)(row_) * DM : p.in[2] + (size_t)((row_) - MLAT) * DM)
    int row = blockIdx.x * 8 + wv;
    if (row < MALL) { const float* src = PRE_SRC(row);
#pragma unroll
        for (int i = 0; i < 8; ++i) v[i] = *(const float4*)(src + 4 * (lane + 64 * i)); }
    for (; row < MALL; row += stride) {
        const int nxt = row + stride;
        if (nxt < MALL) { const float* src = PRE_SRC(nxt);
#pragma unroll
            for (int i = 0; i < 8; ++i) vn[i] = *(const float4*)(src + 4 * (lane + 64 * i)); }
        const int r = row < MLAT ? (row >> 13) : 4;
        if (r != r_loaded) { r_loaded = r;
            const float* sh = MOD + r * (6 * DM); const float* sc = sh + DM;
#pragma unroll
            for (int i = 0; i < 8; ++i) { const int col = 4 * (lane + 64 * i); const float4 gg = *(const float4*)(g + col), s1 = *(const float4*)(sc + col);
                pa[i] = make_float4(gg.x * (1.f + s1.x), gg.y * (1.f + s1.y), gg.z * (1.f + s1.z), gg.w * (1.f + s1.w)); ps[i] = *(const float4*)(sh + col); } }
        float ss = 0.f;
#pragma unroll
        for (int i = 0; i < 8; ++i) ss += v[i].x * v[i].x + v[i].y * v[i].y + v[i].z * v[i].z + v[i].w * v[i].w;
        ss = wave_sum(ss);
        const float rstd = rsqrtf(ss * (1.0f / DM) + EPSF);
#pragma unroll
        for (int i = 0; i < 8; ++i) { const int col = 4 * (lane + 64 * i);
            uint2 w; w.x = pk2(v[i].x * rstd * pa[i].x + ps[i].x, v[i].y * rstd * pa[i].y + ps[i].y);
            w.y = pk2(v[i].z * rstd * pa[i].z + ps[i].z, v[i].w * rstd * pa[i].w + ps[i].w);
            *(uint2*)(H + (size_t)row * DM + col) = w; }
#pragma unroll
        for (int i = 0; i < 8; ++i) v[i] = vn[i];
    }
#undef PRE_SRC
}

__device__ __forceinline__ void phase_hy1(const Params& p, unsigned char* lds) {
    float* tile = (float*)lds;
    const int tid = otid();
    const bf16_t* PHY = (const bf16_t*)(p.ws + OFF_PHY); bf16_t* MIX = (bf16_t*)(p.ws + OFF_H); bf16_t* UHT = (bf16_t*)(p.ws + OFF_UHT);
    const float* cw = p.in[15]; const float* cb = p.in[16];
    const bool g16 = (gridDim.x & 15) == 0;
    const int c8 = (tid & 7) * 8, tr = tid >> 3;
    float wr[3][3][8], br[3][8]; int ct_loaded = -1; uint4 raw[3][3], rawn[3][3];
    for (int k = 0;; ++k) {
        int ct, tt;
        if (g16) { ct = blockIdx.x & 15; tt = (int)(blockIdx.x >> 4) + k * (int)(gridDim.x >> 4); if (tt >= 512) break; }
        else { const int tl = blockIdx.x + k * gridDim.x; if (tl >= 512 * 16) break; ct = tl & 15; tt = tl >> 4; }
        const int c0 = ct * 64, row0 = tt * 64;
        if (ct != ct_loaded) { ct_loaded = ct;
#pragma unroll
            for (int gI = 0; gI < 3; ++gI) { const int col = gI * 1024 + c0 + c8;
#pragma unroll
                for (int j = 0; j < 8; ++j) br[gI][j] = cb[col + j];
#pragma unroll
                for (int i = 0; i < 3; ++i)
#pragma unroll
                    for (int j = 0; j < 8; ++j) wr[gI][i][j] = cw[i * 3072 + col + j]; } }
        const int row = row0 + tr, tpos = row & (SL - 1);
        if (k == 0) {
#pragma unroll
            for (int gI = 0; gI < 3; ++gI)
#pragma unroll
                for (int i = 0; i < 3; ++i) { int tp = tpos + i - 1; tp = tp < 0 ? 0 : (tp >= SL ? SL - 1 : tp);
                    raw[gI][i] = *(const uint4*)(PHY + (size_t)(row - tpos + tp) * 3072 + gI * 1024 + c0 + c8); }
        }
        {
            int ctn, ttn; bool have;
            if (g16) { ctn = ct; ttn = tt + (int)(gridDim.x >> 4); have = ttn < 512; } else { const int tl = blockIdx.x + (k + 1) * gridDim.x; have = tl < 512 * 16; ctn = tl & 15; ttn = tl >> 4; }
            if (have) { const int rown = ttn * 64 + tr, tposn = rown & (SL - 1);
#pragma unroll
                for (int gI = 0; gI < 3; ++gI)
#pragma unroll
                    for (int i = 0; i < 3; ++i) { int tp = tposn + i - 1; tp = tp < 0 ? 0 : (tp >= SL ? SL - 1 : tp);
                        rawn[gI][i] = *(const uint4*)(PHY + (size_t)(rown - tposn + tp) * 3072 + gI * 1024 + ctn * 64 + c8); } }
        }
        float res[3][8];
#pragma unroll
        for (int gI = 0; gI < 3; ++gI) {
            float a[8];
#pragma unroll
            for (int j = 0; j < 8; ++j) a[j] = br[gI][j];
#pragma unroll
            for (int i = 0; i < 3; ++i) {
                const int tp = tpos + i - 1; const float msk = (tp >= 0 && tp < SL) ? 1.0f : 0.0f;
                float f[8]; unpack8(raw[gI][i], f);
#pragma unroll
                for (int j = 0; j < 8; ++j) a[j] += (wr[gI][i][j] * msk) * f[j];
            }
#pragma unroll
            for (int j = 0; j < 8; ++j) res[gI][j] = a[j];
        }
#pragma unroll
        for (int gI = 0; gI < 3; ++gI)
#pragma unroll
            for (int i = 0; i < 3; ++i) raw[gI][i] = rawn[gI][i];
        *(uint4*)(MIX + (size_t)row * DM + 1024 + c0 + c8) = pack8(res[0]);
#pragma unroll
        for (int j = 0; j < 8; ++j) tile[(c8 + j) * 65 + tr] = res[1][j] * res[2][j];
        __syncthreads();
        {   const int c = tid >> 3, t8 = (tid & 7) * 8; const int b = row0 >> 13, tb = (row0 & (SL - 1)) + t8;
            bf16_t* dp = UHT + ((size_t)(b * 1024 + c0 + c)) * SL + tb; float f[8];
#pragma unroll
            for (int j = 0; j < 8; ++j) f[j] = tile[c * 65 + t8 + j];
            *(uint4*)dp = pack8(f); }
        __syncthreads();
    }
}

__device__ __forceinline__ void phase_hy3(const Params& p, unsigned char* lds) {
    float* tile = (float*)lds;
    const int tid = otid();
    bf16_t* MIX = (bf16_t*)(p.ws + OFF_H); const bf16_t* UHT = (const bf16_t*)(p.ws + OFF_UHT);
    const int c = tid >> 3, t8 = (tid & 7) * 8, tr = tid >> 3, c8 = (tid & 7) * 8;
    uint4 uy, um, ny, nm;
#define HY3_LOAD(tl_, y_, m_) do { const int ct_ = (tl_) & 15, tt_ = (tl_) >> 4, c0_ = ct_ * 64, row0_ = tt_ * 64; const int b_ = row0_ >> 13, tb_ = (row0_ & (SL - 1)) + t8; \
        y_ = *(const uint4*)(UHT + ((size_t)(b_ * 1024 + c0_ + c)) * SL + tb_); m_ = *(const uint4*)(MIX + (size_t)(row0_ + tr) * DM + 1024 + c0_ + c8); } while (0)
    int tl = blockIdx.x;
    if (tl < 512 * 16) HY3_LOAD(tl, uy, um);
    for (; tl < 512 * 16; tl += gridDim.x) {
        const int ct = tl & 15, tt = tl >> 4, c0 = ct * 64, row0 = tt * 64;
        if (tl + (int)gridDim.x < 512 * 16) HY3_LOAD(tl + (int)gridDim.x, ny, nm);
        {   float f[8]; unpack8(uy, f); float* tp = tile + c * 65 + t8;
#pragma unroll
            for (int j = 0; j < 8; ++j) tp[j] = f[j]; }
        __syncthreads();
        {   bf16_t* mp = MIX + (size_t)(row0 + tr) * DM + 1024 + c0 + c8;
            float f[8]; unpack8(um, f);
#pragma unroll
            for (int j = 0; j < 8; ++j) f[j] *= tile[(c8 + j) * 65 + tr];
            *(uint4*)mp = pack8(f); }
        __syncthreads();
        uy = ny; um = nm;
    }
#undef HY3_LOAD
}


__device__ __forceinline__ float2 cmul(float2 a, float2 b) { return make_float2(a.x * b.x - a.y * b.y, a.x * b.y + a.y * b.x); }
__device__ __forceinline__ int pidx(int i) { return i + ((i >> 6) << 2); }
template <bool INV> __device__ __forceinline__ float2 mulw16(float2 d, int m) {
    const float C1 = 0.9238795325112867f, S1 = 0.3826834323650898f, C2 = 0.7071067811865476f;
    float c, s;
    switch (m & 7) {
        case 0: return d;
        case 1: c = C1; s = S1; break;
        case 2: c = C2; s = C2; break;
        case 3: c = S1; s = C1; break;
        case 4: return INV ? make_float2(-d.y, d.x) : make_float2(d.y, -d.x);
        case 5: c = -S1; s = C1; break;
        case 6: c = -C2; s = C2; break;
        default: c = -C1; s = S1; break;
    }
    if (!INV) s = -s;
    return make_float2(d.x * c - d.y * s, d.x * s + d.y * c);
}
template <int R> __device__ __forceinline__ constexpr int brev(int q) { int r = 0; for (int b = 1, o = R >> 1; b < R; b <<= 1, o >>= 1) if (q & b) r |= o; return r; }
template <int R, int LOG, int S0 = 0> __device__ __forceinline__ void dft_fwd(float2 (&v)[R]) {
#pragma unroll
    for (int s = S0; s < LOG; ++s) {
        const int h = (R / 2) >> s;
#pragma unroll
        for (int j = 0; j < R; ++j) {
            if (j & h) continue;
            const int m = (j & (h - 1)) * (R / (2 * h)) * (16 / R);
            const float2 a = v[j], b = v[j + h];
            v[j] = make_float2(a.x + b.x, a.y + b.y);
            v[j + h] = mulw16<false>(make_float2(a.x - b.x, a.y - b.y), m);
        }
    }
}
template <int R, int LOG, int S0 = 0> __device__ __forceinline__ void dft_inv(float2 (&v)[R]) {
#pragma unroll
    for (int s = LOG - 1; s >= S0; --s) {
        const int h = (R / 2) >> s;
#pragma unroll
        for (int j = 0; j < R; ++j) {
            if (j & h) continue;
            const int m = (j & (h - 1)) * (R / (2 * h)) * (16 / R);
            const float2 a = v[j], b = mulw16<true>(v[j + h], m);
            v[j] = make_float2(a.x + b.x, a.y + b.y);
            v[j + h] = make_float2(a.x - b.x, a.y - b.y);
        }
    }
}
__device__ __forceinline__ void tw_powers(float2 w1, float2 (&w)[16]) {
    w[1] = w1; w[2] = cmul(w1, w1); w[3] = cmul(w[2], w1); w[4] = cmul(w[2], w[2]); w[5] = cmul(w[4], w1); w[6] = cmul(w[4], w[2]); w[7] = cmul(w[4], w[3]);
    w[8] = cmul(w[4], w[4]);
#pragma unroll
    for (int k = 1; k < 8; ++k) w[8 + k] = cmul(w[8], w[k]);
}
template <int n, bool INV, bool HALF = false, bool TW = false> __device__ __forceinline__ void fft_pass16(float2* X, int tid, const float2 (&wpre)[16]) {
    constexpr int st = n / 16, PST = (st >= 64) ? st + 4 * (st / 64) : st;
#pragma unroll 1
    for (int g = tid; g < 1024; g += NT) {
        int lo = g & (st - 1); asm volatile("" : "+v"(lo));
        const int blk = g / st, base = blk * n + lo;
        float2* Xp = X + pidx(base);
        float2 w[16];
        if (TW) {
#pragma unroll
            for (int k = 1; k < 16; ++k) w[k] = make_float2(wpre[k].x, INV ? -wpre[k].y : wpre[k].y);
        } else {   const float rev = (float)lo * (1.0f / n); const float c = __builtin_amdgcn_cosf(rev), s = __builtin_amdgcn_sinf(rev);
            tw_powers(make_float2(c, INV ? s : -s), w); }
        float2 v[16];
        if (!INV) {
            if (HALF) {
#pragma unroll
                for (int j = 0; j < 8; ++j) { v[j] = Xp[j * PST]; v[j + 8] = mulw16<false>(v[j], j); }
                dft_fwd<16, 4, 1>(v);
            } else {
#pragma unroll
                for (int j = 0; j < 16; ++j) v[j] = Xp[j * PST];
                dft_fwd<16, 4>(v);
            }
#pragma unroll
            for (int q = 1; q < 16; ++q) v[q] = cmul(v[q], w[brev<16>(q)]);
#pragma unroll
            for (int q = 0; q < 16; ++q) Xp[brev<16>(q) * PST] = v[q];
        } else {
#pragma unroll
            for (int q = 0; q < 16; ++q) { const int k = brev<16>(q); float2 t = Xp[k * PST]; if (k) t = cmul(t, w[k]); v[q] = t; }
            if (HALF) {
                dft_inv<16, 4, 1>(v);
#pragma unroll
                for (int j = 0; j < 8; ++j) { const float2 b = mulw16<true>(v[j + 8], j); Xp[j * PST] = make_float2(v[j].x + b.x, v[j].y + b.y); }
            } else {
                dft_inv<16, 4>(v);
#pragma unroll
                for (int j = 0; j < 16; ++j) Xp[j * PST] = v[j];
            }
        }
    }
}
__device__ __forceinline__ void phase_hy2(const Params& p, unsigned char* lds) {
    float2* X = (float2*)lds;
    const int tid = otid();
    const float* TAPS = (const float*)(p.ws + OFF_TAPS); bf16_t* UHT = (bf16_t*)(p.ws + OFF_UHT);
    float2 w64[16];
    {   const float r64 = (float)(tid & 3) * (1.0f / 64.0f);
        tw_powers(make_float2(__builtin_amdgcn_cosf(r64), -__builtin_amdgcn_sinf(r64)), w64); w64[0] = make_float2(1.f, 0.f); }
    for (int c = blockIdx.x; c < 1024; c += gridDim.x) {
        float4* KS = (float4*)(p.ws + OFF_KSPEC) + (size_t)blockIdx.x * 8192;
#pragma unroll
        for (int i = 0; i < 8; ++i) { const int t = 4 * (tid + NT * i); const float4 v = *(const float4*)(TAPS + (size_t)c * 16384 + t);
            float4* xp = (float4*)(X + pidx(t)); xp[0] = make_float4(v.x, 0.f, v.y, 0.f); xp[1] = make_float4(v.z, 0.f, v.w, 0.f); }
        __syncthreads();
        fft_pass16<16384, false, false, false>(X, tid, w64); __syncthreads();
        fft_pass16<1024, false, false, false>(X, tid, w64); __syncthreads();
        fft_pass16<64, false, false, true>(X, tid, w64); __syncthreads();
#pragma unroll 2
        for (int i = 0; i < 8; ++i) { const float4* xp = (const float4*)(X + pidx(4 * (tid + NT * i))); const float4 a = xp[0], b = xp[1];
            float2 v[4] = {make_float2(a.x, a.y), make_float2(a.z, a.w), make_float2(b.x, b.y), make_float2(b.z, b.w)};
            dft_fwd<4, 2>(v);
            const float sc = 1.0f / 16384.0f;
            KS[2 * (tid + NT * i)] = make_float4(v[0].x * sc, v[0].y * sc, v[1].x * sc, v[1].y * sc); KS[2 * (tid + NT * i) + 1] = make_float4(v[2].x * sc, v[2].y * sc, v[3].x * sc, v[3].y * sc); }
        __syncthreads();
        for (int pr = 0; pr < 2; ++pr) {
            bf16_t* u1 = UHT + ((size_t)((2 * pr) * 1024 + c)) * SL; bf16_t* u2 = UHT + ((size_t)((2 * pr + 1) * 1024 + c)) * SL;
#pragma unroll
            for (int i = 0; i < 4; ++i) { const int t = 4 * (tid + NT * i); const uint2 ua = *(const uint2*)(u1 + t), ub = *(const uint2*)(u2 + t);
                const float4 a = make_float4(bf_lo(ua.x), bf_hi(ua.x), bf_lo(ua.y), bf_hi(ua.y)), b = make_float4(bf_lo(ub.x), bf_hi(ub.x), bf_lo(ub.y), bf_hi(ub.y));
                float4* xp = (float4*)(X + pidx(t)); xp[0] = make_float4(a.x, b.x, a.y, b.y); xp[1] = make_float4(a.z, b.z, a.w, b.w); }
            __syncthreads();
            fft_pass16<16384, false, true, false>(X, tid, w64); __syncthreads();
            fft_pass16<1024, false, false, false>(X, tid, w64); __syncthreads();
            fft_pass16<64, false, false, true>(X, tid, w64); __syncthreads();
#pragma unroll 2
            for (int i = 0; i < 8; ++i) { float4* xp = (float4*)(X + pidx(4 * (tid + NT * i))); const float4 a = xp[0], b = xp[1];
                float2 v[4] = {make_float2(a.x, a.y), make_float2(a.z, a.w), make_float2(b.x, b.y), make_float2(b.z, b.w)};
                dft_fwd<4, 2>(v);
                const float4 k0 = KS[2 * (tid + NT * i)], k1 = KS[2 * (tid + NT * i) + 1];
                v[0] = cmul(v[0], make_float2(k0.x, k0.y)); v[1] = cmul(v[1], make_float2(k0.z, k0.w)); v[2] = cmul(v[2], make_float2(k1.x, k1.y)); v[3] = cmul(v[3], make_float2(k1.z, k1.w));
                dft_inv<4, 2>(v);
                xp[0] = make_float4(v[0].x, v[0].y, v[1].x, v[1].y); xp[1] = make_float4(v[2].x, v[2].y, v[3].x, v[3].y); }
            __syncthreads();
            fft_pass16<64, true, false, true>(X, tid, w64); __syncthreads();
            fft_pass16<1024, true, false, false>(X, tid, w64); __syncthreads();
            fft_pass16<16384, true, true, false>(X, tid, w64); __syncthreads();
#pragma unroll
            for (int i = 0; i < 4; ++i) { const int t = 4 * (tid + NT * i); const float4* xp = (const float4*)(X + pidx(t)); const float4 a = xp[0], b = xp[1];
                uint2 w1, w2; w1.x = pk2(a.x, a.z); w1.y = pk2(b.x, b.z); w2.x = pk2(a.y, a.w); w2.y = pk2(b.y, b.w);
                *(uint2*)(u1 + t) = w1; *(uint2*)(u2 + t) = w2; }
            __syncthreads();
        }
    }
}


__device__ __forceinline__ void item_decode(int item, int& b, int& n, int& h, int& row0, int& seq0, int& seqlen) {
    h = item & 7; const int cidx = item >> 3; b = cidx / NCHUNK; n = cidx % NCHUNK;
    if (n < 4) { seq0 = MLAT + b * CL; seqlen = CL; row0 = seq0 + n * CHK; } else { seq0 = b * SL; seqlen = SL; row0 = seq0 + (n - 4) * CHK; }
}
constexpr int G2X_A10 = 0, G2X_T11 = 5120, G2X_T00T = 10240, G2X_XT = 20480, G2X_BYTES = 30720;
template <int D> __device__ __forceinline__ void g2_tinv_diag(const float* As, int lane, const float* rsu, const float* rsw, bf16_t* TM, unsigned char* xl) {
    const int blk = lane >> 5, cc = lane & 31;
    int abase = D * 64 * 68 + blk * (32 * 68 + 32); asm volatile("" : "+v"(abase));
    const float* Ad = As + abase;
    {   const float* ap = As + D * 64 * 68 + cc * 68 + 32 + 16 * blk; bf16_t* a10 = (bf16_t*)(xl + G2X_A10) + D * 32 * 40;
#pragma unroll
        for (int q = 0; q < 4; ++q) { const float4 v = *(const float4*)(ap + 4 * q);
            a10[(16 * blk + 4 * q + 0) * 40 + cc] = f2bf(v.x); a10[(16 * blk + 4 * q + 1) * 40 + cc] = f2bf(v.y); a10[(16 * blk + 4 * q + 2) * 40 + cc] = f2bf(v.z); a10[(16 * blk + 4 * q + 3) * 40 + cc] = f2bf(v.w); } }
    float x[32];
#pragma unroll
    for (int i = 0; i < 32; ++i) x[i] = (i == cc) ? 1.0f : 0.0f;
#pragma clang loop unroll(full)
    for (int j = 0; j < 31; ++j) {
        const float xj = x[j];
        int zj = 0; asm volatile("" : "+v"(zj) : "v"(x[j > 0 ? j - 1 : 0])); zj &= ~3;
#pragma clang loop unroll(full)
        for (int i4 = ((j + 1) & ~3); i4 < 32; i4 += 4) {
            const float4 a = *(const float4*)(Ad + zj + j * 68 + i4);
            if (i4 > j) x[i4] -= a.x * xj;
            if (i4 + 1 > j) x[i4 + 1] -= a.y * xj;
            if (i4 + 2 > j) x[i4 + 2] -= a.z * xj;
            x[i4 + 3] -= a.w * xj;
        }
    }
    const int sj = 32 * blk + cc, jo = D ? 63 - sj : sj;
    const float su = rsu[D * 64 + jo], sw = rsw[D * 64 + jo];
    bf16_t* tu = TM + (D * 2 + 0) * 64 * 72 + jo; bf16_t* tw = TM + (D * 2 + 1) * 64 * 72 + jo;
#pragma unroll
    for (int ii = 0; ii < 32; ++ii) { const int si = 32 * blk + ii, io = D ? 63 - si : si; tu[io * 72] = f2bf(x[ii] * su); tw[io * 72] = f2bf(x[ii] * sw); }
    if (blk == 1) {
        bf16_t* t11 = (bf16_t*)(xl + G2X_T11) + D * 32 * 40 + cc;
#pragma unroll
        for (int ii = 0; ii < 32; ++ii) { const int io = D ? 63 - ii : ii; tu[io * 72] = 0; tw[io * 72] = 0; t11[ii * 40] = f2bf(x[ii]); }
    } else {
        bf16_t* t0u = (bf16_t*)(xl + G2X_T00T) + (D * 2 + 0) * 32 * 40 + cc * 40; bf16_t* t0w = (bf16_t*)(xl + G2X_T00T) + (D * 2 + 1) * 32 * 40 + cc * 40;
#pragma unroll
        for (int q = 0; q < 4; ++q) { uint4 wu, ww;
            wu.x = pk2(x[8 * q] * su, x[8 * q + 1] * su); wu.y = pk2(x[8 * q + 2] * su, x[8 * q + 3] * su); wu.z = pk2(x[8 * q + 4] * su, x[8 * q + 5] * su); wu.w = pk2(x[8 * q + 6] * su, x[8 * q + 7] * su);
            ww.x = pk2(x[8 * q] * sw, x[8 * q + 1] * sw); ww.y = pk2(x[8 * q + 2] * sw, x[8 * q + 3] * sw); ww.z = pk2(x[8 * q + 4] * sw, x[8 * q + 5] * sw); ww.w = pk2(x[8 * q + 6] * sw, x[8 * q + 7] * sw);
            *(uint4*)(t0u + 8 * q) = wu; *(uint4*)(t0w + 8 * q) = ww; }
    }
}
constexpr int G2_KB = 0, G2_QB = 17408, G2_TM = 0  , G2_KT = 36864, G2_VT = 55296, G2_AS = 73728, G2_GT = 108544, G2_XL = 110592;
static_assert(G2_GT + 8 * 64 * 4 <= G2_XL && G2_XL + G2X_BYTES <= LDS_BYTES, "G2 LDS");
__device__ __forceinline__ void phase_gdn_prep(const Params& p, unsigned char* lds) {
    bf16_t* kb = (bf16_t*)(lds + G2_KB); bf16_t* qb = (bf16_t*)(lds + G2_QB); bf16_t* kT = (bf16_t*)(lds + G2_KT); bf16_t* vT = (bf16_t*)(lds + G2_VT);
    float* As = (float*)(lds + G2_AS); bf16_t* TM = (bf16_t*)(lds + G2_TM); float* gt = (float*)(lds + G2_GT); unsigned char* xl = lds + G2_XL;
    float* beta_s = gt; float* gc_s = gt + 128; float* rsu = gt + 256; float* rsw = gt + 384;
    const bf16_t* PG = (const bf16_t*)(p.ws + OFF_PGDN); const float* GATES = (const float*)(p.ws + OFF_GATES);
    const float* cw = p.in[11]; const float* a_log = p.in[12]; const float* dt_bias = p.in[13];
    bf16_t* KT = (bf16_t*)(p.ws + OFF_KT); bf16_t* QO = (bf16_t*)(p.ws + OFF_Q); bf16_t* UW = (bf16_t*)(p.ws + OFF_UW); bf16_t* ATT = (bf16_t*)(p.ws + OFF_ATT);
    float* GSC = (float*)(p.ws + OFF_GSC);
    for (int item = blockIdx.x; item < NITEM; item += gridDim.x) {
        int tid = otid();
        const int lane = tid & 63, wid = __builtin_amdgcn_readfirstlane(tid >> 6), fr = lane & 15, fq = lane >> 4;
        int b, n, h, row0, seq0, seqlen; item_decode(item, b, n, h, row0, seq0, seqlen);
        const bool ctx = n < 4;
        float graw_b = 0.f, graw_a = 0.f;
        if (tid < 128) { const int d = tid >> 6, i = d ? 63 - lane : lane; const float* gp = GATES + (size_t)(row0 + i) * 32; graw_b = gp[d * 8 + h]; graw_a = gp[16 + d * 8 + h]; }
        {   const int r = tid >> 3, c16 = (tid & 7) * 16;
            uint4 raw[3][5][2];
#pragma unroll
            for (int mt = 0; mt < 3; ++mt)
#pragma unroll
                for (int i = 0; i < 5; ++i) { int rr = row0 + r + i - 2; rr = rr < seq0 ? seq0 : (rr >= seq0 + seqlen ? seq0 + seqlen - 1 : rr);
                    const bf16_t* sp = PG + (size_t)rr * 3072 + mt * 1024 + h * 128 + c16; raw[mt][i][0] = *(const uint4*)sp; raw[mt][i][1] = *(const uint4*)(sp + 8); }
#pragma unroll
            for (int mt = 0; mt < 3; ++mt) {
                if (mt == 2 && ctx) break;
                const int col = mt * 1024 + h * 128 + c16;
                float a[16];
#pragma unroll
                for (int j = 0; j < 16; ++j) a[j] = 0.f;
#pragma unroll
                for (int i = 0; i < 5; ++i) {
                    const int rr = row0 + r + i - 2;
                    const float msk = (rr >= seq0 && rr < seq0 + seqlen) ? 1.0f : 0.0f;
                    float f0[8], f1[8]; unpack8(raw[mt][i][0], f0); unpack8(raw[mt][i][1], f1);
                    const float* wp = cw + i * 3072 + col;
#pragma unroll
                    for (int j = 0; j < 8; ++j) { a[j] += (wp[j] * msk) * f0[j]; a[8 + j] += (wp[8 + j] * msk) * f1[j]; }
                }
                float ss = 0.f;
#pragma unroll
                for (int j = 0; j < 16; ++j) { a[j] = silu(a[j]); ss += a[j] * a[j]; }
                if (mt != 1) {
                    ss += __shfl_xor(ss, 1); ss += __shfl_xor(ss, 2); ss += __shfl_xor(ss, 4);
                    const float sc = rsqrtf(ss + EPSF) * (mt == 2 ? 0.08838834764831845f : 1.0f);
#pragma unroll
                    for (int j = 0; j < 16; ++j) a[j] *= sc;
                }
                uint4 w0, w1; w0.x = pk2(a[0], a[1]); w0.y = pk2(a[2], a[3]); w0.z = pk2(a[4], a[5]); w0.w = pk2(a[6], a[7]);
                w1.x = pk2(a[8], a[9]); w1.y = pk2(a[10], a[11]); w1.z = pk2(a[12], a[13]); w1.w = pk2(a[14], a[15]);
                if (mt == 0) {
                    *(uint4*)(kb + r * 136 + c16) = w0; *(uint4*)(kb + r * 136 + c16 + 8) = w1;
#pragma unroll
                    for (int j = 0; j < 16; ++j) kT[(c16 + j) * 72 + r] = f2bf(a[j]);
                } else if (mt == 1) {
#pragma unroll
                    for (int j = 0; j < 16; ++j) vT[(c16 + j) * 72 + r] = f2bf(a[j]);
                } else {
                    *(uint4*)(qb + r * 136 + c16) = w0; *(uint4*)(qb + r * 136 + c16 + 8) = w1;
                    bf16_t* qp = QO + (size_t)item * 8192 + r * 128 + c16; *(uint4*)qp = w0; *(uint4*)(qp + 8) = w1;
                }
            }
        }
        if (tid < 128) {
            const int d = tid >> 6, i = d ? 63 - lane : lane;
            const float beta = 1.0f / (1.0f + __expf(-graw_b));
            const float x = graw_a + dt_bias[d * 8 + h];
            const float sp = x > 20.f ? x : __logf(1.0f + __expf(x));
            float g = -__expf(a_log[d * 8 + h]) * sp;
#pragma unroll
            for (int o = 1; o < 64; o <<= 1) { const float t = __shfl_up(g, o); if (lane >= o) g += t; }
            const float glast = __shfl(g, 63);
            const float eg = __expf(g), ee = __expf(glast - g);
            beta_s[d * 64 + i] = beta; gc_s[d * 64 + i] = g; rsu[d * 64 + i] = beta; rsw[d * 64 + i] = beta * eg;
            float* gs = GSC + ((size_t)item * 2 + d) * 192; gs[i] = eg; gs[64 + i] = ee; if (lane == 63) gs[128] = __expf(glast);
        }
        __syncthreads();
#pragma unroll
        for (int i = 0; i < 2; ++i) { const int q16 = tid + NT * i; *(uint4*)(KT + (size_t)item * 8192 + (size_t)q16 * 8) = *(const uint4*)(kT + (q16 >> 3) * 72 + (q16 & 7) * 8); }
        {   const int mt = wid >> 1, ntp = wid & 1;
            f32x4 ckk[2], cqk[2];
#pragma unroll
            for (int e = 0; e < 2; ++e) { ckk[e] = (f32x4){0.f, 0.f, 0.f, 0.f}; cqk[e] = (f32x4){0.f, 0.f, 0.f, 0.f}; }
#pragma unroll
            for (int ks = 0; ks < 4; ++ks) {
                const bf16x8 ak = *(const bf16x8*)(kb + (16 * mt + fr) * 136 + 32 * ks + 8 * fq);
                bf16x8 aq = ak; if (!ctx) aq = *(const bf16x8*)(qb + (16 * mt + fr) * 136 + 32 * ks + 8 * fq);
#pragma unroll
                for (int e = 0; e < 2; ++e) { const bf16x8 bk = *(const bf16x8*)(kb + (16 * (2 * ntp + e) + fr) * 136 + 32 * ks + 8 * fq);
                    ckk[e] = __builtin_amdgcn_mfma_f32_16x16x32_bf16(ak, bk, ckk[e], 0, 0, 0);
                    cqk[e] = __builtin_amdgcn_mfma_f32_16x16x32_bf16(aq, bk, cqk[e], 0, 0, 0); }
            }
#pragma unroll
            for (int e = 0; e < 2; ++e)
#pragma unroll
                for (int r = 0; r < 4; ++r) {
                    const int i = 16 * mt + 4 * fq + r, j = 16 * (2 * ntp + e) + fr;
#pragma unroll
                    for (int d = 0; d < 2; ++d) {
                        const bool before = d ? (j > i) : (j < i); const bool incl = before || (i == j);
                        const float df = incl ? gc_s[d * 64 + i] - gc_s[d * 64 + j] : 0.f; const float ex = __expf(df);
                        const float av = before ? beta_s[d * 64 + i] * ckk[e][r] * ex : 0.f;
                        const int ii = d ? 63 - i : i, jj = d ? 63 - j : j;
                        As[(d * 64 + jj) * 68 + ii] = av;
                        if (!ctx) ATT[((size_t)item * 2 + d) * 4096 + i * 64 + j] = f2bf(incl ? cqk[e][r] * ex : 0.f);
                    }
                }
        }
        __syncthreads();
        if (wid == 0) g2_tinv_diag<0>(As, lane, rsu, rsw, TM, xl);
        else if (wid == 1) g2_tinv_diag<1>(As, lane, rsu, rsw, TM, xl);
        __syncthreads();
        {   const int dd = wid >> 2, vv = (wid >> 1) & 1, mh = wid & 1;
            const bf16_t* a10 = (const bf16_t*)(xl + G2X_A10) + dd * 32 * 40; const bf16_t* t11 = (const bf16_t*)(xl + G2X_T11) + dd * 32 * 40;
            const bf16_t* t0t = (const bf16_t*)(xl + G2X_T00T) + (dd * 2 + vv) * 32 * 40; bf16_t* xt = (bf16_t*)(xl + G2X_XT) + (dd * 2 + vv) * 32 * 40;
            const bf16x8 aA = *(const bf16x8*)(a10 + (16 * mh + fr) * 40 + 8 * fq);
#pragma unroll
            for (int nt = 0; nt < 2; ++nt) { const bf16x8 bT = *(const bf16x8*)(t0t + (16 * nt + fr) * 40 + 8 * fq);
                f32x4 acc = (f32x4){0.f, 0.f, 0.f, 0.f}; acc = __builtin_amdgcn_mfma_f32_16x16x32_bf16(aA, bT, acc, 0, 0, 0);
                uint2 w; w.x = pk2_c(acc[0], acc[1]); w.y = pk2_c(acc[2], acc[3]);
                *(uint2*)(xt + (16 * nt + fr) * 40 + 16 * mh + 4 * fq) = w; }
            __syncthreads();
            const bf16x8 aT = *(const bf16x8*)(t11 + (16 * mh + fr) * 40 + 8 * fq);
            bf16_t* tm = TM + (dd * 2 + vv) * 64 * 72;
#pragma unroll
            for (int nt = 0; nt < 2; ++nt) { const bf16x8 bX = *(const bf16x8*)(xt + (16 * nt + fr) * 40 + 8 * fq);
                f32x4 acc = (f32x4){0.f, 0.f, 0.f, 0.f}; acc = __builtin_amdgcn_mfma_f32_16x16x32_bf16(aT, bX, acc, 0, 0, 0);
                const int sj = 16 * nt + fr, jo = dd ? 63 - sj : sj;
#pragma unroll
                for (int r = 0; r < 4; ++r) { const int si = 32 + 16 * mh + 4 * fq + r, io = dd ? 63 - si : si; tm[io * 72 + jo] = (bf16_t)(pk2_c(-acc[r], 0.f) & 0xffffu); } }
        }
        __syncthreads();
        {   const int mi = wid >> 1, half = wid & 1, uw = mi & 1;
            const bf16_t* Tm = TM + mi * 64 * 72; const bf16_t* Bm = uw ? kT : vT;
            bf16_t* dst = UW + ((size_t)item * 4 + mi) * 8192;
#pragma unroll
            for (int mm = 0; mm < 2; ++mm) {
                const int mt = 2 * half + mm;
                const bf16x8 a0 = *(const bf16x8*)(Tm + (16 * mt + fr) * 72 + 8 * fq), a1 = *(const bf16x8*)(Tm + (16 * mt + fr) * 72 + 32 + 8 * fq);
#pragma unroll
                for (int nt = 0; nt < 8; ++nt) {
                    const bf16x8 b0 = *(const bf16x8*)(Bm + (16 * nt + fr) * 72 + 8 * fq), b1 = *(const bf16x8*)(Bm + (16 * nt + fr) * 72 + 32 + 8 * fq);
                    f32x4 acc = (f32x4){0.f, 0.f, 0.f, 0.f};
                    acc = __builtin_amdgcn_mfma_f32_16x16x32_bf16(b0, a0, acc, 0, 0, 0);
                    acc = __builtin_amdgcn_mfma_f32_16x16x32_bf16(b1, a1, acc, 0, 0, 0);
                    uint2 w; w.x = pk2_c(acc[0], acc[1]); w.y = pk2_c(acc[2], acc[3]);
                    *(uint2*)(dst + (16 * mt + fr) * 128 + 16 * nt + 4 * fq) = w;
                }
            }
        }
        __syncthreads();
    }
}

constexpr int SC_BUF = 68224, SC_W = 0, SC_KT = 17408, SC_Q = 35840, SC_AT = 53248, SC_U = 62464  , SC_S = 67584  ,
              SC_ST = 2 * SC_BUF, SC_VT = SC_ST + 8704, SC_VE = SC_VT + 4608;
static_assert(SC_S + 132 * 4 <= SC_BUF && SC_VE + 4608 <= LDS_BYTES - 16, "scan LDS");
struct ScanLd { uint4 w[4], k[4], q[4], a[2], u; float sc; };
struct ScanCtx { const bf16_t* KT; const bf16_t* QO; const bf16_t* UW; const bf16_t* ATT; const float* GSC; int lt, fr, fq, wid, sl, d, h, b; };
__device__ __forceinline__ void scan_item(const ScanCtx& c, int s, int& item, bool& ctx, int& row0) {
    const int n = c.d ? (s < 4 ? 3 - s : 135 - s) : s; item = ((c.b * NCHUNK + n) << 3) + c.h; ctx = n < 4;
    row0 = ctx ? MLAT + c.b * CL + n * CHK : c.b * SL + (n - 4) * CHK;
}
__device__ __forceinline__ void scan_load(const ScanCtx& c, ScanLd& L, int s) {
    int it, r0; bool cx; scan_item(c, s, it, cx, r0); (void)cx; (void)r0;
    const bf16_t* wp = c.UW + (((size_t)it * 2 + c.d) * 2 + 1) * 8192; const bf16_t* up = c.UW + (((size_t)it * 2 + c.d) * 2) * 8192;
    const bf16_t* kp = c.KT + (size_t)it * 8192; const bf16_t* qp = c.QO + (size_t)it * 8192; const bf16_t* ap = c.ATT + ((size_t)it * 2 + c.d) * 4096;
    const float* gs = c.GSC + ((size_t)it * 2 + c.d) * 192;
    const unsigned o16 = (unsigned)c.lt * 16u;
#pragma unroll
    for (int i = 0; i < 4; ++i) { const unsigned q = o16 + 4096u * i; L.w[i] = *(const uint4*)((const char*)wp + q); L.k[i] = *(const uint4*)((const char*)kp + q); L.q[i] = *(const uint4*)((const char*)qp + q); }
#pragma unroll
    for (int i = 0; i < 2; ++i) L.a[i] = *(const uint4*)((const char*)ap + o16 + 4096u * i);
    L.u = *(const uint4*)((const char*)up + (unsigned)((c.lt >> 2) * 256 + 64 * c.sl + (c.lt & 3) * 16));
    L.sc = gs[c.lt < 129 ? c.lt : 128];
}
__device__ __forceinline__ void scan_store(const ScanCtx& c, const ScanLd& L, unsigned char* bp) {
#pragma unroll
    for (int i = 0; i < 4; ++i) { const int q = c.lt + 256 * i;
        *(uint4*)(bp + SC_W + (q >> 4) * 272 + (q & 15) * 16) = L.w[i];
        *(uint4*)(bp + SC_KT + (q >> 3) * 144 + (q & 7) * 16) = L.k[i];
        *(uint4*)(bp + SC_Q + (q >> 4) * 272 + (q & 15) * 16) = L.q[i]; }
#pragma unroll
    for (int i = 0; i < 2; ++i) { const int q = c.lt + 256 * i; *(uint4*)(bp + SC_AT + (q >> 3) * 144 + (q & 7) * 16) = L.a[i]; }
    *(uint4*)(bp + SC_U + (c.lt >> 2) * 80 + (c.lt & 3) * 16) = L.u;
    if (c.lt < 129) *(float*)(bp + SC_S + c.lt * 4) = L.sc;
}
__device__ __forceinline__ void scan_alpha(const ScanCtx& c, unsigned char* lds, const unsigned char* bc, bool ctx, f32x4 (&O1)[2]) {
    const int fr = c.fr, fq = c.fq, mt = c.wid;
    f32x4 P[2]; P[0] = (f32x4){0.f, 0.f, 0.f, 0.f}; P[1] = (f32x4){0.f, 0.f, 0.f, 0.f}; O1[0] = (f32x4){0.f, 0.f, 0.f, 0.f}; O1[1] = (f32x4){0.f, 0.f, 0.f, 0.f};
#pragma unroll
    for (int ks = 0; ks < 4; ++ks) {
        const bf16x8 aW = *(const bf16x8*)(bc + SC_W + (16 * mt + fr) * 272 + (32 * ks + 8 * fq) * 2);
        bf16x8 aQ = aW; if (!ctx) aQ = *(const bf16x8*)(bc + SC_Q + (16 * mt + fr) * 272 + (32 * ks + 8 * fq) * 2);
#pragma unroll
        for (int nt = 0; nt < 2; ++nt) {
            const bf16x8 bS = *(const bf16x8*)(lds + SC_ST + (16 * nt + fr) * 272 + (32 * ks + 8 * fq) * 2);
            P[nt] = __builtin_amdgcn_mfma_f32_16x16x32_bf16(aW, bS, P[nt], 0, 0, 0);
            if (!ctx) O1[nt] = __builtin_amdgcn_mfma_f32_16x16x32_bf16(aQ, bS, O1[nt], 0, 0, 0);
        }
    }
    float eec[4];
#pragma unroll
    for (int r = 0; r < 4; ++r) eec[r] = *(const float*)(bc + SC_S + (64 + 16 * mt + 4 * fq + r) * 4);
#pragma unroll
    for (int nt = 0; nt < 2; ++nt) {
        float vn[4];
#pragma unroll
        for (int r = 0; r < 4; ++r) vn[r] = bf2f(*(const bf16_t*)(bc + SC_U + (16 * mt + 4 * fq + r) * 80 + (16 * nt + fr) * 2)) - P[nt][r];
        uint2 w; w.x = pk2(vn[0], vn[1]); w.y = pk2(vn[2], vn[3]);
        *(uint2*)(lds + SC_VT + (16 * nt + fr) * 144 + (16 * mt + 4 * fq) * 2) = w;
        w.x = pk2(vn[0] * eec[0], vn[1] * eec[1]); w.y = pk2(vn[2] * eec[2], vn[3] * eec[3]);
        *(uint2*)(lds + SC_VE + (16 * nt + fr) * 144 + (16 * mt + 4 * fq) * 2) = w;
    }
}
__device__ __forceinline__ void scan_beta(const ScanCtx& c, unsigned char* lds, const unsigned char* bc, bool ctx, int row0, const f32x4 (&O1)[2], f32x4 (&Sacc)[2][2], bf16_t* OD) {
    const int fr = c.fr, fq = c.fq, mt = c.wid;
    const float decc = *(const float*)(bc + SC_S + 128 * 4);
#pragma unroll
    for (int j = 0; j < 2; ++j) {
        const int dt = 2 * c.wid + j;
        const bf16x8 aK0 = *(const bf16x8*)(bc + SC_KT + (16 * dt + fr) * 144 + (8 * fq) * 2), aK1 = *(const bf16x8*)(bc + SC_KT + (16 * dt + fr) * 144 + (32 + 8 * fq) * 2);
#pragma unroll
        for (int e = 0; e < 2; ++e) {
            f32x4 a = Sacc[j][e] * decc;
            const bf16x8 b0 = *(const bf16x8*)(lds + SC_VE + (16 * e + fr) * 144 + (8 * fq) * 2), b1 = *(const bf16x8*)(lds + SC_VE + (16 * e + fr) * 144 + (32 + 8 * fq) * 2);
            a = __builtin_amdgcn_mfma_f32_16x16x32_bf16(aK0, b0, a, 0, 0, 0);
            a = __builtin_amdgcn_mfma_f32_16x16x32_bf16(aK1, b1, a, 0, 0, 0);
            Sacc[j][e] = a;
        }
    }
    if (!ctx) {
        const bf16x8 aA0 = *(const bf16x8*)(bc + SC_AT + (16 * mt + fr) * 144 + (8 * fq) * 2), aA1 = *(const bf16x8*)(bc + SC_AT + (16 * mt + fr) * 144 + (32 + 8 * fq) * 2);
        float egc[4];
#pragma unroll
        for (int r = 0; r < 4; ++r) egc[r] = *(const float*)(bc + SC_S + (16 * mt + 4 * fq + r) * 4);
#pragma unroll
        for (int nt = 0; nt < 2; ++nt) {
            const bf16x8 b0 = *(const bf16x8*)(lds + SC_VT + (16 * nt + fr) * 144 + (8 * fq) * 2), b1 = *(const bf16x8*)(lds + SC_VT + (16 * nt + fr) * 144 + (32 + 8 * fq) * 2);
            f32x4 O2 = (f32x4){0.f, 0.f, 0.f, 0.f};
            O2 = __builtin_amdgcn_mfma_f32_16x16x32_bf16(aA0, b0, O2, 0, 0, 0);
            O2 = __builtin_amdgcn_mfma_f32_16x16x32_bf16(aA1, b1, O2, 0, 0, 0);
#pragma unroll
            for (int r = 0; r < 4; ++r) OD[(size_t)(row0 + 16 * mt + 4 * fq + r) * 1024 + c.h * 128 + 32 * c.sl + 16 * nt + fr] = f2bf(egc[r] * O1[nt][r] + O2[r]);
        }
    }
#pragma unroll
    for (int j = 0; j < 2; ++j)
#pragma unroll
        for (int e = 0; e < 2; ++e) { uint2 w; w.x = pk2_c(Sacc[j][e][0], Sacc[j][e][1]); w.y = pk2_c(Sacc[j][e][2], Sacc[j][e][3]);
            *(uint2*)(lds + SC_ST + (16 * e + fr) * 272 + (16 * (2 * c.wid + j) + 4 * fq) * 2) = w; }
}
__device__ __forceinline__ void phase_gdn_scan(const Params& p, unsigned char* lds) {
    ScanCtx c;
    const int tid = otid(), lane = tid & 63; c.wid = __builtin_amdgcn_readfirstlane(tid >> 6); c.fr = lane & 15; c.fq = lane >> 4;
    const bool loader = c.wid >= 4; c.lt = tid - 256;
    c.KT = (const bf16_t*)(p.ws + OFF_KT); c.QO = (const bf16_t*)(p.ws + OFF_Q); c.UW = (const bf16_t*)(p.ws + OFF_UW);
    c.ATT = (const bf16_t*)(p.ws + OFF_ATT); c.GSC = (const float*)(p.ws + OFF_GSC);
    for (int work = blockIdx.x; work < 256; work += gridDim.x) {
        const int xcd_ = work & 7, idx_ = work >> 3, grp_ = (idx_ >> 2) * 8 + xcd_;
        c.sl = idx_ & 3; c.d = grp_ & 1; c.h = (grp_ >> 1) & 7; c.b = grp_ >> 4;
        bf16_t* OD = (bf16_t*)(p.ws + (c.d ? OFF_OB : OFF_OF));
        for (int i = tid; i < 8704 / 4; i += NT) ((unsigned*)(lds + SC_ST))[i] = 0u;
        if (loader) {
            ScanLd L0, L1;
#define SCAN_ZERO(L_) do { _Pragma("unroll") for (int i = 0; i < 4; ++i) { L_.w[i] = make_uint4(0u, 0u, 0u, 0u); L_.k[i] = make_uint4(0u, 0u, 0u, 0u); L_.q[i] = make_uint4(0u, 0u, 0u, 0u); } \
                L_.a[0] = make_uint4(0u, 0u, 0u, 0u); L_.a[1] = make_uint4(0u, 0u, 0u, 0u); L_.u = make_uint4(0u, 0u, 0u, 0u); L_.sc = 0.f; } while (0)
            SCAN_ZERO(L0); SCAN_ZERO(L1);
#undef SCAN_ZERO
            scan_load(c, L0, 0); scan_store(c, L0, lds); scan_load(c, L1, 1);
            __syncthreads();
#define SCAN_LSTEP(s_, LD_, ST_) do { const int ss_ = (s_); if (ss_ + 2 < NCHUNK) scan_load(c, LD_, ss_ + 2); __syncthreads(); \
                if (ss_ + 1 < NCHUNK) scan_store(c, ST_, lds + ((ss_ + 1) & 1) * SC_BUF); __syncthreads(); } while (0)
#pragma unroll 1
            for (int s = 0; s < NCHUNK; s += 2) {
                SCAN_LSTEP(s, L0, L1); SCAN_LSTEP(s + 1, L1, L0); }
#undef SCAN_LSTEP
        } else {
            f32x4 Sacc[2][2];
#pragma unroll
            for (int j = 0; j < 2; ++j) { Sacc[j][0] = (f32x4){0.f, 0.f, 0.f, 0.f}; Sacc[j][1] = (f32x4){0.f, 0.f, 0.f, 0.f}; }
            __syncthreads();
#pragma unroll 1
            for (int s = 0; s < NCHUNK; ++s) {
                int item, row0; bool ctx; scan_item(c, s, item, ctx, row0); (void)item;
                const unsigned char* bc = lds + (s & 1) * SC_BUF; f32x4 O1[2];
                scan_alpha(c, lds, bc, ctx, O1);
                __syncthreads();
                scan_beta(c, lds, bc, ctx, row0, O1, Sacc, OD);
                __syncthreads();
            }
        }
    }
}

__device__ __forceinline__ void phase_gdn_out(const Params& p) {
    const bf16_t* OFp = (const bf16_t*)(p.ws + OFF_OF); const bf16_t* OBp = (const bf16_t*)(p.ws + OFF_OB); const bf16_t* PZ = (const bf16_t*)(p.ws + OFF_PZ);
    bf16_t* MIX = (bf16_t*)(p.ws + OFF_H); const float* gn = p.in[14];
    const size_t total = (size_t)MLAT * 128, stride = (size_t)gridDim.x * NT;
    size_t e = (size_t)blockIdx.x * NT + otid();
    const bool gn_fixed = ((stride & 127) == 0); float gnr[8];
#pragma unroll
    for (int j = 0; j < 8; ++j) gnr[j] = gn[(((int)(e & 127) * 8) & 127) + j];
    uint4 ua, ub, uz, na, nb, nz;
    if (e < total) { const size_t row = e >> 7; const int c8 = (int)(e & 127) * 8; ua = *(const uint4*)(OFp + row * 1024 + c8); ub = *(const uint4*)(OBp + row * 1024 + c8); uz = *(const uint4*)(PZ + row * 1024 + c8); }
    for (; e < total; e += stride) {
        const size_t en = e + stride;
        if (en < total) { const size_t row = en >> 7; const int c8 = (int)(en & 127) * 8; na = *(const uint4*)(OFp + row * 1024 + c8); nb = *(const uint4*)(OBp + row * 1024 + c8); nz = *(const uint4*)(PZ + row * 1024 + c8); }
        const size_t row = e >> 7; const int c8 = (int)(e & 127) * 8;
        float a[8], bq[8], z[8];
        unpack8(ua, a); unpack8(ub, bq); unpack8(uz, z);
        float ss = 0.f;
#pragma unroll
        for (int j = 0; j < 8; ++j) { a[j] += bq[j]; ss += a[j] * a[j]; }
        ss += __shfl_xor(ss, 1); ss += __shfl_xor(ss, 2); ss += __shfl_xor(ss, 4); ss += __shfl_xor(ss, 8);
        const float rstd = rsqrtf(ss * (1.0f / 128.0f) + EPSF);
#pragma unroll
        for (int j = 0; j < 8; ++j) a[j] = a[j] * rstd * (gn_fixed ? gnr[j] : gn[(c8 & 127) + j]) * silu(z[j]);
        *(uint4*)(MIX + row * DM + c8) = pack8(a);
        ua = na; ub = nb; uz = nz;
    }
}

__device__ __forceinline__ void phase_postmix(const Params& p) {
    const int tid_ = otid(), lane = tid_ & 63, wv = __builtin_amdgcn_readfirstlane(tid_ >> 6);
    const float* MOD = (const float*)(p.ws + OFF_MOD); const float* w1 = p.in[7]; const float* w2 = p.in[8];
    const bf16_t* OUT = (const bf16_t*)(p.ws + OFF_OUT); bf16_t* H = (bf16_t*)(p.ws + OFF_H); bf16_t* S1B = (bf16_t*)(p.ws + OFF_S1B);
    const int stride = gridDim.x * 8;
    uint4 ov[4], ovn[4]; float4 xv[8], xvn[8], pgw[4][2]; int b_loaded = -1;
    int row = blockIdx.x * 8 + wv;
    if (row < MLAT) {
#pragma unroll
        for (int i = 0; i < 4; ++i) { ov[i] = *(const uint4*)(OUT + (size_t)row * DM + 8 * (lane + 64 * i));
            xv[2 * i] = *(const float4*)(p.in[0] + (size_t)row * DM + 8 * (lane + 64 * i)); xv[2 * i + 1] = *(const float4*)(p.in[0] + (size_t)row * DM + 8 * (lane + 64 * i) + 4); } }
    for (; row < MLAT; row += stride) {
        const int nxt = row + stride;
        if (nxt < MLAT) {
#pragma unroll
            for (int i = 0; i < 4; ++i) { ovn[i] = *(const uint4*)(OUT + (size_t)nxt * DM + 8 * (lane + 64 * i));
                xvn[2 * i] = *(const float4*)(p.in[0] + (size_t)nxt * DM + 8 * (lane + 64 * i)); xvn[2 * i + 1] = *(const float4*)(p.in[0] + (size_t)nxt * DM + 8 * (lane + 64 * i) + 4); } }
        const int b = row >> 13; const float* mb = MOD + b * (6 * DM);
        const float* ga = mb + 2 * DM; const float* shf = mb + 3 * DM; const float* scf = mb + 4 * DM;
        if (b != b_loaded) { b_loaded = b;
#pragma unroll
            for (int i = 0; i < 4; ++i)
#pragma unroll
                for (int hh = 0; hh < 2; ++hh) { const int col = 8 * (lane + 64 * i) + 4 * hh; const float4 wv4 = *(const float4*)(w1 + col), gv = *(const float4*)(ga + col);
                    pgw[i][hh] = make_float4(gv.x * wv4.x, gv.y * wv4.y, gv.z * wv4.z, gv.w * wv4.w); } }
        float o[4][8]; float ss = 0.f;
#pragma unroll
        for (int i = 0; i < 4; ++i) { unpack8(ov[i], o[i]);
#pragma unroll
            for (int j = 0; j < 8; ++j) ss += o[i][j] * o[i][j]; }
        ss = wave_sum(ss); const float rstd = rsqrtf(ss * (1.0f / DM) + EPSF);
        float ss2 = 0.f;
#pragma unroll
        for (int i = 0; i < 4; ++i) { const int col = 8 * (lane + 64 * i);
#pragma unroll
            for (int hh = 0; hh < 2; ++hh) { const float4 xq = xv[2 * i + hh], gw = pgw[i][hh];
                float4 s; s.x = xq.x + gw.x * (o[i][4 * hh] * rstd); s.y = xq.y + gw.y * (o[i][4 * hh + 1] * rstd); s.z = xq.z + gw.z * (o[i][4 * hh + 2] * rstd); s.w = xq.w + gw.w * (o[i][4 * hh + 3] * rstd);
                o[i][4 * hh] = s.x; o[i][4 * hh + 1] = s.y; o[i][4 * hh + 2] = s.z; o[i][4 * hh + 3] = s.w;
                ss2 += s.x * s.x + s.y * s.y + s.z * s.z + s.w * s.w; } }
        ss2 = wave_sum(ss2); const float rstd2 = rsqrtf(ss2 * (1.0f / DM) + EPSF);
#pragma unroll
        for (int i = 0; i < 4; ++i) { const int col = 8 * (lane + 64 * i); float f[8];
#pragma unroll
            for (int j = 0; j < 8; ++j) f[j] = o[i][j] * rstd2 * w2[col + j] * (1.f + scf[col + j]) + shf[col + j];
            *(uint4*)(H + (size_t)row * DM + col) = pack8(f); *(uint4*)(S1B + (size_t)row * DM + col) = pack8(o[i]); }
#pragma unroll
        for (int i = 0; i < 4; ++i) { ov[i] = ovn[i]; xv[2 * i] = xvn[2 * i]; xv[2 * i + 1] = xvn[2 * i + 1]; }
    }
}

__device__ __forceinline__ void phase_final(const Params& p) {
    const int tid_ = otid(), lane = tid_ & 63, wv = __builtin_amdgcn_readfirstlane(tid_ >> 6);
    const float* MOD = (const float*)(p.ws + OFF_MOD); const float* w = p.in[9]; const bf16_t* FF = (const bf16_t*)(p.ws + OFF_FF); const bf16_t* S1B = (const bf16_t*)(p.ws + OFF_S1B);
    const int stride = gridDim.x * 8;
    uint4 fv[4], fvn[4], sv[4], svn[4]; float4 pg[4][2]; int b_loaded = -1;
    int row = blockIdx.x * 8 + wv;
    if (row < MLAT) {
#pragma unroll
        for (int i = 0; i < 4; ++i) { fv[i] = *(const uint4*)(FF + (size_t)row * DM + 8 * (lane + 64 * i)); sv[i] = *(const uint4*)(S1B + (size_t)row * DM + 8 * (lane + 64 * i)); } }
    for (; row < MLAT; row += stride) {
        const int nxt = row + stride;
        if (nxt < MLAT) {
#pragma unroll
            for (int i = 0; i < 4; ++i) { fvn[i] = *(const uint4*)(FF + (size_t)nxt * DM + 8 * (lane + 64 * i)); svn[i] = *(const uint4*)(S1B + (size_t)nxt * DM + 8 * (lane + 64 * i)); } }
        const int b = row >> 13;
        if (b != b_loaded) { b_loaded = b; const float* gf = MOD + b * (6 * DM) + 5 * DM;
#pragma unroll
            for (int i = 0; i < 4; ++i)
#pragma unroll
                for (int hh = 0; hh < 2; ++hh) { const int col = 8 * (lane + 64 * i) + 4 * hh; const float4 wv4 = *(const float4*)(w + col), gv = *(const float4*)(gf + col);
                    pg[i][hh] = make_float4(gv.x * wv4.x, gv.y * wv4.y, gv.z * wv4.z, gv.w * wv4.w); } }
        float o[4][8]; float ss = 0.f;
#pragma unroll
        for (int i = 0; i < 4; ++i) { unpack8(fv[i], o[i]);
#pragma unroll
            for (int j = 0; j < 8; ++j) ss += o[i][j] * o[i][j]; }
        ss = wave_sum(ss); const float rstd = rsqrtf(ss * (1.0f / DM) + EPSF);
#pragma unroll
        for (int i = 0; i < 4; ++i) { const int col = 8 * (lane + 64 * i); float s1[8]; unpack8(sv[i], s1);
#pragma unroll
            for (int hh = 0; hh < 2; ++hh) { const float4 gw = pg[i][hh]; float4 s;
                s.x = s1[4 * hh] + gw.x * (o[i][4 * hh] * rstd); s.y = s1[4 * hh + 1] + gw.y * (o[i][4 * hh + 1] * rstd);
                s.z = s1[4 * hh + 2] + gw.z * (o[i][4 * hh + 2] * rstd); s.w = s1[4 * hh + 3] + gw.w * (o[i][4 * hh + 3] * rstd);
                *(float4*)(p.out + (size_t)row * DM + col + 4 * hh) = s; } }
#pragma unroll
        for (int i = 0; i < 4; ++i) { fv[i] = fvn[i]; sv[i] = svn[i]; }
    }
}

#define XB_TMO      128
#define XB_XCNT(j)  (256  + 64 * (j))
#define XB_XSUB(j)  (1280 + 64 * (j))
#define XB_XGEN(j)  (2304 + 64 * (j))
#define XB_TOP      3328
#define XB_TOPGEN   3392
#define XCD_BAR_WORDS 3456
#define XB_SPIN_CAP (1u << 18)
#define LAS __attribute__((address_space(3)))

__device__ __forceinline__ unsigned xb_ld(unsigned* p)              { return __hip_atomic_load(p, __ATOMIC_RELAXED, __HIP_MEMORY_SCOPE_AGENT); }
__device__ __forceinline__ unsigned xb_add(unsigned* p, unsigned v) { return __hip_atomic_fetch_add(p, v, __ATOMIC_RELAXED, __HIP_MEMORY_SCOPE_AGENT); }
__device__ __forceinline__ unsigned xb_xcc_id() { return (unsigned)__builtin_amdgcn_s_getreg((3 << 11) | 20) & 0xFu; }
#define XB_SPIN(cond, bar) do { unsigned _sp = 0; while (cond) { __builtin_amdgcn_s_sleep(1); \
    if ((++_sp & 255u) == 0u) { if (xb_ld(&(bar)[XB_TMO])) break; if (_sp > XB_SPIN_CAP) { atomicAdd(&(bar)[XB_TMO], 1u); break; } } } } while (0)

struct XcdBarrier {
    unsigned* bar; unsigned x;
    volatile LAS unsigned* st;
};

__device__ __forceinline__ XcdBarrier xcd_barrier_post(unsigned* bar, volatile LAS unsigned* st) {
    XcdBarrier b; b.bar = bar; b.x = xb_xcc_id(); b.st = st;
    if (threadIdx.x == 0) (void)xb_add(&bar[XB_XCNT(b.x)], 1u);
    return b;
}
__device__ __forceinline__ void xcd_barrier_complete(unsigned* bar, unsigned x, unsigned& nloc, unsigned& nx) {
    const unsigned G = gridDim.x * gridDim.y * gridDim.z;
    unsigned sum, cnt, mine, sp = 0u;
    for (;;) {
        sum = 0u; cnt = 0u; mine = 0u;
#pragma unroll
        for (unsigned j = 0; j < 16; ++j) { const unsigned c = xb_ld(&bar[XB_XCNT(j)]); sum += c; cnt += (c > 0u) ? 1u : 0u; mine = (j == x) ? c : mine; }
        if (sum == G) break;
        __builtin_amdgcn_s_sleep(1);
        if ((++sp & 255u) == 0u) { if (xb_ld(&bar[XB_TMO])) break; if (sp > XB_SPIN_CAP) { atomicAdd(&bar[XB_TMO], 1u); break; } }
    }
    nloc = mine > 0u ? mine : 1u; nx = cnt > 0u ? cnt : 1u;
}

__device__ __forceinline__ void xcd_barrier(const XcdBarrier& b) {
    asm volatile("s_waitcnt vmcnt(0)" ::: "memory");
    __syncthreads();
    if (threadIdx.x == 0) {
        unsigned* bar = b.bar;
        __builtin_amdgcn_s_waitcnt(0);
        unsigned nloc = b.st[0], nx = b.st[1];
        if (nloc == 0u) { xcd_barrier_complete(bar, b.x, nloc, nx); b.st[0] = nloc; b.st[1] = nx; }
        const unsigned old = xb_add(&bar[XB_XSUB(b.x)], 1u);
        const unsigned gen = old / nloc;
        if (old + 1u == (gen + 1u) * nloc) {
            __builtin_amdgcn_fence(__ATOMIC_RELEASE, "agent");
            asm volatile("s_waitcnt vmcnt(0)" ::: "memory");
            const unsigned og = xb_add(&bar[XB_TOP], 1u);
            const unsigned tg = og / nx;
            if (og + 1u == (tg + 1u) * nx) xb_add(&bar[XB_TOPGEN], 1u);
            else XB_SPIN(xb_ld(&bar[XB_TOPGEN]) == tg, bar);
            __builtin_amdgcn_fence(__ATOMIC_ACQUIRE, "agent");
            xb_add(&bar[XB_XGEN(b.x)], 1u);
            asm volatile("s_waitcnt vmcnt(0)" ::: "memory");
        } else {
            XB_SPIN(xb_ld(&bar[XB_XGEN(b.x)]) == gen, bar);
            __builtin_amdgcn_fence(__ATOMIC_ACQUIRE, "agent");
            asm volatile("s_waitcnt vmcnt(0)" ::: "memory");
        }
    }
    __syncthreads();
}


constexpr int NPHASE = 14;
template <class Epi> __device__ __forceinline__ void run_gemm(unsigned char* lds, const bf16_t* A, const bf16_t* Bt, int M, int N, int K, const Epi& E) {
    pg8::Gemm g{A, Bt, M, N, K}; pg8::StaticOrder S; S.init(M, N, (int)gridDim.x, (int)blockIdx.x);
    pg8::gemm_phase<Epi, pg8::StaticOrder, true, true>((PG8_LAS unsigned char*)lds, g, S, E);
}
__global__ void __launch_bounds__(NT, 2) fwd_kernel(Params p) {
    extern __shared__ __attribute__((aligned(16))) unsigned char lds[];
    cg::grid_group grid = cg::this_grid();
    const int lo = p.ph_lo, hi = p.ph_hi;
    unsigned char* ws = p.ws;
    if (lo < 0) grid.sync();
    if (threadIdx.x == 0) *(uint4*)(lds + LDS_BYTES - 16) = make_uint4(0u, 0u, 0u, 0u);
    __syncthreads();
    XcdBarrier xbar = xcd_barrier_post((unsigned*)(ws + OFF_BAR), (volatile LAS unsigned*)((LAS unsigned char*)lds + (LDS_BYTES - 16)));
#ifndef PH_MASK
#define PH_MASK 0xffff
#endif
#ifndef REP_MASK
#define REP_MASK 0
#endif
#define IN(k) ((((PH_MASK) >> (k)) & 1) && lo <= (k) && (k) < hi)
#define REP(k, stmt) do { if (IN(k)) { const int nrep_ = 1 + ((REP_MASK >> (k)) & 1); _Pragma("unroll 1") for (int rep_ = 0; rep_ < nrep_; ++rep_) { if (rep_) xcd_barrier(xbar); stmt; } } } while (0)
#define SEAM(k) do { if (IN(k) && IN((k) + 1)) xcd_barrier(xbar); } while (0)
    REP(0, phase_prologue(p, lds));
    SEAM(0);
    REP(1, phase_prenorm(p));
    SEAM(1);
    { pg8::EpiProj E{(bf16_t*)(ws + OFF_PGDN), (bf16_t*)(ws + OFF_PZ), (bf16_t*)(ws + OFF_PHY), (float*)(ws + OFF_GATES)};
        REP(2, run_gemm(lds, (const bf16_t*)(ws + OFF_H), (const bf16_t*)(ws + OFF_WIN), MALL, N1, DM, E)); }
    SEAM(2);
#pragma unroll 1
    for (int rep_ = 0; rep_ < 1 + ((REP_MASK >> 3) & 1); ++rep_) {
    if (IN(3)) phase_hy1(p, lds);
    SEAM(3);
    if (IN(4)) phase_hy2(p, lds);
    SEAM(4);
    if (IN(5)) phase_hy3(p, lds);
    SEAM(5);
    }
    REP(6, phase_gdn_prep(p, lds));
    SEAM(6);
    REP(7, phase_gdn_scan(p, lds));
    SEAM(7);
    REP(8, phase_gdn_out(p));
    SEAM(8);
    { pg8::EpiPlain E{(bf16_t*)(ws + OFF_OUT), DM};
        REP(9, run_gemm(lds, (const bf16_t*)(ws + OFF_H), (const bf16_t*)(ws + OFF_WOUT), MLAT, DM, DM, E)); }
    SEAM(9);
    REP(10, phase_postmix(p));
    SEAM(10);
    { pg8::EpiSwiglu E{(bf16_t*)(ws + OFF_ACT), DFF};
        REP(11, run_gemm(lds, (const bf16_t*)(ws + OFF_H), (const bf16_t*)(ws + OFF_WGU), MLAT, 2 * DFF, DM, E)); }
    SEAM(11);
    { pg8::EpiPlain E{(bf16_t*)(ws + OFF_FF), DM};
        REP(12, run_gemm(lds, (const bf16_t*)(ws + OFF_ACT), (const bf16_t*)(ws + OFF_WDOWN), MLAT, DM, DFF, E)); }
    SEAM(12);
    if (IN(13)) phase_final(p);
#undef IN
#undef REP
#undef SEAM
}

extern "C" void kernel_launch(void* const* d_in, const int* in_sizes, int n_in, void* d_out, int out_size, void* d_ws, size_t ws_size, hipStream_t stream) {
    static int grid = 0;
    if (grid == 0) {
        if (n_in != 32 || ws_size < WS_TOTAL) { fprintf(stderr, "kernel_launch: need 32 inputs and %zu bytes of workspace (got %d, %zu)\n", (size_t)WS_TOTAL, n_in, ws_size); grid = -1; return; }
        int dev = 0, cus = 0, per_cu = 0;
        hipGetDevice(&dev); hipDeviceGetAttribute(&cus, hipDeviceAttributeMultiprocessorCount, dev);
        if (hipFuncSetAttribute((const void*)fwd_kernel, hipFuncAttributeMaxDynamicSharedMemorySize, LDS_BYTES) != hipSuccess) { fprintf(stderr, "kernel_launch: hipFuncSetAttribute failed\n"); grid = -1; return; }
        if (hipOccupancyMaxActiveBlocksPerMultiprocessor(&per_cu, (const void*)fwd_kernel, NT, LDS_BYTES) != hipSuccess || per_cu < 1) { fprintf(stderr, "kernel_launch: occupancy query gave %d\n", per_cu); per_cu = 1; }
        (void)hipGetLastError();
        grid = cus * per_cu;
    }
    if (grid < 0) return;
    if (hipMemsetAsync((unsigned char*)d_ws + OFF_BAR, 0, XCD_BAR_WORDS * 4, stream) != hipSuccess) { fprintf(stderr, "kernel_launch: memset of the barrier words failed\n"); return; }
    Params p{};
    for (int i = 0; i < 32; ++i) p.in[i] = (const float*)d_in[i];
    p.out = (float*)d_out; p.ws = (unsigned char*)d_ws;
#if MULTI_LAUNCH
    for (int ph = 0; ph < NPHASE; ++ph) { p.ph_lo = ph; p.ph_hi = ph + 1;
        hipLaunchKernelGGL(fwd_kernel, dim3(grid), dim3(NT), LDS_BYTES, stream, p); }
#else
    p.ph_lo = 0; p.ph_hi = NPHASE;
    void* args[] = {&p};
    hipError_t e = hipLaunchCooperativeKernel((const void*)fwd_kernel, dim3(grid), dim3(NT), args, LDS_BYTES, stream);
    if (e != hipSuccess) fprintf(stderr, "cooperative launch failed: %s (grid %d)\n", hipGetErrorString(e), grid);
#endif
}
```
